# Optimizing an MI355X kernel written in HIP

```python
import math
import jax, jax.numpy as jnp
from jax import lax
import numpy as np

D_MODEL = 1024
BATCH = 8
SEQ = 2048
DEPTH = 2

A_HEAD_DIM = 64
A_HEADS = D_MODEL // A_HEAD_DIM
DILATED_PAIRS = ((128, 1), (512, 4), (2048, 16))
DBLK = 128
MLA_HEADS = D_MODEL // 64
Q_RANK = 3 * D_MODEL // 8
KV_RANK = D_MODEL // 4
NOPE_DIM = 64
ROPE_DIM = 32
QK_DIM = NOPE_DIM + ROPE_DIM
V_DIM = 64
QBLK = 128
ROPE_THETA = 10000.0
N_EXPERTS = 64
N_GROUPS = 8
TOPK_GROUPS = 4
TOP_K = 6
EXPERT_DIM = D_MODEL // 4
SHARED_DIM = D_MODEL // 4
ROUTED_SCALE = 2.5
EXPERT_BLOCK = 256
NORM_EPS = 1e-6

kernel_name = 'yoco_dilated_mla_moe_adaln_block'


def _layer_split():
    n_a = (DEPTH + 1) // 2
    return n_a, DEPTH - n_a


def rms_norm(x, g):
    x32 = x.astype(jnp.float32)
    y = x32 * lax.rsqrt(jnp.mean(x32 * x32, axis=-1, keepdims=True) + NORM_EPS)
    return (y * g.astype(jnp.float32)).astype(x.dtype)


def apply_rope(t, pos):
    half = t.shape[-1] // 2
    inv = jnp.power(ROPE_THETA, -jnp.arange(half, dtype=jnp.float32) / half)
    ang = pos.astype(jnp.float32)[..., None] * inv
    cos = jnp.cos(ang)[:, :, None, :]
    sin = jnp.sin(ang)[:, :, None, :]
    t1 = t[..., :half].astype(jnp.float32)
    t2 = t[..., half:].astype(jnp.float32)
    return jnp.concatenate([t1 * cos - t2 * sin, t1 * sin + t2 * cos], axis=-1).astype(t.dtype)


def alibi_slopes(n_heads):
    return jnp.exp2(-8.0 * jnp.arange(1, n_heads + 1, dtype=jnp.float32) / n_heads)


def dilated_branch(q, k, v, pos, slopes, dil, span):
    B, S, H, Dh = q.shape
    L = S // dil
    nb = -(-L // DBLK)
    Lp = nb * DBLK

    def residues(t):
        return jnp.swapaxes(t.reshape((B, L, dil) + t.shape[2:]), 1, 2)

    def pad_len(t, front, back):
        widths = [(0, 0)] * t.ndim
        widths[2] = (front, back)
        return jnp.pad(t, widths)

    def key_windows(t):
        t = pad_len(t, DBLK, Lp - L).reshape((B, dil, nb + 1, DBLK) + t.shape[3:])
        return jnp.concatenate([t[:, :, :-1], t[:, :, 1:]], axis=3)

    qb = pad_len(residues(q), 0, Lp - L).reshape(B, dil, nb, DBLK, H, Dh)
    kw = key_windows(residues(k))
    vw = key_windows(residues(v))
    pr = residues(pos)
    pq = pad_len(pr, 0, Lp - L).reshape(B, dil, nb, DBLK)
    pk = key_windows(pr)

    s = jnp.einsum('brnqhd,brnkhd->brnhqk', qb, kw,
                   preferred_element_type=jnp.float32) * (Dh ** -0.5)
    rel = (pq[..., :, None] - pk[..., None, :]).astype(jnp.float32)
    s = s - slopes[:, None, None] * rel[:, :, :, None]
    a_idx = jnp.arange(DBLK)[:, None]
    c_idx = jnp.arange(2 * DBLK)[None, :]
    dist = a_idx - c_idx + DBLK
    key_idx = jnp.arange(nb)[:, None, None] * DBLK + c_idx[None] - DBLK
    valid = (dist >= 0) & (dist <= span) & (key_idx >= 0)
    s = jnp.where(valid[:, None], s, -jnp.inf)
    m = jnp.max(s, axis=-1, keepdims=True)
    p = jnp.exp(s - m)
    l = jnp.sum(p, axis=-1)
    o = jnp.einsum('brnhqk,brnkhd->brnqhd', p.astype(v.dtype), vw,
                   preferred_element_type=jnp.float32)
    o = o / jnp.moveaxis(l, 3, 4)[..., None]
    lse = jnp.moveaxis(m[..., 0] + jnp.log(l), 3, 4)

    def back(t):
        rest = t.shape[4:]
        t = t.reshape((B, dil, Lp) + rest)[:, :, :L]
        return jnp.swapaxes(t, 1, 2).reshape((B, S) + rest)

    return back(o), back(lse)


def dilated_attention(h, pos, w_qkv, q_norm, k_norm, w_o):
    B, S, _ = h.shape
    qkv = (h @ w_qkv).reshape(B, S, 3, A_HEADS, A_HEAD_DIM)
    q = rms_norm(qkv[:, :, 0], q_norm)
    k = rms_norm(qkv[:, :, 1], k_norm)
    v = qkv[:, :, 2]
    slopes = alibi_slopes(A_HEADS)
    outs, lses = [], []
    for win, dil in DILATED_PAIRS:
        o_b, lse_b = dilated_branch(q, k, v, pos, slopes, dil, win // dil)
        outs.append(o_b)
        lses.append(lse_b)
    wts = jax.nn.softmax(jnp.stack(lses), axis=0)
    o = jnp.einsum('gbsh,gbshd->bshd', wts, jnp.stack(outs))
    return o.reshape(B, S, A_HEADS * A_HEAD_DIM).astype(h.dtype) @ w_o


def shared_kv(x, c, pos, kv_ada_w, kv_ada_b, kv_norm_g, kv_w_down, kv_latent_norm,
              kv_w_uk, kv_w_uv, kv_k_norm):
    B, S, _ = x.shape
    mod = jax.nn.silu(c) @ kv_ada_w + kv_ada_b
    shift, scale = jnp.split(mod, 2, axis=-1)
    h = rms_norm(x, kv_norm_g) * (1.0 + scale[:, None]) + shift[:, None]
    down = h @ kv_w_down
    c_kv = rms_norm(down[..., :KV_RANK], kv_latent_norm)
    k_pe = down[..., KV_RANK:]
    k_nope = (c_kv @ kv_w_uk).reshape(B, S, MLA_HEADS, NOPE_DIM)
    v = (c_kv @ kv_w_uv).reshape(B, S, MLA_HEADS, V_DIM)
    k = jnp.concatenate(
        [k_nope, jnp.broadcast_to(k_pe[:, :, None, :], (B, S, MLA_HEADS, ROPE_DIM))], axis=-1)
    k = rms_norm(k, kv_k_norm)
    k = jnp.concatenate([k[..., :NOPE_DIM], apply_rope(k[..., NOPE_DIM:], pos)], axis=-1)
    return k, v


def mla_attention(h, k, v, pos, w_dq, q_latent_norm, w_uq, q_norm, w_o):
    B, S, _ = h.shape
    c_q = rms_norm(h @ w_dq, q_latent_norm)
    q = (c_q @ w_uq).reshape(B, S, MLA_HEADS, QK_DIM)
    q = rms_norm(q, q_norm)
    q = jnp.concatenate([q[..., :NOPE_DIM], apply_rope(q[..., NOPE_DIM:], pos)], axis=-1)
    nq = S // QBLK
    qb = jnp.moveaxis(q.reshape(B, nq, QBLK, MLA_HEADS, QK_DIM), 1, 0)
    key_pos = jnp.arange(S)

    def block(args):
        qi, start = args
        s = jnp.einsum('bqhd,bkhd->bhqk', qi, k,
                       preferred_element_type=jnp.float32) * (QK_DIM ** -0.5)
        mask = (start + jnp.arange(QBLK))[:, None] >= key_pos[None, :]
        p = jax.nn.softmax(jnp.where(mask, s, -jnp.inf), axis=-1)
        return jnp.einsum('bhqk,bkhd->bqhd', p.astype(v.dtype), v)

    o = lax.map(block, (qb, jnp.arange(nq) * QBLK))
    o = jnp.moveaxis(o, 0, 1).reshape(B, S, MLA_HEADS * V_DIM)
    return o @ w_o


def swiglu(x, w_gu, w_dn):
    g, u = jnp.split(x @ w_gu, 2, axis=-1)
    return (jax.nn.silu(g) * u) @ w_dn


def routed_experts(xf, idx, wts, w_gu, w_dn):
    N, D = xf.shape
    E = w_gu.shape[0]
    K = idx.shape[1]
    A = N * K
    e = idx.reshape(-1)
    tok = jnp.repeat(jnp.arange(N, dtype=jnp.int32), K)
    w = wts.reshape(-1)
    order = jnp.argsort(e, stable=True)
    e_s, tok_s, w_s = e[order], tok[order], w[order]
    counts = jnp.bincount(e, length=E)
    padded = ((counts + EXPERT_BLOCK - 1) // EXPERT_BLOCK) * EXPERT_BLOCK
    pad_end = jnp.cumsum(padded)
    pad_start = pad_end - padded
    raw_start = jnp.cumsum(counts) - counts
    dest = pad_start[e_s] + jnp.arange(A) - raw_start[e_s]
    nblk = (A + E * (EXPERT_BLOCK - 1) + EXPERT_BLOCK - 1) // EXPERT_BLOCK
    P = nblk * EXPERT_BLOCK
    buf_tok = jnp.full((P,), N, dtype=jnp.int32).at[dest].set(tok_s)
    buf_w = jnp.zeros((P,), jnp.float32).at[dest].set(w_s.astype(jnp.float32))
    blk_e = jnp.minimum(
        jnp.searchsorted(pad_end, jnp.arange(nblk) * EXPERT_BLOCK, side='right'), E - 1)
    x_pad = jnp.concatenate([xf, jnp.zeros((1, D), xf.dtype)], axis=0)

    def step(acc, inp):
        t, wb, ei = inp
        y = swiglu(x_pad[t], w_gu[ei], w_dn[ei])
        return acc.at[t].add(y.astype(jnp.float32) * wb[:, None]), None

    acc, _ = lax.scan(step, jnp.zeros((N + 1, D), jnp.float32),
                      (buf_tok.reshape(nblk, EXPERT_BLOCK), buf_w.reshape(nblk, EXPERT_BLOCK), blk_e))
    return acc[:N].astype(xf.dtype)


def moe_ffn(h, w_router, router_bias, w_gate_up, w_down, shared_gate_up, shared_down):
    B, S, D = h.shape
    xf = h.reshape(-1, D)
    N = xf.shape[0]
    scores = jax.nn.sigmoid(jnp.einsum('nd,de->ne', xf, w_router,
                                       preferred_element_type=jnp.float32))
    sel = scores + router_bias.astype(jnp.float32)
    grp = sel.reshape(N, N_GROUPS, N_EXPERTS // N_GROUPS)
    gscore = jnp.sum(lax.top_k(grp, 2)[0], axis=-1)
    _, gidx = lax.top_k(gscore, TOPK_GROUPS)
    gmask = jnp.sum(jax.nn.one_hot(gidx, N_GROUPS), axis=1) > 0
    emask = jnp.repeat(gmask, N_EXPERTS // N_GROUPS, axis=1)
    _, idx = lax.top_k(jnp.where(emask, sel, -jnp.inf), TOP_K)
    w = jnp.take_along_axis(scores, idx, axis=1)
    w = w / jnp.sum(w, axis=-1, keepdims=True) * ROUTED_SCALE
    routed = routed_experts(xf, idx, w, w_gate_up, w_down)
    shared = swiglu(xf, shared_gate_up, shared_down)
    return (routed + shared).reshape(B, S, D)


def setup_inputs(seed: int = 0) -> dict:
    key = jax.random.key(seed)
    ks = jax.random.split(key, 40)
    ctr = [0]

    def nxt():
        ctr[0] += 1
        return ks[ctr[0] - 1]

    f32 = jnp.float32
    D = D_MODEL
    n_a, n_b = _layer_split()

    def w(shape, fan_in, scale=1.0):
        return jax.random.normal(nxt(), shape, f32) * (scale * fan_in ** -0.5)

    def gain(shape):
        return 1.0 + 0.05 * jax.random.normal(nxt(), shape, f32)

    def small(shape, s):
        return s * jax.random.normal(nxt(), shape, f32)

    x = jax.random.normal(nxt(), (BATCH, SEQ, D), f32)
    c = jax.random.normal(nxt(), (BATCH, D), f32)
    pos = (jnp.arange(SEQ, dtype=jnp.int32)[None, :]
           + jax.random.randint(nxt(), (BATCH, 1), 0, 64, dtype=jnp.int32))
    return {
        'x': x, 'c': c, 'pos': pos,
        'ada_w': w((DEPTH, D, 6 * D), D, 0.5),
        'ada_b': small((DEPTH, 6 * D), 0.05),
        'norm1_g': gain((DEPTH, D)),
        'norm2_g': gain((DEPTH, D)),
        'a_w_qkv': w((n_a, D, 3 * A_HEADS * A_HEAD_DIM), D),
        'a_q_norm': gain((n_a, A_HEAD_DIM)),
        'a_k_norm': gain((n_a, A_HEAD_DIM)),
        'a_w_o': w((n_a, A_HEADS * A_HEAD_DIM, D), A_HEADS * A_HEAD_DIM),
        'kv_ada_w': w((D, 2 * D), D, 0.5),
        'kv_ada_b': small((2 * D,), 0.05),
        'kv_norm_g': gain((D,)),
        'kv_w_down': w((D, KV_RANK + ROPE_DIM), D),
        'kv_latent_norm': gain((KV_RANK,)),
        'kv_w_uk': w((KV_RANK, MLA_HEADS * NOPE_DIM), KV_RANK),
        'kv_w_uv': w((KV_RANK, MLA_HEADS * V_DIM), KV_RANK),
        'kv_k_norm': gain((QK_DIM,)),
        'b_w_dq': w((n_b, D, Q_RANK), D),
        'b_q_latent_norm': gain((n_b, Q_RANK)),
        'b_w_uq': w((n_b, Q_RANK, MLA_HEADS * QK_DIM), Q_RANK),
        'b_q_norm': gain((n_b, QK_DIM)),
        'b_w_o': w((n_b, MLA_HEADS * V_DIM, D), MLA_HEADS * V_DIM),
        'moe_w_router': w((DEPTH, D, N_EXPERTS), D),
        'moe_router_bias': small((DEPTH, N_EXPERTS), 0.01),
        'moe_w_gate_up': w((DEPTH, N_EXPERTS, D, 2 * EXPERT_DIM), D),
        'moe_w_down': w((DEPTH, N_EXPERTS, EXPERT_DIM, D), EXPERT_DIM),
        'moe_shared_gate_up': w((DEPTH, D, 2 * SHARED_DIM), D),
        'moe_shared_down': w((DEPTH, SHARED_DIM, D), SHARED_DIM),
    }


def reference(x, c, pos, ada_w, ada_b, norm1_g, norm2_g, a_w_qkv, a_q_norm, a_k_norm, a_w_o,
              kv_ada_w, kv_ada_b, kv_norm_g, kv_w_down, kv_latent_norm, kv_w_uk, kv_w_uv,
              kv_k_norm, b_w_dq, b_q_latent_norm, b_w_uq, b_q_norm, b_w_o, moe_w_router,
              moe_router_bias, moe_w_gate_up, moe_w_down, moe_shared_gate_up, moe_shared_down):
    n_a, _ = _layer_split()
    cond = jax.nn.silu(c)
    k_sh = None
    v_sh = None
    for l in range(DEPTH):
        mod = cond @ ada_w[l] + ada_b[l]
        sh1, sc1, g1, sh2, sc2, g2 = [m[:, None, :] for m in jnp.split(mod, 6, axis=-1)]
        if l == n_a:
            k_sh, v_sh = shared_kv(x, c, pos, kv_ada_w, kv_ada_b, kv_norm_g, kv_w_down,
                                   kv_latent_norm, kv_w_uk, kv_w_uv, kv_k_norm)
        h = rms_norm(x, norm1_g[l]) * (1.0 + sc1) + sh1
        if l < n_a:
            y = dilated_attention(h, pos, a_w_qkv[l], a_q_norm[l], a_k_norm[l], a_w_o[l])
        else:
            j = l - n_a
            y = mla_attention(h, k_sh, v_sh, pos, b_w_dq[j], b_q_latent_norm[j], b_w_uq[j],
                              b_q_norm[j], b_w_o[j])
        x = x + g1 * y
        h = rms_norm(x, norm2_g[l]) * (1.0 + sc2) + sh2
        x = x + g2 * moe_ffn(h, moe_w_router[l], moe_router_bias[l], moe_w_gate_up[l],
                             moe_w_down[l], moe_shared_gate_up[l], moe_shared_down[l])
    return x
```

```cpp
#include <hip/hip_runtime.h>
#include <stdint.h>
#include <cstdio>
#include <cmath>

typedef unsigned short bf16_t;

constexpr int NB = 8, SEQ = 2048, DM = 1024, NT = NB * SEQ, NH = 16;
constexpr int NE = 64, TOPK = 6, PMAX = 114688  , AROWS = PMAX + NT;
constexpr int MODW = 14336;
constexpr float EPS = 1e-6f;
constexpr float LOG2E = 1.4426950408889634f;
constexpr float C2 = 0.125f * LOG2E;
constexpr float C3 = 0.10206207261596577f * LOG2E;

constexpr size_t MiB = 1u << 20;
constexpr size_t WS_CTL = 0;
constexpr size_t WS_MOD = 1 * MiB;
constexpr size_t WS_TOPI = 2 * MiB;
constexpr size_t WS_TOPW = 2 * MiB + 512 * 1024;
constexpr size_t WS_PPOS = 3 * MiB;
constexpr size_t WS_LTOK = 3 * MiB + 512 * 1024;
constexpr size_t WS_KPSS = 4 * MiB;
constexpr size_t WS_KPR = 4 * MiB + 512 * 1024;
constexpr size_t WS_XN = 8 * MiB;
constexpr size_t WS_XKV = 40 * MiB;
constexpr size_t WS_OB = 72 * MiB;
constexpr size_t WS_X1 = 104 * MiB;
constexpr size_t WS_X2 = 168 * MiB;
constexpr size_t WS_ACT = 232 * MiB;
constexpr size_t WS_YB = 296 * MiB;
constexpr size_t WS_R0 = 552 * MiB;
constexpr size_t WS_QB = WS_R0, WS_KB = WS_R0 + 32 * MiB, WS_VB = WS_R0 + 64 * MiB;
constexpr size_t WS_DKV = WS_R0, WS_DQ = WS_R0 + 16 * MiB, WS_CKV = WS_R0 + 32 * MiB, WS_CQ = WS_R0 + 40 * MiB;
constexpr size_t WS_KM = WS_R0 + 52 * MiB, WS_VM = WS_R0 + 100 * MiB, WS_QR = WS_R0 + 132 * MiB;
constexpr size_t WS_END = 1024 * MiB;

constexpr int CW_ECNT = 1024, CW_EOFF = 1024 + 128, CW_CUR = 1024 + 256;

__device__ __forceinline__ float bf2f(bf16_t v) { return __uint_as_float(((unsigned)v) << 16); }
__device__ __forceinline__ bf16_t f2bf(float f) { unsigned u = __float_as_uint(f); return (bf16_t)((u + 0x7fffu + ((u >> 16) & 1u)) >> 16); }


__device__ __forceinline__ float dppf(float v, const int ctrl_sel) {
    const int iv = __float_as_int(v); int r;
    if (ctrl_sel == 0) r = __builtin_amdgcn_update_dpp(iv, iv, 0xB1, 0xF, 0xF, false);
    else if (ctrl_sel == 1) r = __builtin_amdgcn_update_dpp(iv, iv, 0x4E, 0xF, 0xF, false);
    else if (ctrl_sel == 2) r = __builtin_amdgcn_update_dpp(iv, iv, 0x141, 0xF, 0xF, false);
    else r = __builtin_amdgcn_update_dpp(iv, iv, 0x140, 0xF, 0xF, false);
    return __int_as_float(r);
}
__device__ __forceinline__ float sum_x16(float v) { const auto r = __builtin_amdgcn_permlane16_swap(__float_as_int(v), __float_as_int(v), false, false); return __int_as_float(r[0]) + __int_as_float(r[1]); }
__device__ __forceinline__ float sum_x32(float v) { const auto r = __builtin_amdgcn_permlane32_swap(__float_as_int(v), __float_as_int(v), false, false); return __int_as_float(r[0]) + __int_as_float(r[1]); }
__device__ __forceinline__ float max_x16(float v) { const auto r = __builtin_amdgcn_permlane16_swap(__float_as_int(v), __float_as_int(v), false, false); return fmaxf(__int_as_float(r[0]), __int_as_float(r[1])); }
__device__ __forceinline__ float max_x32(float v) { const auto r = __builtin_amdgcn_permlane32_swap(__float_as_int(v), __float_as_int(v), false, false); return fmaxf(__int_as_float(r[0]), __int_as_float(r[1])); }
__device__ __forceinline__ float wave_sum_all(float v) { v += dppf(v, 0); v += dppf(v, 1); v += dppf(v, 2); v += dppf(v, 3); v = sum_x16(v); return sum_x32(v); }
__device__ __forceinline__ float wave_max_all(float v) { v = fmaxf(v, dppf(v, 0)); v = fmaxf(v, dppf(v, 1)); v = fmaxf(v, dppf(v, 2)); v = fmaxf(v, dppf(v, 3)); v = max_x16(v); return max_x32(v); }
__device__ __forceinline__ float max8(float v) { v = fmaxf(v, dppf(v, 0)); v = fmaxf(v, dppf(v, 1)); return fmaxf(v, dppf(v, 2)); }

namespace nv {
__device__ __forceinline__ void route_lane(float score, float bias, int lane, bool& sel, int& jrank, float& w) {
    const float s = score + bias;
    const int g = lane >> 3;
    const float m1 = max8(s);
    unsigned long long bal = __ballot(s == m1);
    const unsigned gm = (unsigned)(bal >> (g * 8)) & 0xffu;
    const int first = __ffs(gm) - 1;
    const float m2 = max8(((lane & 7) == first) ? -INFINITY : s);
    const float gs = m1 + m2;
    int rank = 0;
#pragma unroll
    for (int gg = 0; gg < 8; ++gg) { const float o = __int_as_float(__builtin_amdgcn_readlane(__float_as_int(gs), gg * 8)); rank += ((o > gs) || (o == gs && gg < g)) ? 1 : 0; }
    float v = (rank < 4) ? s : -INFINITY;
    sel = false; jrank = -1;
#pragma unroll
    for (int it = 0; it < TOPK; ++it) {
        const float mx = wave_max_all(v);
        bal = __ballot(v == mx);
        const int f = __ffsll((long long)bal) - 1;
        if (lane == f) { sel = true; jrank = it; v = -INFINITY; }
    }
    const float ssum = wave_sum_all(sel ? score : 0.f);
    w = sel ? score / ssum * 2.5f : 0.f;
}

}

constexpr size_t WS_WQKV = 748 * MiB;
constexpr size_t WS_WO0 = WS_WQKV + 6 * MiB;
constexpr size_t WS_WO1 = WS_WO0 + 2 * MiB;
constexpr size_t WS_WKVD = WS_WO1 + 2 * MiB;
constexpr size_t WS_WDQ = WS_WKVD + 1 * MiB;
constexpr size_t WS_WUKV = WS_WDQ + 1 * MiB;
constexpr size_t WS_WUQ = WS_WUKV + 1 * MiB;
constexpr size_t WS_WR = WS_WUQ + 1536 * 1024;
constexpr size_t WS_WGU = WS_WR + 512 * 1024;
constexpr size_t WS_WDN = WS_WGU + 130 * MiB;
constexpr size_t WS_FAST_END = WS_WDN + 65 * MiB;
static_assert(WS_FAST_END <= WS_END, "d_ws map");
constexpr size_t WS_PART = WS_R0 + 96 * MiB;
constexpr size_t WS_LSE = WS_R0 + 192 * MiB;
constexpr size_t WS_LT2 = 960 * MiB;
constexpr size_t WS_ROPE = 964 * MiB;
constexpr size_t WS_W8 = 968 * MiB;
constexpr size_t WS_PB = 984 * MiB;
constexpr size_t WS_CB = 985 * MiB;
constexpr size_t WS_RSTD = 986 * MiB;
constexpr size_t WS_SSQ = 988 * MiB;
constexpr size_t WS_DUMP = 987 * MiB;
constexpr int CW_ECNTF = 2048;

#define GAS __attribute__((address_space(1)))
#define LAS __attribute__((address_space(3)))
typedef short bf16x8 __attribute__((ext_vector_type(8)));
typedef float f32x4 __attribute__((ext_vector_type(4)));
typedef float f32x2 __attribute__((ext_vector_type(2)));
typedef unsigned u32x4 __attribute__((ext_vector_type(4)));
typedef unsigned u32x2 __attribute__((ext_vector_type(2)));

__device__ __forceinline__ unsigned pk2(float lo, float hi) { return (unsigned)f2bf(lo) | ((unsigned)f2bf(hi) << 16); }
__device__ __forceinline__ unsigned cvt_pk_bf16(float lo, float hi) { unsigned r; asm volatile("v_cvt_pk_bf16_f32 %0, %1, %2" : "=v"(r) : "v"(lo), "v"(hi)); return r; }

namespace pg8 {
constexpr int BM = 256, BK = 64, HALF = 128, HTB = HALF * BK * 2, STAGE_BYTES = 8 * HTB, NXCD = 8, WGM = 8;
__host__ __device__ __forceinline__ int lds_byte(int r, int c) { const int st = (r >> 4) * 2 + (c >> 5), rr = r & 15, cc = c & 31, ob = rr * 64 + cc * 2; return st * 1024 + (ob ^ (((ob >> 9) & 1) << 5)); }
__host__ __device__ __forceinline__ void stage_rc(int b, int& R, int& C) { const int st = b / 1024, sb = b % 1024, swz = sb ^ (((sb >> 9) & 1) << 5); R = (st >> 1) * 16 + swz / 64; C = (st & 1) * 32 + (swz % 64) / 2; }
__host__ __device__ __forceinline__ int perm32(int rho) { const int n = rho >> 4, i = rho & 15; return 8 * (i >> 2) + 4 * n + (i & 3); }

struct Unit { int rowbase; int pn; int aux; int aux2; };

template <class Epi, class Sched, bool ALIGN_EPI>
__device__ __forceinline__ void gemm_phase(LAS unsigned char* lds, const char* Abase, const int K, const Sched& S, const Epi& E, const int abl = 0, const int lda_ = 0) {
    int tid_ = threadIdx.x; asm volatile("" : "+v"(tid_));
    const int tid = tid_, wid = __builtin_amdgcn_readfirstlane(tid >> 6), lane = tid & 63, wr = wid >> 2, wc = wid & 3, fr = lane & 15, fq = lane >> 4;
    const int nt = K / BK;
    int Rr[2]; unsigned Cb[2], voffB[2], lo[2];
#pragma unroll
    for (int i = 0; i < 2; ++i) { int R, C; stage_rc(tid * 16 + i * 8192, R, C); const int Rb = Epi::PERM ? ((R & ~31) + perm32(R & 31)) : R;
        Rr[i] = R; Cb[i] = (unsigned)C * 2u; voffB[i] = (unsigned)(Rb * K + C) * 2u; lo[i] = (unsigned)(R * (lda_ ? lda_ : K) + C) * 2u; }
    const size_t kstep = (size_t)(BK * 2);
    const size_t hstepB = (size_t)HALF * K * 2, hstepA = (size_t)HALF * (lda_ ? lda_ : K) * 2;
    const unsigned ldsw = (unsigned)wid * 1024u;
    const int aoff = lds_byte(wr * 64 + fr, fq * 8), boff = lds_byte(wc * 32 + fr, fq * 8);
#define PG8_SA(b, h) (((b) * 2 + (h)) * HTB)
#define PG8_SB(b, h) ((4 + (b) * 2 + (h)) * HTB)
#define PG8_STAGE_B(bufoff, gbase) do { if (!(abl & 4)) _Pragma("unroll") for (int _i = 0; _i < 2; ++_i) \
        __builtin_amdgcn_global_load_lds((const unsigned*)((const char*)(gbase) + voffB[_i]), (LAS unsigned*)(lds + (bufoff) + ldsw + _i * 8192), 16, 0, 0); } while (0)
#define PG8_STAGE_A(bufoff, h, nx, kb) do { if (abl & 4) break; unsigned _o0, _o1; const char* _b; \
        if constexpr (Sched::GATHER) { _b = Abase + (size_t)(kb); _o0 = (nx) ? ((h) ? an10 : an00) : ((h) ? ac10 : ac00); _o1 = (nx) ? ((h) ? an11 : an01) : ((h) ? ac11 : ac01); } \
        else { _b = Abase + (size_t)(kb) + ((nx) ? nU : cU) + ((h) ? hstepA : (size_t)0); _o0 = lo[0]; _o1 = lo[1]; } \
        __builtin_amdgcn_global_load_lds((const unsigned*)(_b + _o0), (LAS unsigned*)(lds + (bufoff) + ldsw), 16, 0, 0); \
        __builtin_amdgcn_global_load_lds((const unsigned*)(_b + _o1), (LAS unsigned*)(lds + (bufoff) + ldsw + 8192), 16, 0, 0); } while (0)
#define PG8_LDA(dst, b, h) do { _Pragma("unroll") for (int m = 0; m < 4; ++m) _Pragma("unroll") for (int k = 0; k < 2; ++k) dst[m][k] = *(const LAS bf16x8*)(lds + PG8_SA(b, h) + aoff + m * 2048 + k * 1024); } while (0)
#define PG8_LDB(dst, b, h) do { _Pragma("unroll") for (int n = 0; n < 2; ++n) _Pragma("unroll") for (int k = 0; k < 2; ++k) dst[n][k] = *(const LAS bf16x8*)(lds + PG8_SB(b, h) + boff + n * 2048 + k * 1024); } while (0)
#define PG8_MMA(ai, bj, At, Bt) do { if (abl & 2) break; __builtin_amdgcn_s_setprio(1); _Pragma("unroll") for (int m = 0; m < 4; ++m) _Pragma("unroll") for (int n = 0; n < 2; ++n) _Pragma("unroll") for (int k = 0; k < 2; ++k) \
        acc[ai][bj][m][n] = __builtin_amdgcn_mfma_f32_16x16x32_bf16(Bt[n][k], At[m][k], acc[ai][bj][m][n], 0, 0, 0); __builtin_amdgcn_s_setprio(0); } while (0)
#define PG8_WAIT_V(n) asm volatile("s_waitcnt vmcnt(" #n ")" ::: "memory")
#define PG8_WAIT_L(n) asm volatile("s_waitcnt lgkmcnt(" #n ")" ::: "memory")
#define PG8_WAIT_VN(n) do { static_assert(Epi::NSTORE == 0 || Epi::NSTORE == 8, "relaxed wait count"); asm volatile("s_waitcnt vmcnt(" #n ")" ::: "memory"); } while (0)
#define PG8_BAR __builtin_amdgcn_s_barrier()
#define PG8_SCHED __builtin_amdgcn_sched_barrier(0)
    Unit cur, nxt; int ui = 0;
    if (!S.next(0, cur)) return;
    f32x4 acc[2][2][4][2];
#pragma unroll
    for (int a = 0; a < 2; ++a)
#pragma unroll
        for (int b = 0; b < 2; ++b)
#pragma unroll
            for (int m = 0; m < 4; ++m)
#pragma unroll
                for (int n = 0; n < 2; ++n) acc[a][b][m][n] = (f32x4){0.f, 0.f, 0.f, 0.f};
    bf16x8 At[4][2], B0[2][2], B1[2][2];
    unsigned ac00 = 0, ac01 = 0, ac10 = 0, ac11 = 0, an00 = 0, an01 = 0, an10 = 0, an11 = 0; size_t cU = 0, nU = 0;
    if constexpr (Sched::GATHER) { ac00 = S.a_off(cur, Rr[0]) + Cb[0]; ac01 = S.a_off(cur, Rr[1]) + Cb[1]; ac10 = S.a_off(cur, HALF + Rr[0]) + Cb[0]; ac11 = S.a_off(cur, HALF + Rr[1]) + Cb[1]; }
    else cU = S.a_uni(cur);
    const char* cB = S.b_base(cur);
    PG8_STAGE_B(PG8_SB(0, 0), cB); PG8_STAGE_B(PG8_SB(0, 1), cB + hstepB); PG8_STAGE_A(PG8_SA(0, 0), 0, false, 0); PG8_STAGE_A(PG8_SA(0, 1), 1, false, 0);
    if (wr == 1) PG8_BAR;
    PG8_WAIT_V(2); PG8_BAR;
    PG8_STAGE_B(PG8_SB(1, 0), cB + kstep); PG8_STAGE_A(PG8_SA(1, 0), 0, false, kstep); PG8_STAGE_B(PG8_SB(1, 1), cB + hstepB + kstep);
    PG8_WAIT_V(6); PG8_BAR;
    for (;;) {
        const bool has_next = S.next(ui + 1, nxt);
        const char* nB = cB;
        if (has_next) {
            if constexpr (Sched::GATHER) { an00 = S.a_off(nxt, Rr[0]) + Cb[0]; an01 = S.a_off(nxt, Rr[1]) + Cb[1]; an10 = S.a_off(nxt, HALF + Rr[0]) + Cb[0]; an11 = S.a_off(nxt, HALF + Rr[1]) + Cb[1]; }
            else nU = S.a_uni(nxt);
            nB = S.b_base(nxt);
        } else { an00 = ac00; an01 = ac01; an10 = ac10; an11 = ac11; nU = cU; }
#pragma unroll 1
        for (int t = 0; t < nt; t += 2) {
            const bool last = (t == nt - 2);
            const size_t k1 = (size_t)(t + 1) * kstep;
            const size_t k2 = last ? (size_t)0 : (size_t)(t + 2) * kstep;
            const char* b2 = last ? nB : cB + (size_t)(t + 2) * kstep; const char* b3 = b2 + kstep;
            const bool relax = (Epi::NSTORE > 0) && (t == 0) && (ui > 0);
            PG8_LDB(B0, 0, 0); PG8_LDB(B1, 0, 1); PG8_SCHED; PG8_LDA(At, 0, 0); PG8_STAGE_A(PG8_SA(1, 1), 1, false, k1);
            if (relax) PG8_WAIT_VN(16); else PG8_WAIT_V(8);
            PG8_WAIT_L(0); PG8_BAR; PG8_MMA(0, 0, At, B0); PG8_MMA(0, 1, At, B1); PG8_BAR; PG8_SCHED;
            PG8_LDA(At, 0, 1); PG8_STAGE_B(PG8_SB(0, 0), b2); PG8_STAGE_B(PG8_SB(0, 1), b2 + hstepB); PG8_STAGE_A(PG8_SA(0, 0), 0, last, k2);
            if (relax) PG8_WAIT_VN(16); else PG8_WAIT_V(8);
            PG8_WAIT_L(0); PG8_BAR; PG8_MMA(1, 0, At, B0); PG8_MMA(1, 1, At, B1); PG8_BAR; PG8_SCHED;
            PG8_LDB(B0, 1, 0); PG8_LDB(B1, 1, 1); PG8_SCHED; PG8_LDA(At, 1, 0); PG8_STAGE_A(PG8_SA(0, 1), 1, last, k2);
            PG8_WAIT_V(8); PG8_WAIT_L(0); PG8_BAR; PG8_MMA(0, 0, At, B0); PG8_MMA(0, 1, At, B1); PG8_BAR; PG8_SCHED;
            PG8_LDA(At, 1, 1); PG8_STAGE_B(PG8_SB(1, 0), b3); PG8_STAGE_B(PG8_SB(1, 1), b3 + hstepB); PG8_STAGE_A(PG8_SA(1, 0), 0, last, k2 + kstep);
            PG8_WAIT_V(8); PG8_WAIT_L(0); PG8_BAR; PG8_MMA(1, 0, At, B0); PG8_MMA(1, 1, At, B1); PG8_BAR; PG8_SCHED;
        }
        if constexpr (ALIGN_EPI) { if (wr == 0) PG8_BAR; }
        { int fr_e = fr, fq_e = fq; asm volatile("" : "+v"(fr_e), "+v"(fq_e));
          if (!(abl & 1)) E(acc, cur, wr, wc, fr_e, fq_e); }
        if (!has_next) break;
#pragma unroll
        for (int a = 0; a < 2; ++a)
#pragma unroll
            for (int b = 0; b < 2; ++b)
#pragma unroll
                for (int m = 0; m < 4; ++m)
#pragma unroll
                    for (int n = 0; n < 2; ++n) acc[a][b][m][n] = (f32x4){0.f, 0.f, 0.f, 0.f};
        cur = nxt; cB = nB; ac00 = an00; ac01 = an01; ac10 = an10; ac11 = an11; cU = nU; ++ui;
        if constexpr (ALIGN_EPI) { if (wr == 1) PG8_BAR; }
    }
    PG8_WAIT_V(0);
    if constexpr (!ALIGN_EPI) { if (wr == 0) PG8_BAR; }
    PG8_BAR;
#undef PG8_SA
#undef PG8_SB
#undef PG8_STAGE_A
#undef PG8_STAGE_B
#undef PG8_LDA
#undef PG8_LDB
#undef PG8_MMA
#undef PG8_WAIT_V
#undef PG8_WAIT_L
#undef PG8_WAIT_VN
#undef PG8_BAR
#undef PG8_SCHED
}

struct DenseSched {
    static constexpr bool GATHER = false;
    int nN, nwg, G, c, K, lda; unsigned a0; const char* Bt;
    __device__ __forceinline__ void init(int N, int K_, int G_, int c_, unsigned a0_, const void* Bt_, int lda_ = 0) { nN = N / BM; nwg = (NT / BM) * nN; G = G_; c = c_; K = K_; lda = lda_ ? lda_ : K_; a0 = a0_; Bt = (const char*)Bt_; }
    __device__ __forceinline__ bool next(int i, Unit& u) const {
        const int L = i * G + c; if (L >= nwg) return false;
        int wgid = L; { const int q = nwg / NXCD, r = nwg % NXCD, xcd = wgid % NXCD, off = wgid / NXCD; wgid = (xcd < r ? xcd * (q + 1) : r * (q + 1) + (xcd - r) * q) + off; }
        const int nM = NT / BM, nig = WGM * nN, gid = wgid / nig, fm = gid * WGM, gsz = (nM - fm) < WGM ? (nM - fm) : WGM;
        u.rowbase = (fm + ((wgid % nig) % gsz)) * BM; u.pn = (wgid % nig) / gsz; u.aux = 0; u.aux2 = 0; return true;
    }
    __device__ __forceinline__ size_t a_uni(const Unit& u) const { return (size_t)a0 + (size_t)u.rowbase * (size_t)(lda * 2); }
    __device__ __forceinline__ unsigned a_off(const Unit& u, int r) const { return 0u; }
    __device__ __forceinline__ const char* b_base(const Unit& u) const { return Bt + (size_t)u.pn * BM * K * 2; }
};

struct EpiQKV {
    static constexpr int NSTORE = 0;
    static constexpr bool PERM = true;
    bf16_t *Q; const float *qg, *kg;
    __device__ __forceinline__ void operator()(const f32x4 (&acc)[2][2][4][2], const Unit& u, int wr, int wc, int fr, int fq) const {
        const int part = u.pn >> 2, head = (u.pn & 3) * 4 + wc;
        bf16_t* out = Q + (size_t)part * (size_t)(16 * 1024 * 1024) + head * 64 + 8 * fq;
        f32x4 g[2][2];
#pragma unroll
        for (int bj = 0; bj < 2; ++bj)
#pragma unroll
            for (int n = 0; n < 2; ++n) g[bj][n] = (f32x4){1.f, 1.f, 1.f, 1.f};
        if (part < 2) { const float* gp = (part ? kg : qg) + 8 * fq;
#pragma unroll
            for (int bj = 0; bj < 2; ++bj)
#pragma unroll
                for (int n = 0; n < 2; ++n) g[bj][n] = *(const f32x4*)(gp + 32 * bj + 4 * n); }
        const float rscale = (part == 0) ? C2 : 1.f;
#pragma unroll
        for (int ai = 0; ai < 2; ++ai)
#pragma unroll
            for (int m = 0; m < 4; ++m) {
                const int row = u.rowbase + ai * HALF + wr * 64 + m * 16 + fr;
                f32x4 v[2][2];
#pragma unroll
                for (int bj = 0; bj < 2; ++bj)
#pragma unroll
                    for (int n = 0; n < 2; ++n) v[bj][n] = acc[ai][bj][m][n];
                float ss = 0.f;
#pragma unroll
                for (int bj = 0; bj < 2; ++bj)
#pragma unroll
                    for (int n = 0; n < 2; ++n) { const f32x4 x = v[bj][n]; ss += (x[0] * x[0] + x[1] * x[1]) + (x[2] * x[2] + x[3] * x[3]); }
                ss = sum_x16(ss); ss = sum_x32(ss);
                const float r = (part < 2) ? rsqrtf(ss * (1.f / 64.f) + EPS) * rscale : 1.f;
#pragma unroll
                for (int bj = 0; bj < 2; ++bj)
#pragma unroll
                    for (int n = 0; n < 2; ++n) v[bj][n] = v[bj][n] * r * g[bj][n];
#pragma unroll
                for (int bj = 0; bj < 2; ++bj) { u32x4 w; w.x = cvt_pk_bf16(v[bj][0][0], v[bj][0][1]); w.y = cvt_pk_bf16(v[bj][0][2], v[bj][0][3]); w.z = cvt_pk_bf16(v[bj][1][0], v[bj][1][1]); w.w = cvt_pk_bf16(v[bj][1][2], v[bj][1][3]);
                    *(u32x4*)(out + (size_t)row * 1024 + 32 * bj) = w; }
            }
    }
};

struct DualSched {
    static constexpr bool GATHER = false;
    int G, c; unsigned a0; const char* Bt;
    __device__ __forceinline__ bool next(int i, Unit& u) const {
        const int L = i * G + c; if (L >= 256) return false;
        const int w = L >> 7, idx = L & 127;
        u.rowbase = (idx >> 1) * BM; u.pn = idx & 1; u.aux = w; u.aux2 = 0; return true;
    }
    __device__ __forceinline__ size_t a_uni(const Unit& u) const { return (size_t)a0 + (size_t)u.rowbase * 2048; }
    __device__ __forceinline__ unsigned a_off(const Unit& u, int r) const { return 0u; }
    __device__ __forceinline__ const char* b_base(const Unit& u) const { return Bt + ((size_t)(u.aux * 8 + (u.rowbase >> 11)) * 512 + (size_t)u.pn * BM) * 1024 * 2; }
};

template <int NTILE, bool GATHER_>
struct MoeSched {
    static constexpr bool GATHER = GATHER_;
    const LAS int* tab;
    const int* LT2; int G, c, K; unsigned a0; const char* Bt;
    __device__ __forceinline__ bool next(int i, Unit& u) const {
        const int L = i * G + c;
        const int nrb = tab[64] >> 8;
        if (L >= (nrb + 64) * NTILE) return false;
        const int blk = L / NTILE; u.pn = L % NTILE;
        if (blk < nrb) {
            const int row0 = blk << 8, lane = threadIdx.x & 63;
            const unsigned long long bal = __ballot(tab[lane] <= row0);
            const int e = __builtin_popcountll(bal) - 1;
            u.rowbase = row0; u.aux = e; u.aux2 = row0 - tab[e];
        } else { u.rowbase = PMAX + ((blk - nrb) << 8); u.aux = 64; u.aux2 = (blk - nrb) << 8; }
        return true;
    }
    __device__ __forceinline__ size_t a_uni(const Unit& u) const { return (size_t)a0 + (size_t)u.rowbase * (size_t)(K * 2); }
    __device__ __forceinline__ unsigned a_off(const Unit& u, int r) const {
        int tok;
        if (u.aux < 64) { const int idx = u.aux2 + r; tok = 0; if (idx < tab[128 + u.aux]) tok = LT2[u.aux * 16384 + idx]; }
        else tok = u.aux2 + r;
        return a0 + (unsigned)tok * 2048u;
    }
    __device__ __forceinline__ const char* b_base(const Unit& u) const { return Bt + ((size_t)u.aux * NTILE + u.pn) * BM * K * 2; }
};

template <bool XBF>
struct EpiResid {
    static constexpr int NSTORE = 0;
    static constexpr bool PERM = true;
    const void* xin; const float* MOD; int gate_off; bf16_t* out;
    __device__ __forceinline__ void operator()(const f32x4 (&acc)[2][2][4][2], const Unit& u, int wr, int wc, int fr, int fq) const {
        const int b = u.rowbase >> 11, col0 = u.pn * BM + wc * 32 + 8 * fq;
        f32x4 gt[2][2];
#pragma unroll
        for (int bj = 0; bj < 2; ++bj)
#pragma unroll
            for (int n = 0; n < 2; ++n) gt[bj][n] = *(const f32x4*)(MOD + b * MODW + gate_off + col0 + bj * HALF + n * 4);
#pragma unroll
        for (int ai = 0; ai < 2; ++ai)
#pragma unroll
            for (int m = 0; m < 4; ++m) { const size_t off = (size_t)(u.rowbase + ai * HALF + wr * 64 + m * 16 + fr) * 1024 + col0;
#pragma unroll
                for (int bj = 0; bj < 2; ++bj) {
                    f32x4 x0, x1;
                    if (XBF) { const u32x4 xw = *(const u32x4*)((const bf16_t*)xin + off + bj * HALF);
                        x0 = (f32x4){__uint_as_float(xw.x << 16), __uint_as_float(xw.x & 0xffff0000u), __uint_as_float(xw.y << 16), __uint_as_float(xw.y & 0xffff0000u)};
                        x1 = (f32x4){__uint_as_float(xw.z << 16), __uint_as_float(xw.z & 0xffff0000u), __uint_as_float(xw.w << 16), __uint_as_float(xw.w & 0xffff0000u)}; }
                    else { x0 = *(const f32x4*)((const float*)xin + off + bj * HALF); x1 = *(const f32x4*)((const float*)xin + off + bj * HALF + 4); }
                    const f32x4 v0 = x0 + gt[bj][0] * acc[ai][bj][m][0], v1 = x1 + gt[bj][1] * acc[ai][bj][m][1];
                    u32x4 w; w.x = cvt_pk_bf16(v0[0], v0[1]); w.y = cvt_pk_bf16(v0[2], v0[3]); w.z = cvt_pk_bf16(v1[0], v1[1]); w.w = cvt_pk_bf16(v1[2], v1[3]);
                    *(u32x4*)(out + off + bj * HALF) = w; } }
    }
};
struct EpiBf16 {
    static constexpr int NSTORE = 0;
    static constexpr bool PERM = true;
    bf16_t* O; int ldo; size_t sel_stride; const LAS int* tab;
    __device__ __forceinline__ void operator()(const f32x4 (&acc)[2][2][4][2], const Unit& u, int wr, int wc, int fr, int fq) const {
        bf16_t* base = O + (size_t)u.aux * sel_stride + u.pn * BM + wc * 32 + 8 * fq;
        const int nvalid = (tab && u.aux < 64) ? tab[128 + u.aux] - u.aux2 : 256;
#pragma unroll
        for (int ai = 0; ai < 2; ++ai)
#pragma unroll
            for (int m = 0; m < 4; ++m) { const int lr = ai * HALF + wr * 64 + m * 16 + fr; if (lr >= nvalid) continue; bf16_t* rowp = base + (size_t)(u.rowbase + lr) * ldo;
#pragma unroll
                for (int bj = 0; bj < 2; ++bj) { const f32x4 v0 = acc[ai][bj][m][0], v1 = acc[ai][bj][m][1];
                    u32x4 w; w.x = cvt_pk_bf16(v0[0], v0[1]); w.y = cvt_pk_bf16(v0[2], v0[3]); w.z = cvt_pk_bf16(v1[0], v1[1]); w.w = cvt_pk_bf16(v1[2], v1[3]);
                    *(u32x4*)(rowp + bj * HALF) = w; } }
    }
};
struct EpiDown {
    static constexpr int NSTORE = 0;
    static constexpr bool PERM = true, DEFER = false;
    bf16_t* O; const float* RSTD; const float* CB; float* SSQ; float* KPSS; float* KPR; const float* ROPE; const float* gk;
    __device__ __forceinline__ void operator()(const f32x4 (&acc)[2][2][4][2], const Unit& u, int wr, int wc, int fr, int fq) const {
        const int col0 = u.pn * BM + wc * 32 + 8 * fq;
        bf16_t* base = O + (size_t)u.aux * (size_t)(8 * 1024 * 1024) + col0;
        const float* cb = CB + ((u.rowbase >> 11) * 2 + u.aux) * 512 + col0;
        f32x4 bs[2][2];
#pragma unroll
        for (int bj = 0; bj < 2; ++bj)
#pragma unroll
            for (int n = 0; n < 2; ++n) bs[bj][n] = *(const f32x4*)(cb + bj * HALF + n * 4);
        const bool ropew = (u.aux == 0) && (u.pn == 1) && (wc == 0);
        f32x4 g0 = (f32x4){0.f, 0.f, 0.f, 0.f}, g1 = g0;
        if (ropew) { g0 = *(const f32x4*)(gk + 64 + 8 * fq); g1 = *(const f32x4*)(gk + 64 + 8 * fq + 4); }
#pragma unroll
        for (int ai = 0; ai < 2; ++ai)
#pragma unroll
            for (int m = 0; m < 4; ++m) { const int row = u.rowbase + ai * HALF + wr * 64 + m * 16 + fr; const float r = RSTD[row]; bf16_t* rowp = base + (size_t)row * 512;
                f32x4 v[2][2];
#pragma unroll
                for (int bj = 0; bj < 2; ++bj) { v[bj][0] = acc[ai][bj][m][0] * r + bs[bj][0]; v[bj][1] = acc[ai][bj][m][1] * r + bs[bj][1];
                    u32x4 w; w.x = cvt_pk_bf16(v[bj][0][0], v[bj][0][1]); w.y = cvt_pk_bf16(v[bj][0][2], v[bj][0][3]); w.z = cvt_pk_bf16(v[bj][1][0], v[bj][1][1]); w.w = cvt_pk_bf16(v[bj][1][2], v[bj][1][3]);
                    *(u32x4*)(rowp + bj * HALF) = w; }
                float ss = ((v[0][0][0] * v[0][0][0] + v[0][0][1] * v[0][0][1]) + (v[0][0][2] * v[0][0][2] + v[0][0][3] * v[0][0][3])) + ((v[0][1][0] * v[0][1][0] + v[0][1][1] * v[0][1][1]) + (v[0][1][2] * v[0][1][2] + v[0][1][3] * v[0][1][3]));
                if (u.pn == 0) ss += ((v[1][0][0] * v[1][0][0] + v[1][0][1] * v[1][0][1]) + (v[1][0][2] * v[1][0][2] + v[1][0][3] * v[1][0][3])) + ((v[1][1][0] * v[1][1][0] + v[1][1][1] * v[1][1][1]) + (v[1][1][2] * v[1][1][2] + v[1][1][3] * v[1][1][3]));
                ss = sum_x16(ss); ss = sum_x32(ss);
                if (!(u.aux == 0 && u.pn == 1)) { if (fq == 0) SSQ[(size_t)row * 16 + u.aux * 8 + u.pn * 4 + wc] = ss; }
                else if (ropew) {
                    if (fq == 0) KPSS[row] = ss;
                    const f32x4 kg0 = v[0][0] * g0, kg1 = v[0][1] * g1;
                    f32x4 kx0, kx1;
#pragma unroll
                    for (int j = 0; j < 4; ++j) {
                        const auto a = __builtin_amdgcn_permlane32_swap(__float_as_int(kg0[j]), __float_as_int(kg0[j]), false, false);
                        const auto b = __builtin_amdgcn_permlane32_swap(__float_as_int(kg1[j]), __float_as_int(kg1[j]), false, false);
                        kx0[j] = (fq & 2) ? __int_as_float(a[0]) : __int_as_float(a[1]); kx1[j] = (fq & 2) ? __int_as_float(b[0]) : __int_as_float(b[1]); }
                    const float* cp = ROPE + (size_t)row * 16 + 8 * (fq & 1); const float* sp = cp + (size_t)NT * 16;
                    const f32x4 c0 = *(const f32x4*)cp, c1 = *(const f32x4*)(cp + 4), s0 = *(const f32x4*)sp, s1 = *(const f32x4*)(sp + 4);
                    const float sg = (fq & 2) ? 1.f : -1.f;
                    *(f32x4*)(KPR + (size_t)row * 32 + 8 * fq) = kg0 * c0 + kx0 * s0 * sg;
                    *(f32x4*)(KPR + (size_t)row * 32 + 8 * fq + 4) = kg1 * c1 + kx1 * s1 * sg;
                } }
    }
};
struct EpiQ {
    static constexpr int NSTORE = 0;
    static constexpr bool PERM = true, DEFER = false;
    bf16_t* O; const float* SSQ;
    __device__ __forceinline__ void operator()(const f32x4 (&acc)[2][2][4][2], const Unit& u, int wr, int wc, int fr, int fq) const {
        bf16_t* base = O + u.pn * BM + wc * 32 + 8 * fq;
#pragma unroll
        for (int ai = 0; ai < 2; ++ai)
#pragma unroll
            for (int m = 0; m < 4; ++m) { const int row = u.rowbase + ai * HALF + wr * 64 + m * 16 + fr; bf16_t* rowp = base + (size_t)row * 1536;
                const f32x4 sa = *(const f32x4*)(SSQ + (size_t)row * 16 + 8), sb = *(const f32x4*)(SSQ + (size_t)row * 16 + 12);
                const float r = rsqrtf((((sa[0] + sa[1]) + (sa[2] + sa[3])) + ((sb[0] + sb[1]) + (sb[2] + sb[3]))) * (1.f / 384.f) + EPS);
#pragma unroll
                for (int bj = 0; bj < 2; ++bj) { const f32x4 v0 = acc[ai][bj][m][0] * r, v1 = acc[ai][bj][m][1] * r;
                    u32x4 w; w.x = cvt_pk_bf16(v0[0], v0[1]); w.y = cvt_pk_bf16(v0[2], v0[3]); w.z = cvt_pk_bf16(v1[0], v1[1]); w.w = cvt_pk_bf16(v1[2], v1[3]);
                    *(u32x4*)(rowp + bj * HALF) = w; } }
    }
};
constexpr float YB_SCALE = 8.f, YB_CLAMP = 440.f;
struct EpiYB {
    static constexpr bool PERM = true; static constexpr int NSTORE = 8;
    unsigned char* O; const LAS int* tab; unsigned char* dump;
    __device__ __forceinline__ void operator()(const f32x4 (&acc)[2][2][4][2], const Unit& u, int wr, int wc, int fr, int fq) const {
        unsigned char* base = O + u.pn * BM + wc * 64 + 16 * fq;
        unsigned char* dp = dump + (wr * 256 + wc * 64 + fq * 16 + fr) * 16;
        const int nvalid = (u.aux < 64) ? tab[128 + u.aux] - u.aux2 : 256;
#pragma unroll
        for (int ai = 0; ai < 2; ++ai)
#pragma unroll
            for (int m = 0; m < 4; ++m) { const int lr = ai * HALF + wr * 64 + m * 16 + fr;
                int w[4];
#pragma unroll
                for (int bj = 0; bj < 2; ++bj)
#pragma unroll
                    for (int n = 0; n < 2; ++n) { f32x4 v = acc[ai][bj][m][n] * YB_SCALE;
#pragma unroll
                        for (int j = 0; j < 4; ++j) v[j] = __builtin_amdgcn_fmed3f(v[j], -YB_CLAMP, YB_CLAMP);
                        int q = 0; q = __builtin_amdgcn_cvt_pk_fp8_f32(v[0], v[1], q, false); q = __builtin_amdgcn_cvt_pk_fp8_f32(v[2], v[3], q, true); w[bj * 2 + n] = q; }
                u32x4 o; o.x = (unsigned)w[0]; o.y = (unsigned)w[1]; o.z = (unsigned)w[2]; o.w = (unsigned)w[3];
                unsigned char* a_ = (lr < nvalid) ? base + (size_t)(u.rowbase + lr) * 1024 : dp;
                *(GAS u32x4*)a_ = o; }
    }
};
struct EpiSwiglu {
    static constexpr int NSTORE = 0;
    static constexpr bool PERM = true;
    bf16_t* ACT; const LAS int* tab;
    __device__ __forceinline__ void operator()(const f32x4 (&acc)[2][2][4][2], const Unit& u, int wr, int wc, int fr, int fq) const {
        bf16_t* base = ACT + u.pn * 128 + wc * 32 + 8 * fq;
        const int nvalid = (u.aux < 64) ? tab[128 + u.aux] - u.aux2 : 256;
#pragma unroll
        for (int ai = 0; ai < 2; ++ai)
#pragma unroll
            for (int m = 0; m < 4; ++m) { const int lr = ai * HALF + wr * 64 + m * 16 + fr; if (lr >= nvalid) continue; bf16_t* rowp = base + (size_t)(u.rowbase + lr) * 256;
                f32x4 a[2];
#pragma unroll
                for (int n = 0; n < 2; ++n) { const f32x4 g = acc[ai][0][m][n], uu = acc[ai][1][m][n];
#pragma unroll
                    for (int j = 0; j < 4; ++j) a[n][j] = g[j] * __builtin_amdgcn_rcpf(1.f + __expf(-g[j])) * uu[j]; }
                u32x4 w; w.x = cvt_pk_bf16(a[0][0], a[0][1]); w.y = cvt_pk_bf16(a[0][2], a[0][3]); w.z = cvt_pk_bf16(a[1][0], a[1][1]); w.w = cvt_pk_bf16(a[1][2], a[1][3]);
                *(u32x4*)rowp = w; }
    }
};
struct EpiKV {
    static constexpr int NSTORE = 0;
    static constexpr bool PERM = true;
    bf16_t *KM, *VM; const float *KPSS, *KPR, *gk, *SSQ;
    __device__ __forceinline__ void operator()(const f32x4 (&acc)[2][2][4][2], const Unit& u, int wr, int wc, int fr, int fq) const {
        const bool isk = u.pn < 4; const int head = (u.pn & 3) * 4 + wc;
        f32x4 g[2][2];
#pragma unroll
        for (int bj = 0; bj < 2; ++bj)
#pragma unroll
            for (int n = 0; n < 2; ++n) g[bj][n] = isk ? *(const f32x4*)(gk + 32 * bj + 8 * fq + 4 * n) : (f32x4){1.f, 1.f, 1.f, 1.f};
#pragma unroll
        for (int ai = 0; ai < 2; ++ai)
#pragma unroll
            for (int m = 0; m < 4; ++m) {
                const int row = u.rowbase + ai * HALF + wr * 64 + m * 16 + fr;
                float ss = 0.f;
#pragma unroll
                for (int bj = 0; bj < 2; ++bj)
#pragma unroll
                    for (int n = 0; n < 2; ++n) { const f32x4 x = acc[ai][bj][m][n]; ss += (x[0] * x[0] + x[1] * x[1]) + (x[2] * x[2] + x[3] * x[3]); }
                ss = sum_x16(ss); ss = sum_x32(ss);
                const f32x4 sl = *(const f32x4*)(SSQ + (size_t)row * 16);
                const float rl = rsqrtf(((sl[0] + sl[1]) + (sl[2] + sl[3])) * (1.f / 256.f) + EPS);
                const float rk = isk ? rsqrtf((ss * rl * rl + KPSS[row]) * (1.f / 96.f) + EPS) : 1.f, r = rl * rk;
                bf16_t* o = isk ? KM + ((size_t)row * 16 + head) * 96 + 8 * fq : VM + (size_t)row * 1024 + head * 64 + 8 * fq;
#pragma unroll
                for (int bj = 0; bj < 2; ++bj) { const f32x4 v0 = acc[ai][bj][m][0] * r * g[bj][0], v1 = acc[ai][bj][m][1] * r * g[bj][1];
                    u32x4 w; w.x = cvt_pk_bf16(v0[0], v0[1]); w.y = cvt_pk_bf16(v0[2], v0[3]); w.z = cvt_pk_bf16(v1[0], v1[1]); w.w = cvt_pk_bf16(v1[2], v1[3]);
                    *(u32x4*)(o + 32 * bj) = w; }
                if (isk) { const f32x4 p0 = *(const f32x4*)(KPR + (size_t)row * 32 + 8 * fq) * rk, p1 = *(const f32x4*)(KPR + (size_t)row * 32 + 8 * fq + 4) * rk;
                    u32x4 w; w.x = cvt_pk_bf16(p0[0], p0[1]); w.y = cvt_pk_bf16(p0[2], p0[3]); w.z = cvt_pk_bf16(p1[0], p1[1]); w.w = cvt_pk_bf16(p1[2], p1[3]);
                    *(u32x4*)(o + 64) = w; }
            }
    }
};
}

#define XB_TMO      128
#define XB_XCNT(j)  (256  + 64 * (j))
#define XB_XSUB(j)  (1280 + 64 * (j))
#define XB_XGEN(j)  (2304 + 64 * (j))
#define XB_TOP      3328
#define XB_TOPGEN   3392
#define XCD_BAR_WORDS 3456
#define XB_SPIN_CAP (1u << 18)
__device__ __forceinline__ unsigned xb_ld(unsigned* p)              { return __hip_atomic_load(p, __ATOMIC_RELAXED, __HIP_MEMORY_SCOPE_AGENT); }
__device__ __forceinline__ unsigned xb_add(unsigned* p, unsigned v) { return __hip_atomic_fetch_add(p, v, __ATOMIC_RELAXED, __HIP_MEMORY_SCOPE_AGENT); }
__device__ __forceinline__ unsigned xb_xcc_id() { return (unsigned)__builtin_amdgcn_s_getreg((3 << 11) | 20) & 0xFu; }
#define XB_SPIN(cond, bar) do { unsigned _sp = 0; while (cond) { __builtin_amdgcn_s_sleep(1); \
    if ((++_sp & 255u) == 0u) { if (xb_ld(&(bar)[XB_TMO])) break; if (_sp > XB_SPIN_CAP) { atomicAdd(&(bar)[XB_TMO], 1u); break; } } } } while (0)
struct XcdBarrier { unsigned* bar; unsigned x; volatile LAS unsigned* st; };
__device__ __forceinline__ XcdBarrier xcd_barrier_post(unsigned* bar, volatile LAS unsigned* st) {
    XcdBarrier b; b.bar = bar; b.x = xb_xcc_id(); b.st = st;
    if (threadIdx.x == 0) (void)xb_add(&bar[XB_XCNT(b.x)], 1u);
    return b;
}
__device__ __forceinline__ void xcd_barrier_complete(unsigned* bar, unsigned x, unsigned& nloc, unsigned& nx) {
    const unsigned G = gridDim.x * gridDim.y * gridDim.z;
    unsigned sum, cnt, mine, sp = 0u;
    for (;;) {
        sum = 0u; cnt = 0u; mine = 0u;
#pragma unroll
        for (unsigned j = 0; j < 16; ++j) { const unsigned c = xb_ld(&bar[XB_XCNT(j)]); sum += c; cnt += (c > 0u) ? 1u : 0u; mine = (j == x) ? c : mine; }
        if (sum == G) break;
        __builtin_amdgcn_s_sleep(1);
        if ((++sp & 255u) == 0u) { if (xb_ld(&bar[XB_TMO])) break; if (sp > XB_SPIN_CAP) { atomicAdd(&bar[XB_TMO], 1u); break; } }
    }
    nloc = mine > 0u ? mine : 1u; nx = cnt > 0u ? cnt : 1u;
}
__device__ __forceinline__ void xcd_barrier(const XcdBarrier& b) {
    asm volatile("s_waitcnt vmcnt(0)" ::: "memory");
    __syncthreads();
    if (threadIdx.x == 0) {
        unsigned* bar = b.bar;
        __builtin_amdgcn_s_waitcnt(0);
        unsigned nloc = b.st[0], nx = b.st[1];
        if (nloc == 0u) { xcd_barrier_complete(bar, b.x, nloc, nx); b.st[0] = nloc; b.st[1] = nx; }
        const unsigned old = xb_add(&bar[XB_XSUB(b.x)], 1u);
        const unsigned gen = old / nloc;
        if (old + 1u == (gen + 1u) * nloc) {
            __builtin_amdgcn_fence(__ATOMIC_RELEASE, "agent");
            asm volatile("s_waitcnt vmcnt(0)" ::: "memory");
            const unsigned og = xb_add(&bar[XB_TOP], 1u);
            const unsigned tg = og / nx;
            if (og + 1u == (tg + 1u) * nx) xb_add(&bar[XB_TOPGEN], 1u);
            else XB_SPIN(xb_ld(&bar[XB_TOPGEN]) == tg, bar);
            __builtin_amdgcn_fence(__ATOMIC_ACQUIRE, "agent");
            xb_add(&bar[XB_XGEN(b.x)], 1u);
            asm volatile("s_waitcnt vmcnt(0)" ::: "memory");
        } else {
            XB_SPIN(xb_ld(&bar[XB_XGEN(b.x)]) == gen, bar);
            __builtin_amdgcn_fence(__ATOMIC_ACQUIRE, "agent");
            asm volatile("s_waitcnt vmcnt(0)" ::: "memory");
        }
    }
    __syncthreads();
}


namespace at {
typedef float f32x16 __attribute__((ext_vector_type(16)));
typedef short s16x4 __attribute__((ext_vector_type(4)));
__device__ __forceinline__ int crow(int r, int hi) { return (r & 3) + 8 * (r >> 2) + 4 * hi; }
__device__ __forceinline__ s16x4 vtr(const LAS unsigned char* p) { return __builtin_bit_cast(s16x4, __builtin_amdgcn_ds_read_tr16_b64_v4i16((LAS s16x4*)p)); }
__device__ __forceinline__ float bflo(unsigned u) { return __uint_as_float(u << 16); }
__device__ __forceinline__ float bfhi(unsigned u) { return __uint_as_float(u & 0xffff0000u); }

__device__ __forceinline__ void v_frags(bf16x8 (&vf)[8], const LAS unsigned char* vlane) {
#pragma unroll
    for (int d0 = 0; d0 < 2; ++d0)
#pragma unroll
        for (int ks = 0; ks < 4; ++ks) {
            const s16x4 lo = vtr(vlane + d0 * 4096 + ks * 1024), hi = vtr(vlane + d0 * 4096 + ks * 1024 + 512);
            vf[d0 * 4 + ks] = (bf16x8){lo[0], lo[1], lo[2], lo[3], hi[0], hi[1], hi[2], hi[3]};
        }
}
__device__ __forceinline__ void v_frags_half(bf16x8 (&vf)[4], const LAS unsigned char* vlane, int d0) {
#pragma unroll
    for (int ks = 0; ks < 4; ++ks) {
        const s16x4 lo = vtr(vlane + d0 * 4096 + ks * 1024), hi = vtr(vlane + d0 * 4096 + ks * 1024 + 512);
        vf[ks] = (bf16x8){lo[0], lo[1], lo[2], lo[3], hi[0], hi[1], hi[2], hi[3]};
    }
}
__device__ __forceinline__ void pv_mma_half(f32x16& o, const bf16x8 (&vf)[4], const u32x4 (&pw)[4]) {
    __builtin_amdgcn_s_setprio(1);
#pragma unroll
    for (int ks = 0; ks < 4; ++ks) o = __builtin_amdgcn_mfma_f32_32x32x16_bf16(__builtin_bit_cast(bf16x8, pw[ks]), vf[ks], o, 0, 0, 0);
    __builtin_amdgcn_s_setprio(0);
}
__device__ __forceinline__ void pv_mma(f32x16 (&o)[2], const bf16x8 (&vf)[8], const u32x4 (&pw)[4]) {
    __builtin_amdgcn_s_setprio(1);
#pragma unroll
    for (int ks = 0; ks < 4; ++ks)
#pragma unroll
        for (int d0 = 0; d0 < 2; ++d0) o[d0] = __builtin_amdgcn_mfma_f32_32x32x16_bf16(__builtin_bit_cast(bf16x8, pw[ks]), vf[d0 * 4 + ks], o[d0], 0, 0, 0);
    __builtin_amdgcn_s_setprio(0);
}
constexpr float SM_THR = 8.f;
__device__ __forceinline__ bool softmax_step(f32x16& p0, f32x16& p1, float& mhat, float& l, f32x16 (&o)[2], u32x4 (&pw)[4], LAS float* wsf, int r32, int hi, bool first) {
    float a = fmaxf(fmaxf(p0[0], p1[0]), fmaxf(p0[1], p1[1]));
#pragma unroll
    for (int r = 2; r < 16; r += 2) a = fmaxf(a, fmaxf(fmaxf(p0[r], p1[r]), fmaxf(p0[r + 1], p1[r + 1])));
    a = max_x32(a);
    const bool moved = first || __any(a > SM_THR);
    if (moved) {
        const float dl = first ? a : fmaxf(a, 0.f);
        mhat += dl;
#pragma unroll
        for (int r = 0; r < 16; ++r) { p0[r] -= dl; p1[r] -= dl; }
        if (!first) {
            const float f = __builtin_amdgcn_exp2f(-dl);
            l *= f;
            if (hi == 0) wsf[r32] = f;
            asm volatile("s_waitcnt lgkmcnt(0)" ::: "memory");
#pragma unroll
            for (int g = 0; g < 4; ++g) { const f32x4 al = *(const LAS f32x4*)(wsf + 8 * g + 4 * hi);
#pragma unroll
                for (int j = 0; j < 4; ++j) { o[0][4 * g + j] *= al[j]; o[1][4 * g + j] *= al[j]; } }
        }
    }
    f32x2 sa = (f32x2){0.f, 0.f}, sb = (f32x2){0.f, 0.f};
#pragma unroll
    for (int r = 0; r < 16; r += 2) {
        p0[r] = __builtin_amdgcn_exp2f(p0[r]); p0[r + 1] = __builtin_amdgcn_exp2f(p0[r + 1]); p1[r] = __builtin_amdgcn_exp2f(p1[r]); p1[r + 1] = __builtin_amdgcn_exp2f(p1[r + 1]);
        sa += (f32x2){p0[r], p0[r + 1]}; sb += (f32x2){p1[r], p1[r + 1]};
    }
    sa += sb; l += sa.x + sa.y;
#pragma unroll
    for (int k = 0; k < 2; ++k) {
        pw[k].x = cvt_pk_bf16(p0[8 * k + 0], p0[8 * k + 1]); pw[k].y = cvt_pk_bf16(p0[8 * k + 2], p0[8 * k + 3]); pw[k].z = cvt_pk_bf16(p0[8 * k + 4], p0[8 * k + 5]); pw[k].w = cvt_pk_bf16(p0[8 * k + 6], p0[8 * k + 7]);
        pw[2 + k].x = cvt_pk_bf16(p1[8 * k + 0], p1[8 * k + 1]); pw[2 + k].y = cvt_pk_bf16(p1[8 * k + 2], p1[8 * k + 3]); pw[2 + k].z = cvt_pk_bf16(p1[8 * k + 4], p1[8 * k + 5]); pw[2 + k].w = cvt_pk_bf16(p1[8 * k + 6], p1[8 * k + 7]);
    }    return moved;
}
__device__ __forceinline__ void finish_store(const f32x16 (&o)[2], float l, LAS float* wsf, int r32, int hi, bf16_t* Orow0, size_t ostride) {
    l = sum_x32(l);
    if (hi == 0) wsf[32 + r32] = l;
    asm volatile("s_waitcnt lgkmcnt(0)" ::: "memory");
#pragma unroll
    for (int g = 0; g < 4; ++g) { const f32x4 lv = *(const LAS f32x4*)(wsf + 32 + 8 * g + 4 * hi);
#pragma unroll
        for (int j = 0; j < 4; ++j) { const float rl = __builtin_amdgcn_rcpf(lv[j]); const int row = 8 * g + 4 * hi + j;
            Orow0[(size_t)row * ostride + r32] = f2bf(o[0][4 * g + j] * rl); Orow0[(size_t)row * ostride + 32 + r32] = f2bf(o[1][4 * g + j] * rl); } }
}

constexpr int MLA_KB = 12288, MLA_BUF = 20480;
template <class BG>
__device__ __forceinline__ void mla_unit(LAS unsigned char* lds, int b, int h, int qb, const bf16_t* QR, const bf16_t* KM, const bf16_t* VM, const float* ROPE, const float* gq, bf16_t* OB, BG& bg, const int abl = 0) {
    int tid = threadIdx.x; asm volatile("" : "+v"(tid));
    const int lane = tid & 63, r32 = lane & 31, hi = lane >> 5, wid = __builtin_amdgcn_readfirstlane(tid >> 6);
    const int q0 = qb * 256, NTL = 4 * (qb + 1), rowbase = b * SEQ;
    LAS float* wsf = (LAS float*)(lds + 2 * MLA_BUF) + wid * 64;
    const bf16_t* kg0 = KM + ((size_t)(rowbase + lane) * 16 + h) * 96 + wid * 8;
    const bf16_t* kg1 = KM + ((size_t)(rowbase + lane) * 16 + h) * 96 + (8 + (wid & 3)) * 8;
    const bf16_t* vg = VM + (size_t)(rowbase + 16 * (wid & 3) + (lane >> 2)) * 1024 + h * 64 + (wid >> 2) * 32 + (lane & 3) * 8;
    const int kl0 = wid * 1024 + lane * 16, kl1 = (8 + (wid & 3)) * 1024 + lane * 16, vl = MLA_KB + wid * 1024 + lane * 16;
    u32x4 ak0, ak1, av, bk0, bk1, bv; ak1 = (u32x4){0u, 0u, 0u, 0u}; bk1 = ak1;
#define MLA_LOAD(S, t) do { S##k0 = *(const GAS u32x4*)(kg0 + (size_t)(t) * 64 * 1536); if (wid < 4) S##k1 = *(const GAS u32x4*)(kg1 + (size_t)(t) * 64 * 1536); S##v = *(const GAS u32x4*)(vg + (size_t)(t) * 64 * 1024); } while (0)
#define MLA_WRITE(S, buf) do { *(LAS u32x4*)(lds + (buf) * MLA_BUF + kl0) = S##k0; if (wid < 4) *(LAS u32x4*)(lds + (buf) * MLA_BUF + kl1) = S##k1; *(LAS u32x4*)(lds + (buf) * MLA_BUF + vl) = S##v; } while (0)
    MLA_LOAD(a, 0);
    bf16x8 qr[6];
    {
        const int qrow = rowbase + q0 + wid * 32 + r32;
        const bf16_t* qp = QR + (size_t)qrow * 1536 + h * 96 + hi * 8;
        float qf[6][8]; float ss = 0.f;
#pragma unroll
        for (int d0 = 0; d0 < 6; ++d0) { const u32x4 w = *(const GAS u32x4*)(qp + 16 * d0);
            qf[d0][0] = bflo(w.x); qf[d0][1] = bfhi(w.x); qf[d0][2] = bflo(w.y); qf[d0][3] = bfhi(w.y); qf[d0][4] = bflo(w.z); qf[d0][5] = bfhi(w.z); qf[d0][6] = bflo(w.w); qf[d0][7] = bfhi(w.w);
#pragma unroll
            for (int j = 0; j < 8; ++j) ss += qf[d0][j] * qf[d0][j]; }
        ss = sum_x32(ss);
        const float rn = rsqrtf(ss * (1.f / 96.f) + EPS) * C3;
#pragma unroll
        for (int d0 = 0; d0 < 6; ++d0) { const f32x4 g0 = *(const GAS f32x4*)(gq + 16 * d0 + 8 * hi), g1 = *(const GAS f32x4*)(gq + 16 * d0 + 8 * hi + 4);
#pragma unroll
            for (int j = 0; j < 4; ++j) { qf[d0][j] *= rn * g0[j]; qf[d0][4 + j] *= rn * g1[j]; } }
        { const f32x4 c0 = *(const GAS f32x4*)(ROPE + (size_t)qrow * 16 + 8 * hi), c1 = *(const GAS f32x4*)(ROPE + (size_t)qrow * 16 + 8 * hi + 4);
          const f32x4 s0 = *(const GAS f32x4*)(ROPE + (size_t)NT * 16 + (size_t)qrow * 16 + 8 * hi), s1 = *(const GAS f32x4*)(ROPE + (size_t)NT * 16 + (size_t)qrow * 16 + 8 * hi + 4);
#pragma unroll
          for (int j = 0; j < 8; ++j) { const float cs = j < 4 ? c0[j & 3] : c1[j & 3], sn = j < 4 ? s0[j & 3] : s1[j & 3]; const float t1 = qf[4][j], t2 = qf[5][j];
              qf[4][j] = t1 * cs - t2 * sn; qf[5][j] = t1 * sn + t2 * cs; } }
#pragma unroll
        for (int d0 = 0; d0 < 6; ++d0) { u32x4 w; w.x = cvt_pk_bf16(qf[d0][0], qf[d0][1]); w.y = cvt_pk_bf16(qf[d0][2], qf[d0][3]); w.z = cvt_pk_bf16(qf[d0][4], qf[d0][5]); w.w = cvt_pk_bf16(qf[d0][6], qf[d0][7]);
            qr[d0] = __builtin_bit_cast(bf16x8, w); }
    }
    MLA_WRITE(a, 0);
    MLA_LOAD(a, 1);
    __syncthreads();
    float m = 0.f, l = 0.f; f32x16 o[2], negm;
#pragma unroll
    for (int r = 0; r < 16; ++r) { o[0][r] = 0.f; o[1][r] = 0.f; negm[r] = 0.f; }
    const int qabs = q0 + wid * 32 + r32, qmax_w = q0 + wid * 32 + 31;
    const int voff = MLA_KB + ((lane >> 4) & 1) * 32 + (lane & 3) * 8 + (4 * hi + ((lane & 15) >> 2)) * 64;
#define MLA_STEP(t, buf, LS, WS) do { \
        if (!(abl & 4)) bg.tick();                                   \
        if ((t) + 2 < NTL && !(abl & 2)) MLA_LOAD(LS, (t) + 2); \
        if (64 * (t) <= qmax_w && !(abl & 1)) {                      \
            const LAS unsigned char* kb = lds + (buf) * MLA_BUF + hi * 1024 + r32 * 16; \
            bf16x8 kf[12]; \
            _Pragma("unroll") for (int d0 = 0; d0 < 6; ++d0) { kf[2 * d0] = *(const LAS bf16x8*)(kb + d0 * 2048); kf[2 * d0 + 1] = *(const LAS bf16x8*)(kb + d0 * 2048 + 512); } \
            f32x16 p0, p1; \
            __builtin_amdgcn_sched_barrier(0); \
            __builtin_amdgcn_s_setprio(1); \
            p0 = __builtin_amdgcn_mfma_f32_32x32x16_bf16(kf[0], qr[0], negm, 0, 0, 0);     \
            p1 = __builtin_amdgcn_mfma_f32_32x32x16_bf16(kf[1], qr[0], negm, 0, 0, 0); \
            _Pragma("unroll") for (int d0 = 1; d0 < 6; ++d0) { \
                p0 = __builtin_amdgcn_mfma_f32_32x32x16_bf16(kf[2 * d0], qr[d0], p0, 0, 0, 0); \
                p1 = __builtin_amdgcn_mfma_f32_32x32x16_bf16(kf[2 * d0 + 1], qr[d0], p1, 0, 0, 0); } \
            __builtin_amdgcn_s_setprio(0); \
            bf16x8 vf[8]; \
            v_frags(vf, lds + (buf) * MLA_BUF + voff); \
            __builtin_amdgcn_sched_barrier(0); \
            if (64 * (t) + 63 > q0 + wid * 32) {                     \
                _Pragma("unroll") for (int r = 0; r < 16; ++r) { const int kv = 64 * (t) + crow(r, hi); if (kv > qabs) p0[r] = -INFINITY; if (kv + 32 > qabs) p1[r] = -INFINITY; } } \
            u32x4 pw[4]; \
            if (softmax_step(p0, p1, m, l, o, pw, wsf, r32, hi, (t) == 0)) { _Pragma("unroll") for (int r = 0; r < 16; ++r) negm[r] = -m; } \
            __builtin_amdgcn_sched_barrier(0); \
            pv_mma(o, vf, pw); \
        } \
        if ((t) + 1 < NTL && !(abl & 2)) MLA_WRITE(WS, (buf) ^ 1); \
        __syncthreads(); } while (0)
#pragma unroll 1
    for (int t = 0; t < NTL; t += 2) {
        MLA_STEP(t, 0, b, a);
        MLA_STEP(t + 1, 1, a, b);
    }
#undef MLA_STEP
#undef MLA_LOAD
#undef MLA_WRITE
    finish_store(o, l, wsf, r32, hi, OB + (size_t)(rowbase + q0 + wid * 32) * 1024 + h * 64, 1024);
    __syncthreads();
}

struct DilU { int b, h, dil, r, n; };
struct DilStage { u32x4 kk[8], vv[8]; int pk; };
__device__ __forceinline__ void dil_load_k(DilStage& st, const DilU& u, int hw, int lane, const bf16_t* K, const int* pos) {
    if (hw >= ((u.n == 0) ? 2 : 0)) {
        const int rowbase = u.b * SEQ, ci = 64 * hw + lane, tokk = (128 * (u.n - 1) + ci) * u.dil + u.r;
        const bf16_t* kg = K + (size_t)(rowbase + tokk) * 1024 + u.h * 64;
#pragma unroll
        for (int c = 0; c < 8; ++c) st.kk[c] = *(const GAS u32x4*)(kg + c * 8);
        st.pk = pos[rowbase + tokk];
    }
}
__device__ __forceinline__ void dil_load_v(DilStage& st, const DilU& u, int hw, int lane, const bf16_t* V) {
    if (hw >= ((u.n == 0) ? 2 : 0)) {
        const int rowbase = u.b * SEQ;
#pragma unroll
        for (int pc = 0; pc < 8; ++pc) { const int rg = pc & 3, dh = pc >> 2; const int cv = 64 * hw + 16 * rg + (lane >> 2); const int tokv = (128 * (u.n - 1) + cv) * u.dil + u.r;
            st.vv[pc] = *(const GAS u32x4*)(V + (size_t)(rowbase + tokv) * 1024 + u.h * 64 + dh * 32 + (lane & 3) * 8); }
    }
}
__device__ __forceinline__ void dil_write(const DilStage& st, const DilU& u, LAS unsigned char* hl, LAS float* xs, int hw, int lane) {
    if (hw >= ((u.n == 0) ? 2 : 0)) {
#pragma unroll
        for (int c = 0; c < 8; ++c) *(LAS u32x4*)(hl + hw * 8192 + c * 1024 + lane * 16) = st.kk[c];
#pragma unroll
        for (int pc = 0; pc < 8; ++pc) *(LAS u32x4*)(hl + 32768 + hw * 8192 + pc * 1024 + lane * 16) = st.vv[pc];
        xs[64 * hw + lane] = (float)st.pk;
    }
}
struct RingStage { u32x4 d[8]; int pk; };
__device__ __forceinline__ void ring_load(RingStage& st, const DilU& u0, int wv, int lane, const bf16_t* K, const bf16_t* V, const int* pos) {
    const int j = wv >> 1, rowbase = u0.b * SEQ, key0 = 128 * (u0.n + (j >> 1)) + 64 * (j & 1);
    if (!(wv & 1)) {
        const int tok = (key0 + lane) * u0.dil + u0.r;
        const bf16_t* kg = K + (size_t)(rowbase + tok) * 1024 + u0.h * 64;
#pragma unroll
        for (int c = 0; c < 8; ++c) st.d[c] = *(const GAS u32x4*)(kg + c * 8);
        st.pk = pos[rowbase + tok];
    } else {
#pragma unroll
        for (int pc = 0; pc < 8; ++pc) { const int rg = pc & 3, dh = pc >> 2; const int tok = (key0 + 16 * rg + (lane >> 2)) * u0.dil + u0.r;
            st.d[pc] = *(const GAS u32x4*)(V + (size_t)(rowbase + tok) * 1024 + u0.h * 64 + dh * 32 + (lane & 3) * 8); }
    }
}
__device__ __forceinline__ void ring_write(const RingStage& st, const DilU& u0, LAS unsigned char* lds, LAS float* xs, int wv, int lane) {
    const int j = wv >> 1, slot = (u0.n + (j >> 1)) & 3;
    LAS unsigned char* base = lds + slot * 32768 + (j & 1) * 8192 + ((wv & 1) ? 16384 : 0);
#pragma unroll
    for (int c = 0; c < 8; ++c) *(LAS u32x4*)(base + c * 1024 + lane * 16) = st.d[c];
    if (!(wv & 1)) xs[slot * 128 + (j & 1) * 64 + lane] = (float)st.pk;
}
template <bool MERGE, bool RING>
__device__ __forceinline__ void dil_compute(LAS unsigned char* hl, LAS float* xs, int hw, int wv, int lane, const DilU& u, const bf16x8 (&qr)[4], float posq,
                                            bf16_t* PARTg, float* LSEg, const bf16_t* P0, const bf16_t* P1, const float* L0, const float* L1, bf16_t* OB, const int abl = 0) {
    const int b = u.b, h = u.h, dil = u.dil, r = u.r, n = u.n;
    const int r32 = lane & 31, hi = lane >> 5;
    const int rowbase = b * SEQ, first_tile = (n == 0) ? 2 : 0;
    LAS float* wsf = RING ? xs + 512 + wv * 64 : xs + 256 + hw * 64;
    const int a = 32 * hw + r32;
    const int tokq = (128 * n + a) * dil + r;
    const float slope2 = exp2f(-0.5f * (float)(h + 1)) * LOG2E;
    float m = 0.f, l = 0.f; f32x16 o[2], negm;
#pragma unroll
    for (int rr = 0; rr < 16; ++rr) { o[0][rr] = 0.f; o[1][rr] = 0.f; negm[rr] = 0.f; }
    const int tlo = max((32 * hw) >> 6, first_tile), thi = (abl & 1) ? -1 : min((32 * hw + 159) >> 6, 3);
    const int voff = ((lane >> 4) & 1) * 32 + (lane & 3) * 8 + (4 * hi + ((lane & 15) >> 2)) * 64;
#pragma unroll 1
    for (int T = tlo; T <= thi; ++T) {
        const int slot = (n - 1 + (T >> 1)) & 3;
        const int kofs = RING ? slot * 32768 + (T & 1) * 8192 : T * 8192, vofs = RING ? kofs + 16384 : 32768 + T * 8192;
        const LAS float* posk = RING ? xs + slot * 128 + (T & 1) * 64 : xs + 64 * T;
        const LAS unsigned char* kb = hl + kofs + hi * 1024 + r32 * 16;
        bf16x8 kf[8];
#pragma unroll
        for (int d0 = 0; d0 < 4; ++d0) { kf[2 * d0] = *(const LAS bf16x8*)(kb + d0 * 2048); kf[2 * d0 + 1] = *(const LAS bf16x8*)(kb + d0 * 2048 + 512); }
        f32x16 p0, p1;
        __builtin_amdgcn_sched_barrier(0);
        __builtin_amdgcn_s_setprio(1);
        p0 = __builtin_amdgcn_mfma_f32_32x32x16_bf16(kf[0], qr[0], negm, 0, 0, 0);
        p1 = __builtin_amdgcn_mfma_f32_32x32x16_bf16(kf[1], qr[0], negm, 0, 0, 0);
#pragma unroll
        for (int d0 = 1; d0 < 4; ++d0) {
            p0 = __builtin_amdgcn_mfma_f32_32x32x16_bf16(kf[2 * d0], qr[d0], p0, 0, 0, 0);
            p1 = __builtin_amdgcn_mfma_f32_32x32x16_bf16(kf[2 * d0 + 1], qr[d0], p1, 0, 0, 0);
        }
        __builtin_amdgcn_s_setprio(0);
        bf16x8 vf0[4];
        v_frags_half(vf0, hl + vofs + voff, 0);
        __builtin_amdgcn_sched_barrier(0);
#pragma unroll
        for (int g = 0; g < 4; ++g) { const f32x4 pa = *(const LAS f32x4*)(posk + 8 * g + 4 * hi), pb = *(const LAS f32x4*)(posk + 32 + 8 * g + 4 * hi);
#pragma unroll
            for (int j = 0; j < 4; ++j) { p0[4 * g + j] += slope2 * (pa[j] - posq); p1[4 * g + j] += slope2 * (pb[j] - posq); } }
        if (64 * T < 32 * hw + 31 || 64 * T + 63 > 32 * hw + 128) {
#pragma unroll
            for (int rr = 0; rr < 16; ++rr) { const int c0 = 64 * T + crow(rr, hi), c1 = c0 + 32;
                if (c0 < a || c0 > a + 128) p0[rr] = -INFINITY;
                if (c1 < a || c1 > a + 128) p1[rr] = -INFINITY; }
        }
        u32x4 pw[4];
        if (softmax_step(p0, p1, m, l, o, pw, wsf, r32, hi, T == tlo)) {
#pragma unroll
            for (int rr = 0; rr < 16; ++rr) negm[rr] = -m; }
        bf16x8 vf1[4];
        v_frags_half(vf1, hl + vofs + voff, 1);
        __builtin_amdgcn_sched_barrier(0);
        pv_mma_half(o[0], vf0, pw);
        pv_mma_half(o[1], vf1, pw);
    }
    l = sum_x32(l);
    int r32e = r32, hie = hi; asm volatile("" : "+v"(r32e), "+v"(hie));
    const int tokqe = (128 * n + 32 * hw + r32e) * dil + r;
    if (!MERGE) {
        if (hie == 0) { wsf[32 + r32e] = l; LSEg[(size_t)(rowbase + tokqe) * 16 + h] = m + log2f(l); }
        asm volatile("s_waitcnt lgkmcnt(0)" ::: "memory");
#pragma unroll
        for (int g = 0; g < 4; ++g) { const f32x4 lv = *(const LAS f32x4*)(wsf + 32 + 8 * g + 4 * hie);
#pragma unroll
            for (int j = 0; j < 4; ++j) { const float rl = __builtin_amdgcn_rcpf(lv[j]); const int tok = (128 * n + 32 * hw + 8 * g + 4 * hie + j) * dil + r;
                bf16_t* op = PARTg + (size_t)(rowbase + tok) * 1024 + h * 64 + r32e;
                op[0] = f2bf(o[0][4 * g + j] * rl); op[32] = f2bf(o[1][4 * g + j] * rl); } }
    } else {
        if (hie == 0) { wsf[32 + r32e] = l; wsf[r32e] = m + log2f(l); }
        asm volatile("s_waitcnt lgkmcnt(0)" ::: "memory");
#pragma unroll
        for (int g = 0; g < 4; ++g) {
            float e0[4], e1[4]; bf16_t a0[4], a1[4], b0[4], b1[4];
#pragma unroll
            for (int j = 0; j < 4; ++j) { const int tok = (128 * n + 32 * hw + 8 * g + 4 * hie + j) * dil + r; const size_t rw = (size_t)(rowbase + tok), off = rw * 1024 + h * 64 + r32e;
                e0[j] = L0[rw * 16 + h]; e1[j] = L1[rw * 16 + h]; a0[j] = P0[off]; a1[j] = P0[off + 32]; b0[j] = P1[off]; b1[j] = P1[off + 32]; }
            const f32x4 lv = *(const LAS f32x4*)(wsf + 32 + 8 * g + 4 * hie), ls2 = *(const LAS f32x4*)(wsf + 8 * g + 4 * hie);
#pragma unroll
            for (int j = 0; j < 4; ++j) { const int rr = 4 * g + j; const int tok = (128 * n + 32 * hw + 8 * g + 4 * hie + j) * dil + r; const size_t rw = (size_t)(rowbase + tok);
                const float e2 = ls2[j];
                const float M = fmaxf(fmaxf(e0[j], e1[j]), e2); const float w0 = exp2f(e0[j] - M), w1 = exp2f(e1[j] - M), w2 = exp2f(e2 - M);
                const float rden = __builtin_amdgcn_rcpf(w0 + w1 + w2), w2l = w2 * __builtin_amdgcn_rcpf(lv[j]);
                const size_t off = rw * 1024 + h * 64 + r32e;
                OB[off] = f2bf((w0 * bf2f(a0[j]) + w1 * bf2f(b0[j]) + w2l * o[0][rr]) * rden); OB[off + 32] = f2bf((w0 * bf2f(a1[j]) + w1 * bf2f(b1[j]) + w2l * o[1][rr]) * rden); }
        }
    }
}
}

namespace mk {
constexpr int NWAVES = 8, NTHREADS = 512;
constexpr int RING_BYTES = 131072, LDSCTL_OFF = RING_BYTES, MISC_OFF = LDSCTL_OFF + 2048;
constexpr int XS_OFF = RING_BYTES + 4096;
constexpr int LDS_BYTES = RING_BYTES + 4096 + 4096;
constexpr int CW_BAR = 4096;
constexpr int NPHASE = 19;

struct Args {
    const float* in[30]; float* out; unsigned char* ws; int ph_lo, ph_hi;
};

__device__ __forceinline__ float wave_sum(float v) { return wave_sum_all(v); }

struct TItem { const float* W; int ldw, k0, srccol0; bf16_t* WT; bf16_t* lo; int Kd, dstrow0, spread; const float* ks; };
__device__ __forceinline__ void titem_load(const TItem& it, f32x4 (&v)[8], int lane) {
    const int c = lane & 7, coff = it.spread ? 16 * (c >> 1) + 4 * (c & 1) : 4 * c;
#pragma unroll
    for (int i = 0; i < 8; ++i) v[i] = __builtin_nontemporal_load((const GAS f32x4*)(it.W + (size_t)(it.k0 + 8 * i + (lane >> 3)) * it.ldw + it.srccol0 + coff));
}
__device__ __forceinline__ void titem_finish(const TItem& it, const f32x4 (&v)[8], LAS float* scr, int lane) {
#pragma unroll
    for (int i = 0; i < 8; ++i) { LAS float* d = scr + (8 * i + (lane >> 3)) * 33 + 4 * (lane & 7); d[0] = v[i].x; d[1] = v[i].y; d[2] = v[i].z; d[3] = v[i].w; }
    asm volatile("s_waitcnt lgkmcnt(0)" ::: "memory");
    const int c = lane & 7;
#pragma unroll
    for (int j = 0; j < 4; ++j) { const int n = (lane >> 3) + 8 * j; const LAS float* sp = scr + (8 * c) * 33 + n;
        float f[8];
#pragma unroll
        for (int q = 0; q < 8; ++q) f[q] = sp[q * 33];
        if (it.ks) { const f32x4 s0 = *(const GAS f32x4*)(it.ks + it.k0 + 8 * c), s1 = *(const GAS f32x4*)(it.ks + it.k0 + 8 * c + 4);
            f[0] *= s0.x; f[1] *= s0.y; f[2] *= s0.z; f[3] *= s0.w; f[4] *= s1.x; f[5] *= s1.y; f[6] *= s1.z; f[7] *= s1.w; }
        u32x4 o; o.x = pk2(f[0], f[1]); o.y = pk2(f[2], f[3]); o.z = pk2(f[4], f[5]); o.w = pk2(f[6], f[7]);
        __builtin_nontemporal_store(o, (GAS u32x4*)(it.WT + (size_t)(it.dstrow0 + n) * it.Kd + it.k0 + 8 * c));
        if (it.lo) {
            float rs[8];
#pragma unroll
            for (int q = 0; q < 8; ++q) rs[q] = f[q] - bf2f(f2bf(f[q]));
            u32x4 ol; ol.x = pk2(rs[0], rs[1]); ol.y = pk2(rs[2], rs[3]); ol.z = pk2(rs[4], rs[5]); ol.w = pk2(rs[6], rs[7]);
            *(GAS u32x4*)(it.lo + (size_t)(it.dstrow0 + n) * it.Kd + it.k0 + 8 * c) = ol;
        }
    }
    asm volatile("s_waitcnt lgkmcnt(0)" ::: "memory");
}

__device__ __forceinline__ int hpw_src_block(int db) { const int pn = db >> 3, q = db & 7, bj = q >> 2, wc = q & 3; return (4 * pn + wc) * 2 + bj; }

__device__ __forceinline__ int opaque(int v) { asm volatile("" : "+v"(v)); return v; }
struct Ctx {
    LAS unsigned char* lds; int tid, lane, wave, G, vcu;
    unsigned char* ws; const float* const* in; float* out;
};
template <class T> __device__ __forceinline__ T* opaque_uniform_ptr(T* p) {
    const unsigned long long u = (unsigned long long)p;
    unsigned lo = __builtin_amdgcn_readfirstlane((unsigned)u), hi = __builtin_amdgcn_readfirstlane((unsigned)(u >> 32));
    asm volatile("" : "+s"(lo), "+s"(hi));
    return (T*)(((unsigned long long)hi << 32) | lo);
}
__device__ __forceinline__ Ctx phase_ctx(const Ctx& F0) {
    Ctx F = F0; F.lane = opaque(F0.lane); F.tid = opaque(F0.tid);
    F.ws = opaque_uniform_ptr(F0.ws); F.out = opaque_uniform_ptr(F0.out); return F;
}

constexpr int I_QKV = 16 * 96, I_O = 16 * 32, I_KVD = 16 * 9, I_DQ = 16 * 12, I_UK = 4 * 32, I_UQ = 6 * 48, I_R = 2 * 16 * 2;
constexpr int I_GU1 = 16 * 16, I_DN1 = 4 * 32, I_GUL = 65 * I_GU1, I_DNL = 65 * I_DN1, I_MOEL = I_GUL + I_DNL;
constexpr int NITEMS_P0 = I_MOEL + I_QKV + 2 * I_O + I_KVD + I_DQ + 2 * I_UK + I_UQ + I_R;
__device__ __forceinline__ TItem decode_item(const Ctx& F, int it, int l) {
    bf16_t* Wqkv = (bf16_t*)(F.ws + WS_WQKV); bf16_t* Wo0 = (bf16_t*)(F.ws + WS_WO0); bf16_t* Wo1 = (bf16_t*)(F.ws + WS_WO1);
    bf16_t* Wkvd = (bf16_t*)(F.ws + WS_WKVD); bf16_t* Wdq = (bf16_t*)(F.ws + WS_WDQ); bf16_t* Wukv = (bf16_t*)(F.ws + WS_WUKV); bf16_t* Wuq = (bf16_t*)(F.ws + WS_WUQ);
    bf16_t* Wr = (bf16_t*)(F.ws + WS_WR); bf16_t* Wgu = (bf16_t*)(F.ws + WS_WGU); bf16_t* Wdn = (bf16_t*)(F.ws + WS_WDN);
    TItem t; t.lo = nullptr; t.spread = 0; t.ks = nullptr;
    int r = it;
    if (r < I_GUL) {
        const int e = r / I_GU1, rr = r % I_GU1, kb = rr >> 4, db = rr & 15, tl = db >> 3, q = db & 7, sb = (q >> 2) * 8 + tl * 4 + (q & 3), le = l * 65 + e;
        t.W = (e < 64) ? F.in[26] + ((size_t)l * 64 + e) * 1024 * 512 : F.in[28] + (size_t)l * 1024 * 512;
        t.ldw = 512; t.k0 = kb * 64; t.srccol0 = sb * 32; t.WT = Wgu + (size_t)le * 512 * 1024; t.Kd = 1024; t.dstrow0 = db * 32; return t; }
    r -= I_GUL;
    if (r < I_DNL) {
        const int e = r / I_DN1, rr = r % I_DN1, kb = rr >> 5, db = rr & 31, le = l * 65 + e;
        t.W = (e < 64) ? F.in[27] + ((size_t)l * 64 + e) * 256 * 1024 : F.in[29] + (size_t)l * 256 * 1024;
        { const int pn = db >> 3, q = db & 7, bj = q >> 2, wc = q & 3; t.srccol0 = pn * 256 + 64 * wc + 8 * bj; t.spread = 1; }
        t.ldw = 1024; t.k0 = kb * 64; t.WT = Wdn + (size_t)le * 1024 * 256; t.Kd = 256; t.dstrow0 = db * 32; return t; }
    r -= I_DNL;
    if (r < I_QKV) { const int kb = r / 96, db = r % 96, sct = db >> 5; t.W = F.in[7]; t.ldw = 3072; t.k0 = kb * 64; t.srccol0 = (sct * 32 + hpw_src_block(db & 31)) * 32; t.WT = Wqkv; t.Kd = 1024; t.dstrow0 = db * 32; return t; }
    r -= I_QKV;
    if (r < 2 * I_O) { const int w = r / I_O, rr = r % I_O, kb = rr >> 5, db = rr & 31; t.W = w ? F.in[23] : F.in[10]; t.ldw = 1024; t.k0 = kb * 64; t.srccol0 = db * 32; t.WT = w ? Wo1 : Wo0; t.Kd = 1024; t.dstrow0 = db * 32; return t; }
    r -= 2 * I_O;
    if (r < I_KVD) { const int kb = r / 9, db = r % 9; t.W = F.in[14]; t.ldw = 288; t.k0 = kb * 64; t.srccol0 = db * 32; t.WT = Wkvd; t.Kd = 1024; t.dstrow0 = db * 32; return t; }
    r -= I_KVD;
    if (r < I_DQ) { const int kb = r / 12, db = r % 12; t.W = F.in[19]; t.ldw = 384; t.k0 = kb * 64; t.srccol0 = db * 32; t.WT = Wdq; t.Kd = 1024; t.dstrow0 = db * 32; return t; }
    r -= I_DQ;
    if (r < 2 * I_UK) { const int w = r / I_UK, rr = r % I_UK, kb = rr >> 5, db = rr & 31; t.W = w ? F.in[17] : F.in[16]; t.ldw = 1024; t.k0 = kb * 64; t.srccol0 = hpw_src_block(db) * 32; t.WT = Wukv; t.Kd = 256; t.dstrow0 = w * 1024 + db * 32; t.ks = F.in[15]; return t; }
    r -= 2 * I_UK;
    if (r < I_UQ) { const int kb = r / 48, db = r % 48; t.W = F.in[21]; t.ldw = 1536; t.k0 = kb * 64; t.srccol0 = db * 32; t.WT = Wuq; t.Kd = 384; t.dstrow0 = db * 32; t.ks = F.in[20]; return t; }
    r -= I_UQ;
    { const int l = r >> 5, rr = r & 31, kb = rr >> 1, db = rr & 1;
      t.W = F.in[24] + (size_t)l * 1024 * 64; t.ldw = 64; t.k0 = kb * 64; t.srccol0 = db * 32; t.WT = Wr + (size_t)(l * 2 + 0) * 64 * 1024; t.lo = Wr + (size_t)(l * 2 + 1) * 64 * 1024; t.Kd = 1024; t.dstrow0 = db * 32; return t; }
}


struct BgConv {
    Ctx F; int l, idx, end, stride, cnt, base; bool pend; LAS float* scr; TItem it; f32x4 v[8];
    static constexpr int BG_PERIOD = 2;
    __device__ __forceinline__ void init(const Ctx& F_, int l_, int first, int end_, int stride_, LAS float* scr_) { F = F_; l = l_; idx = first; end = end_; stride = stride_; cnt = 0; base = 0; pend = false; scr = scr_; }
    __device__ __forceinline__ void tick() {
        if (++cnt < BG_PERIOD) return;
        cnt = 0;
        if (pend) { titem_finish(it, v, scr, F.lane); pend = false; }
        if (idx < end) { it = decode_item(F, base + idx, l); titem_load(it, v, F.lane); pend = true; idx += stride; }
    }
    __device__ __forceinline__ void step() {
        if (pend) { titem_finish(it, v, scr, F.lane); pend = false; }
        if (idx < end) { it = decode_item(F, base + idx, l); titem_load(it, v, F.lane); pend = true; idx += stride; }
    }
    __device__ __forceinline__ void drain() {
        for (;;) {
            if (pend) { titem_finish(it, v, scr, F.lane); pend = false; }
            if (idx >= end) break;
            it = decode_item(F, base + idx, l); titem_load(it, v, F.lane); pend = true; idx += stride;
        }
    }
};
struct BgNone { __device__ __forceinline__ void tick() {} };

__device__ __forceinline__ void phase_prologue(const Ctx& F0) {
    const Ctx F = phase_ctx(F0);
    LAS float* sc = (LAS float*)(F.lds + 8 * 16384 - 32768);
    LAS int* qctl = (LAS int*)(F.lds + XS_OFF);
    const float* c = F.in[1];
    if (F.tid < 3) qctl[F.tid] = 0;
    for (int i = F.tid; i < 8 * 1024; i += NTHREADS) { const float cv = c[i]; sc[i] = cv / (1.f + expf(-cv)); }
    __syncthreads();
    float* MOD = (float*)(F.ws + WS_MOD);
    LAS float* red = (LAS float*)(F.lds + 67584);
    if (F.wave < 4) {
        int seq = 0;
        for (int task = F.vcu; task < MODW / 64; task += F.G) {
            ++seq;
            const int j = task * 64 + F.lane;
            const float* W; int nc, jj; float bias;
            if (j < 12288) { const int l = j / 6144; jj = j % 6144; W = F.in[3] + (size_t)l * 1024 * 6144; nc = 6144; bias = F.in[4][l * 6144 + jj]; }
            else { jj = j - 12288; W = F.in[11]; nc = 2048; bias = F.in[12][jj]; }
            float acc[8];
#pragma unroll
            for (int b = 0; b < 8; ++b) acc[b] = 0.f;
            const int kbeg = F.wave * 256;
#pragma unroll 1
            for (int k0 = kbeg; k0 < kbeg + 256; k0 += 16) {
                float w[16];
#pragma unroll
                for (int q = 0; q < 16; ++q) w[q] = __builtin_nontemporal_load(W + (size_t)(k0 + q) * nc + jj);
#pragma unroll
                for (int q4 = 0; q4 < 4; ++q4)
#pragma unroll
                    for (int b = 0; b < 8; ++b) { const f32x4 s4 = *(const LAS f32x4*)(sc + b * 1024 + k0 + 4 * q4);
                        acc[b] += s4.x * w[4 * q4]; acc[b] += s4.y * w[4 * q4 + 1]; acc[b] += s4.z * w[4 * q4 + 2]; acc[b] += s4.w * w[4 * q4 + 3]; }
            }
            if (F.wave != 0) {
                while (__hip_atomic_load(qctl + 2, __ATOMIC_RELAXED, __HIP_MEMORY_SCOPE_WORKGROUP) != seq - 1) __builtin_amdgcn_s_sleep(2);
#pragma unroll
                for (int b = 0; b < 8; ++b) red[((F.wave - 1) * 8 + b) * 64 + F.lane] = acc[b];
                asm volatile("s_waitcnt lgkmcnt(0)" ::: "memory");
                if (F.lane == 0) __hip_atomic_fetch_add(qctl + 1, 1, __ATOMIC_RELEASE, __HIP_MEMORY_SCOPE_WORKGROUP);
            } else {
                while (__hip_atomic_load(qctl + 1, __ATOMIC_ACQUIRE, __HIP_MEMORY_SCOPE_WORKGROUP) != 3 * seq) __builtin_amdgcn_s_sleep(2);
#pragma unroll
                for (int b = 0; b < 8; ++b) MOD[b * MODW + j] = (((acc[b] + red[(0 * 8 + b) * 64 + F.lane]) + red[(1 * 8 + b) * 64 + F.lane]) + red[(2 * 8 + b) * 64 + F.lane]) + bias;
                asm volatile("s_waitcnt lgkmcnt(0)" ::: "memory");
                if (F.lane == 0) __hip_atomic_store(qctl + 2, seq, __ATOMIC_RELEASE, __HIP_MEMORY_SCOPE_WORKGROUP);
            }
        }
    }
    LAS float* scr = (LAS float*)(F.lds + F.wave * 8448);
    {
        constexpr int NITEMS = NITEMS_P0 - I_DNL;
#define P0_IDX(i) ((i) < I_GUL ? (i) : (i) + I_DNL)
#define P0_GRAB(dst) do { int s_ = 0; if (F.lane == 0) s_ = __hip_atomic_fetch_add(qctl, 1, __ATOMIC_RELAXED, __HIP_MEMORY_SCOPE_WORKGROUP); s_ = __builtin_amdgcn_readfirstlane(s_); dst = (F.vcu + (s_ >> 3) * F.G) * 8 + (s_ & 7); } while (0)
        f32x4 va[8], vb[8]; TItem ta, tb;
        int it; P0_GRAB(it);
        if (it < NITEMS) { ta = decode_item(F, P0_IDX(it), 0); titem_load(ta, va, F.lane); }
        while (it < NITEMS) {
            int itn; P0_GRAB(itn);
            if (itn < NITEMS) { tb = decode_item(F, P0_IDX(itn), 0); titem_load(tb, vb, F.lane); }
            titem_finish(ta, va, scr, F.lane);
            if (itn >= NITEMS) break;
            int itn2; P0_GRAB(itn2);
            if (itn2 < NITEMS) { ta = decode_item(F, P0_IDX(itn2), 0); titem_load(ta, va, F.lane); }
            titem_finish(tb, vb, scr, F.lane);
            it = itn2;
        }
#undef P0_GRAB
    }
}

__device__ __forceinline__ void modnorm_row(const float* xrow, const float* g, const float* sc, const float* sh, bf16_t* orow, int lane) {
    const GAS f32x4* xr = (const GAS f32x4*)xrow + lane;
    f32x4 v[4]; float s2 = 0.f;
#pragma unroll
    for (int j = 0; j < 4; ++j) { v[j] = xr[64 * j]; s2 += (v[j].x * v[j].x + v[j].y * v[j].y) + (v[j].z * v[j].z + v[j].w * v[j].w); }
    const float rstd = rsqrtf(wave_sum(s2) * (1.f / 1024.f) + EPS);
    GAS u32x2* o8 = (GAS u32x2*)orow + lane;
#pragma unroll
    for (int j = 0; j < 4; ++j) {
        const f32x4 gg = ((const GAS f32x4*)g)[lane + 64 * j], ss = ((const GAS f32x4*)sc)[lane + 64 * j], hh = ((const GAS f32x4*)sh)[lane + 64 * j];
        const f32x4 o = v[j] * rstd * gg * (ss + 1.f) + hh;
        u32x2 w; w.x = pk2(o.x, o.y); w.y = pk2(o.z, o.w); o8[64 * j] = w;
    }
}
constexpr int I_FOLD1 = 16 * 9 + 16 * 12, I_FOLD = 8 * I_FOLD1;
__device__ __forceinline__ float sum8(float v) { v += dppf(v, 0); v += dppf(v, 1); return v + dppf(v, 2); }
__device__ __forceinline__ void fold_item(const Ctx& F, int idx, LAS float* scr) {
    const int lane = F.lane, b = idx / I_FOLD1; int r = idx % I_FOLD1;
    const float* MOD = (const float*)(F.ws + WS_MOD) + b * MODW;
    int w, kb, db, ldw; const float *W, *sg, *ssc, *ssh;
    if (r < 144) { w = 0; kb = r / 9; db = r % 9; W = F.in[14]; ldw = 288; sg = F.in[13]; ssc = MOD + 12288 + 1024; ssh = MOD + 12288; }
    else { r -= 144; w = 1; kb = r / 12; db = r % 12; W = F.in[19]; ldw = 384; sg = F.in[5] + 1024; ssc = MOD + 6144 + 1024; ssh = MOD + 6144; }
    const int k0 = kb * 64, c = lane & 7;
    f32x4 v[8];
#pragma unroll
    for (int i = 0; i < 8; ++i) v[i] = *(const GAS f32x4*)(W + (size_t)(k0 + 8 * i + (lane >> 3)) * ldw + db * 32 + 4 * c);
    float A[8], H[8];
    { const f32x4 g0 = *(const GAS f32x4*)(sg + k0 + 8 * c), g1 = *(const GAS f32x4*)(sg + k0 + 8 * c + 4), s0 = *(const GAS f32x4*)(ssc + k0 + 8 * c), s1 = *(const GAS f32x4*)(ssc + k0 + 8 * c + 4);
      const f32x4 h0 = *(const GAS f32x4*)(ssh + k0 + 8 * c), h1 = *(const GAS f32x4*)(ssh + k0 + 8 * c + 4);
      const f32x4 a0 = g0 * (s0 + 1.f), a1 = g1 * (s1 + 1.f);
      A[0] = a0.x; A[1] = a0.y; A[2] = a0.z; A[3] = a0.w; A[4] = a1.x; A[5] = a1.y; A[6] = a1.z; A[7] = a1.w;
      H[0] = h0.x; H[1] = h0.y; H[2] = h0.z; H[3] = h0.w; H[4] = h1.x; H[5] = h1.y; H[6] = h1.z; H[7] = h1.w; }
#pragma unroll
    for (int i = 0; i < 8; ++i) { LAS float* d = scr + (8 * i + (lane >> 3)) * 33 + 4 * c; d[0] = v[i].x; d[1] = v[i].y; d[2] = v[i].z; d[3] = v[i].w; }
    asm volatile("s_waitcnt lgkmcnt(0)" ::: "memory");
    bf16_t* WT = (bf16_t*)(F.ws + WS_W8) + (size_t)(w * 8 + b) * 512 * 1024;
    float* PB = (float*)(F.ws + WS_PB) + ((size_t)((b * 2 + w) * 16 + kb)) * 512 + db * 32;
#pragma unroll
    for (int j = 0; j < 4; ++j) { const int n = (lane >> 3) + 8 * j; const LAS float* sp = scr + (8 * c) * 33 + n;
        float f[8];
#pragma unroll
        for (int q = 0; q < 8; ++q) f[q] = sp[q * 33];
        float pb = 0.f;
#pragma unroll
        for (int q = 0; q < 8; ++q) { pb += f[q] * H[q]; f[q] *= A[q]; }
        u32x4 o; o.x = pk2(f[0], f[1]); o.y = pk2(f[2], f[3]); o.z = pk2(f[4], f[5]); o.w = pk2(f[6], f[7]);
        *(GAS u32x4*)(WT + (size_t)(db * 32 + n) * 1024 + k0 + 8 * c) = o;
        pb = sum8(pb);
        if (c == 0) PB[n] = pb;
    }
    asm volatile("s_waitcnt lgkmcnt(0)" ::: "memory");
}

__device__ __forceinline__ void phase_norm1(const Ctx& F0) {
    const Ctx F = phase_ctx(F0);
    const int gw = F.vcu * NWAVES + F.wave, NGW = F.G * NWAVES, lane = F.lane;
    const float* MOD = (const float*)(F.ws + WS_MOD);
    bf16_t* XN = (bf16_t*)(F.ws + WS_XN);
    const float* x = F.in[0]; const float* g = F.in[5];
    for (int idx = gw; idx < I_FOLD; idx += NGW) fold_item(F, idx, (LAS float*)(F.lds + F.wave * 8448));
    for (int base = gw * 8; base < NT; base += NGW * 8) {
        const int b = base / SEQ;
        const float* sc = MOD + b * MODW + 1024; const float* sh = MOD + b * MODW;
        f32x4 Aw[4], Bw[4];
#pragma unroll
        for (int q = 0; q < 4; ++q) { const int c0 = 16 * lane + 4 * q;
            const f32x4 gg = *(const GAS f32x4*)(g + c0), ss = *(const GAS f32x4*)(sc + c0);
            Aw[q] = gg * (ss + 1.f); Bw[q] = *(const GAS f32x4*)(sh + c0); }
        f32x4 v[4];
#pragma unroll
        for (int q = 0; q < 4; ++q) v[q] = *(const GAS f32x4*)(x + (size_t)base * 1024 + 16 * lane + 4 * q);
#pragma unroll 1
        for (int ti = 0; ti < 8; ++ti) {
            const int m = base + ti, mn = ti < 7 ? m + 1 : m;
            f32x4 vn[4];
#pragma unroll
            for (int q = 0; q < 4; ++q) vn[q] = *(const GAS f32x4*)(x + (size_t)mn * 1024 + 16 * lane + 4 * q);
            float s2 = 0.f;
#pragma unroll
            for (int q = 0; q < 4; ++q) s2 += (v[q].x * v[q].x + v[q].y * v[q].y) + (v[q].z * v[q].z + v[q].w * v[q].w);
            const float rstd = rsqrtf(wave_sum(s2) * (1.f / 1024.f) + EPS);
            unsigned wq[8];
#pragma unroll
            for (int q = 0; q < 4; ++q) { const f32x4 o = v[q] * rstd * Aw[q] + Bw[q]; wq[2 * q] = pk2(o.x, o.y); wq[2 * q + 1] = pk2(o.z, o.w); }
            u32x4 w0, w1; w0.x = wq[0]; w0.y = wq[1]; w0.z = wq[2]; w0.w = wq[3]; w1.x = wq[4]; w1.y = wq[5]; w1.z = wq[6]; w1.w = wq[7];
            bf16_t* o = XN + (size_t)m * 1024 + 16 * lane;
            *(GAS u32x4*)(o) = w0; *(GAS u32x4*)(o + 8) = w1;
#pragma unroll
            for (int q = 0; q < 4; ++q) v[q] = vn[q];
        }
    }
}


__device__ __forceinline__ void load_tables(const Ctx& F0, int l) {
    const Ctx F = phase_ctx(F0);
    LAS int* tab = (LAS int*)(F.lds + LDSCTL_OFF);
    const int* ctl = (const int*)(F.ws + WS_CTL);
    __syncthreads();
    if (F.wave == 0) {
        const int c = ctl[CW_ECNTF + 128 * l + F.lane];
        const int pc = ((c + 255) >> 8) << 8;
        tab[256 + F.lane] = pc; tab[128 + F.lane] = c;
        asm volatile("s_waitcnt lgkmcnt(0)" ::: "memory");
        int x = 0;
        for (int j = 0; j < 64; ++j) { const int y = tab[256 + j]; if (j < F.lane) x += y; }
        tab[F.lane] = x; if (F.lane == 63) tab[64] = x + pc;
    }
    __syncthreads();
}

__device__ __forceinline__ void phase_route(const Ctx& F0, int l, const bf16_t* X) {
    const Ctx F = phase_ctx(F0);
    const float* MOD = (const float*)(F.ws + WS_MOD);
    const float* g = F.in[6] + l * 1024; const float* rb = F.in[25] + l * 64;
    bf16_t* XN = (bf16_t*)(F.ws + WS_XN);
    const bf16_t* Whi = (const bf16_t*)(F.ws + WS_WR) + (size_t)(l * 2) * 64 * 1024; const bf16_t* Wlo = Whi + 64 * 1024;
    int* TOPI = (int*)(F.ws + WS_TOPI); float* TOPW = (float*)(F.ws + WS_TOPW); int* LP = (int*)(F.ws + WS_PPOS); int* LT2 = (int*)(F.ws + WS_LT2);
    unsigned* ecnt = (unsigned*)(F.ws + WS_CTL) + CW_ECNTF + 128 * l;
    LAS float* part = (LAS float*)(F.lds);
    LAS int* hist = (LAS int*)(F.lds + 65536); LAS int* gbase = (LAS int*)(F.lds + 65536 + 256);
    const int lane = F.lane;
    for (int bt = F.vcu; bt < NT / 64; bt += F.G) {
        if (F.tid < 64) hist[F.tid] = 0;
        const int tokb = bt * 64, tok0 = tokb + F.wave * 8, b = tok0 / SEQ;
        const float* sc = MOD + b * MODW + l * 6144 + 4096; const float* sh = MOD + b * MODW + l * 6144 + 3072;
        {
            f32x4 Aw[4], Bw[4];
#pragma unroll
            for (int q = 0; q < 4; ++q) { const int c0 = 16 * lane + 4 * q;
                const f32x4 gg = *(const GAS f32x4*)(g + c0), ss = *(const GAS f32x4*)(sc + c0);
                Aw[q] = gg * (ss + 1.f); Bw[q] = *(const GAS f32x4*)(sh + c0); }
            u32x4 xa = *(const GAS u32x4*)(X + (size_t)tok0 * 1024 + 16 * lane), xb = *(const GAS u32x4*)(X + (size_t)tok0 * 1024 + 16 * lane + 8);
#pragma unroll 1
            for (int ti = 0; ti < 8; ++ti) {
                const int tok = tok0 + ti, tokn = ti < 7 ? tok + 1 : tok;
                const u32x4 xan = *(const GAS u32x4*)(X + (size_t)tokn * 1024 + 16 * lane), xbn = *(const GAS u32x4*)(X + (size_t)tokn * 1024 + 16 * lane + 8);
                const unsigned xw[8] = {xa.x, xa.y, xa.z, xa.w, xb.x, xb.y, xb.z, xb.w};
                f32x4 v[4]; float s2 = 0.f;
#pragma unroll
                for (int q = 0; q < 4; ++q) { v[q] = (f32x4){__uint_as_float(xw[2 * q] << 16), __uint_as_float(xw[2 * q] & 0xffff0000u), __uint_as_float(xw[2 * q + 1] << 16), __uint_as_float(xw[2 * q + 1] & 0xffff0000u)};
                    s2 += (v[q].x * v[q].x + v[q].y * v[q].y) + (v[q].z * v[q].z + v[q].w * v[q].w); }
                const float rstd = rsqrtf(wave_sum(s2) * (1.f / 1024.f) + EPS);
                unsigned wq[8];
#pragma unroll
                for (int q = 0; q < 4; ++q) { const f32x4 o = v[q] * rstd * Aw[q] + Bw[q]; wq[2 * q] = pk2(o.x, o.y); wq[2 * q + 1] = pk2(o.z, o.w); }
                u32x4 w0, w1; w0.x = wq[0]; w0.y = wq[1]; w0.z = wq[2]; w0.w = wq[3]; w1.x = wq[4]; w1.y = wq[5]; w1.z = wq[6]; w1.w = wq[7];
                bf16_t* o = XN + (size_t)tok * 1024 + 16 * lane;
                *(GAS u32x4*)(o) = w0; *(GAS u32x4*)(o + 8) = w1;
                xa = xan; xb = xbn;
            }
        }
        asm volatile("s_waitcnt vmcnt(0)" ::: "memory");
        __syncthreads();
        {
            const int ksl = F.wave & 3, th = F.wave >> 2;
            f32x4 acc[2][4];
#pragma unroll
            for (int tt = 0; tt < 2; ++tt)
#pragma unroll
                for (int et = 0; et < 4; ++et) acc[tt][et] = (f32x4){0.f, 0.f, 0.f, 0.f};
            const size_t aoffs = (size_t)(tokb + th * 32 + (lane & 15)) * 1024 + ksl * 256 + 8 * (lane >> 4);
            const size_t boffs = (size_t)(lane & 15) * 1024 + ksl * 256 + 8 * (lane >> 4);
#pragma unroll 2
            for (int ks = 0; ks < 8; ++ks) {
                bf16x8 ah[2];
#pragma unroll
                for (int tt = 0; tt < 2; ++tt) ah[tt] = *(const GAS bf16x8*)(XN + aoffs + (size_t)tt * 16 * 1024 + ks * 32);
#pragma unroll
                for (int et = 0; et < 4; ++et) {
                    const bf16x8 bh = *(const GAS bf16x8*)(Whi + boffs + (size_t)et * 16 * 1024 + ks * 32), bl = *(const GAS bf16x8*)(Wlo + boffs + (size_t)et * 16 * 1024 + ks * 32);
#pragma unroll
                    for (int tt = 0; tt < 2; ++tt) {
                        acc[tt][et] = __builtin_amdgcn_mfma_f32_16x16x32_bf16(ah[tt], bh, acc[tt][et], 0, 0, 0);
                        acc[tt][et] = __builtin_amdgcn_mfma_f32_16x16x32_bf16(ah[tt], bl, acc[tt][et], 0, 0, 0);
                    }
                }
            }
#pragma unroll
            for (int tt = 0; tt < 2; ++tt)
#pragma unroll
                for (int et = 0; et < 4; ++et)
#pragma unroll
                    for (int r = 0; r < 4; ++r) part[(ksl * 64 + th * 32 + tt * 16 + (lane >> 4) * 4 + r) * 64 + et * 16 + (lane & 15)] = acc[tt][et][r];
        }
        __syncthreads();
        const float bias = rb[lane];
        LAS unsigned* pk = (LAS unsigned*)(F.lds + 69632 + F.wave * 4096);
        LAS float* wf = (LAS float*)(F.lds + 69632 + F.wave * 4096 + 2048);
        int running = 0;
#pragma unroll 1
        for (int ti = 0; ti < 8; ++ti) {
            const int tl = F.wave * 8 + ti;
            const float logit = ((part[(0 * 64 + tl) * 64 + lane] + part[(1 * 64 + tl) * 64 + lane]) + part[(2 * 64 + tl) * 64 + lane]) + part[(3 * 64 + tl) * 64 + lane];
            const float score = 1.f / (1.f + expf(-logit));
            bool sel; int jr; float w;
            nv::route_lane(score, bias, lane, sel, jr, w);
            pk[ti * 64 + lane] = sel ? (0x80000000u | ((unsigned)jr << 16) | (unsigned)running) : 0u; wf[ti * 64 + lane] = w;
            running += sel ? 1 : 0;
        }
        const int wbase = __hip_atomic_fetch_add(hist + lane, running, __ATOMIC_RELAXED, __HIP_MEMORY_SCOPE_WORKGROUP);
        __syncthreads();
        if (F.wave == 0) { const int h = hist[lane]; gbase[lane] = (int)__hip_atomic_fetch_add(ecnt + lane, (unsigned)h, __ATOMIC_RELAXED, __HIP_MEMORY_SCOPE_AGENT); }
        __syncthreads();
        const int gb = gbase[lane] + wbase;
#pragma unroll 1
        for (int ti = 0; ti < 8; ++ti) {
            const unsigned v = pk[ti * 64 + lane];
            if (v & 0x80000000u) {
                const int tok = tok0 + ti, jr = (int)((v >> 16) & 0xffu), lp = gb + (int)(v & 0xffffu);
                TOPI[tok * 6 + jr] = lane; TOPW[tok * 6 + jr] = wf[ti * 64 + lane]; LP[tok * 6 + jr] = lp; LT2[lane * 16384 + lp] = tok;
            }
        }
        __syncthreads();
    }
}

template <bool LAST>
__device__ __forceinline__ void phase_combine(const Ctx& F0, int l, const bf16_t* Xin, void* Xout) {
    const Ctx F = phase_ctx(F0);
    load_tables(F, l);
    const LAS int* tab = (const LAS int*)(F.lds + LDSCTL_OFF);
    const float* MOD = (const float*)(F.ws + WS_MOD);
    const unsigned char* YB = (const unsigned char*)(F.ws + WS_YB);
    const int* TOPI = (const int*)(F.ws + WS_TOPI); const float* TOPW = (const float*)(F.ws + WS_TOPW); const int* LP = (const int*)(F.ws + WS_PPOS);
    float* RSTD = (float*)(F.ws + WS_RSTD); float* ROPE = (float*)(F.ws + WS_ROPE); const int* posp = (const int*)F.in[2];
    const int gw = F.vcu * NWAVES + F.wave, NGW = F.G * NWAVES, lane = F.lane;
    const float inv = powf(10000.f, -(float)(lane & 15) / 16.f);
    if (!LAST && F.wave == 0) {
        const float* PB = (const float*)(F.ws + WS_PB); float* CB = (float*)(F.ws + WS_CB);
        for (int t = F.vcu; t < 128; t += F.G) { const int o = t * 64 + lane, n = o & 511, w = (o >> 9) & 1;
            float sacc = 0.f;
            if (n < (w ? 384 : 288)) {
#pragma unroll
                for (int kb = 0; kb < 16; ++kb) sacc += PB[((size_t)(o >> 9) * 16 + kb) * 512 + n]; }
            CB[o] = sacc; }
    }
    for (int base = gw * 8; base < NT; base += NGW * 8) {
        const int b = base / SEQ;
        f32x4 gate[4];
#pragma unroll
        for (int q = 0; q < 4; ++q) gate[q] = *(const GAS f32x4*)(MOD + b * MODW + l * 6144 + 5120 + 16 * lane + 4 * q);
        u32x4 y[7], xa, xb; float w[7];
#define CMB_LOAD(TOK, Y, W, XA, XB) do { const int tk_ = (TOK); _Pragma("unroll") for (int j = 0; j < 7; ++j) { int p; \
            if (j < 6) { const int e = TOPI[tk_ * 6 + j]; p = tab[e] + LP[tk_ * 6 + j]; W[j] = TOPW[tk_ * 6 + j] * (1.f / pg8::YB_SCALE); } else { p = PMAX + tk_; W[j] = 1.f / pg8::YB_SCALE; } \
            Y[j] = __builtin_nontemporal_load((const GAS u32x4*)(YB + (size_t)p * 1024 + 16 * lane)); }     \
            { const size_t off_ = (size_t)tk_ * 1024 + 16 * lane; XA = *(const GAS u32x4*)(Xin + off_); XB = *(const GAS u32x4*)(Xin + off_ + 8); } } while (0)
        CMB_LOAD(base, y, w, xa, xb);
#pragma unroll 1
        for (int ti = 0; ti < 8; ++ti) {
            const int tok = base + ti;
            u32x4 yn[7], xan, xbn; float wn[7];
            CMB_LOAD(ti < 7 ? tok + 1 : tok, yn, wn, xan, xbn);
            f32x4 a[4];
#pragma unroll
            for (int q = 0; q < 4; ++q) a[q] = (f32x4){0.f, 0.f, 0.f, 0.f};
#pragma unroll
            for (int j = 0; j < 7; ++j) {
                const unsigned yw[4] = {y[j].x, y[j].y, y[j].z, y[j].w};
#pragma unroll
                for (int q = 0; q < 4; ++q) { const f32x2 lo = __builtin_amdgcn_cvt_pk_f32_fp8((int)yw[q], false), hi = __builtin_amdgcn_cvt_pk_f32_fp8((int)yw[q], true);
                    a[q][0] += w[j] * lo.x; a[q][1] += w[j] * lo.y; a[q][2] += w[j] * hi.x; a[q][3] += w[j] * hi.y; }
            }
            float s2 = 0.f;
            { const size_t off = (size_t)tok * 1024 + 16 * lane;
              const unsigned xw[8] = {xa.x, xa.y, xa.z, xa.w, xb.x, xb.y, xb.z, xb.w};
#pragma unroll
              for (int q = 0; q < 4; ++q) {
                  const f32x4 xi = (f32x4){__uint_as_float(xw[2 * q] << 16), __uint_as_float(xw[2 * q] & 0xffff0000u), __uint_as_float(xw[2 * q + 1] << 16), __uint_as_float(xw[2 * q + 1] & 0xffff0000u)};
                  const f32x4 xo = xi + gate[q] * a[q];
                  a[q] = xo;
                  if (LAST) *(GAS f32x4*)((float*)Xout + off + 4 * q) = xo;
                  s2 += (xo.x * xo.x + xo.y * xo.y) + (xo.z * xo.z + xo.w * xo.w);
              }
              if (!LAST) { u32x4 w0, w1; w0.x = pk2(a[0].x, a[0].y); w0.y = pk2(a[0].z, a[0].w); w0.z = pk2(a[1].x, a[1].y); w0.w = pk2(a[1].z, a[1].w);
                  w1.x = pk2(a[2].x, a[2].y); w1.y = pk2(a[2].z, a[2].w); w1.z = pk2(a[3].x, a[3].y); w1.w = pk2(a[3].z, a[3].w);
                  *(GAS u32x4*)((bf16_t*)Xout + off) = w0; *(GAS u32x4*)((bf16_t*)Xout + off + 8) = w1; }
            }
            if (!LAST) {
                const float rstd = rsqrtf(wave_sum(s2) * (1.f / 1024.f) + EPS);
                if (lane == 0) RSTD[tok] = rstd;
                if (lane < 16) { const float ang = (float)posp[tok] * inv; ROPE[(size_t)tok * 16 + lane] = cosf(ang); ROPE[(size_t)NT * 16 + (size_t)tok * 16 + lane] = sinf(ang); }
            }
#pragma unroll
            for (int j = 0; j < 7; ++j) { y[j] = yn[j]; w[j] = wn[j]; }
            xa = xan; xb = xbn;
        }
#undef CMB_LOAD
    }
}

__device__ __forceinline__ void phase_latent(const Ctx& F0) {
    const Ctx F = phase_ctx(F0);
    const bf16_t* DKV = (const bf16_t*)(F.ws + WS_DKV); const bf16_t* DQ = (const bf16_t*)(F.ws + WS_DQ);
    bf16_t* CKV = (bf16_t*)(F.ws + WS_CKV); bf16_t* CQ = (bf16_t*)(F.ws + WS_CQ);
    float* KPR = (float*)(F.ws + WS_KPR); float* KPSS = (float*)(F.ws + WS_KPSS); float* ROPE = (float*)(F.ws + WS_ROPE);
    const float* g_lat = F.in[15]; const float* g_k = F.in[18]; const float* g_ql = F.in[20]; const int* pos = (const int*)F.in[2];
    const int gw = F.vcu * NWAVES + F.wave, NGW = F.G * NWAVES, lane = F.lane;
    const f32x4 glat = *(const GAS f32x4*)(g_lat + 4 * lane), gq0 = *(const GAS f32x4*)(g_ql + 4 * lane);
    const f32x2 gq1 = *(const GAS f32x2*)(g_ql + 256 + 2 * lane);
    const float gk_pe = lane < 32 ? g_k[64 + lane] : 0.f;
    const float inv = powf(10000.f, -(float)(lane & 15) / 16.f);
    for (int row = gw; row < NT; row += NGW) {
        const u32x2 d = *(const GAS u32x2*)(DKV + (size_t)row * 512 + 4 * lane);
        f32x4 v; v.x = __uint_as_float(d.x << 16); v.y = __uint_as_float(d.x & 0xffff0000u); v.z = __uint_as_float(d.y << 16); v.w = __uint_as_float(d.y & 0xffff0000u);
        const float r = rsqrtf(wave_sum((v.x * v.x + v.y * v.y) + (v.z * v.z + v.w * v.w)) * (1.f / 256.f) + EPS);
        const f32x4 o = v * r * glat;
        u32x2 wv; wv.x = pk2(o.x, o.y); wv.y = pk2(o.z, o.w); *(GAS u32x2*)(CKV + (size_t)row * 256 + 4 * lane) = wv;
        const float kp = lane < 32 ? bf2f(DKV[(size_t)row * 512 + 256 + lane]) : 0.f;
        const float kss = wave_sum(kp * kp);
        const float ang = (float)pos[row] * inv, cs = cosf(ang), sn = sinf(ang);
        const float kg = kp * gk_pe; float kx; { const auto rr = __builtin_amdgcn_permlane16_swap(__float_as_int(kg), __float_as_int(kg), false, false); kx = (lane & 16) ? __int_as_float(rr[0]) : __int_as_float(rr[1]); }
        if (lane == 0) KPSS[row] = kss;
        if (lane < 32) KPR[(size_t)row * 32 + lane] = (lane < 16) ? (kg * cs - kx * sn) : (kx * sn + kg * cs);
        if (lane < 16) { ROPE[(size_t)row * 16 + lane] = cs; ROPE[(size_t)NT * 16 + (size_t)row * 16 + lane] = sn; }
        const u32x2 q = *(const GAS u32x2*)(DQ + (size_t)row * 512 + 4 * lane); const unsigned q1 = *(const GAS unsigned*)(DQ + (size_t)row * 512 + 256 + 2 * lane);
        f32x4 qa; qa.x = __uint_as_float(q.x << 16); qa.y = __uint_as_float(q.x & 0xffff0000u); qa.z = __uint_as_float(q.y << 16); qa.w = __uint_as_float(q.y & 0xffff0000u);
        f32x2 qb; qb.x = __uint_as_float(q1 << 16); qb.y = __uint_as_float(q1 & 0xffff0000u);
        const float r2 = rsqrtf(wave_sum((qa.x * qa.x + qa.y * qa.y) + (qa.z * qa.z + qa.w * qa.w) + (qb.x * qb.x + qb.y * qb.y)) * (1.f / 384.f) + EPS);
        const f32x4 oa = qa * r2 * gq0; const f32x2 ob = qb * r2 * gq1;
        u32x2 wq; wq.x = pk2(oa.x, oa.y); wq.y = pk2(oa.z, oa.w); *(GAS u32x2*)(CQ + (size_t)row * 384 + 4 * lane) = wq;
        *(GAS unsigned*)(CQ + (size_t)row * 384 + 256 + 2 * lane) = pk2(ob.x, ob.y);
    }
}

__global__ void __launch_bounds__(NTHREADS, 2) fwd(Args args) {
    extern __shared__ __attribute__((aligned(16))) unsigned char lds_raw[];
    Ctx F;
    F.lds = (LAS unsigned char*)lds_raw;
    F.tid = threadIdx.x; F.lane = F.tid & 63; F.wave = __builtin_amdgcn_readfirstlane(F.tid >> 6);
    F.G = gridDim.x; { const int bx = blockIdx.x; F.vcu = (F.G % 8 == 0) ? (bx % 8) * (F.G / 8) + bx / 8 : bx; }
    F.ws = args.ws; F.in = args.in; F.out = args.out;
    volatile LAS unsigned* MISC = (volatile LAS unsigned*)(F.lds + MISC_OFF);
    for (int u = F.tid; u < (LDS_BYTES - LDSCTL_OFF) / 4; u += NTHREADS) ((LAS unsigned*)(F.lds + LDSCTL_OFF))[u] = 0u;
    __syncthreads();
    const int lo = args.ph_lo, hi = args.ph_hi;
    const bool single = (hi - lo) > 1;
    unsigned* barw = (unsigned*)(F.ws + WS_CTL) + CW_BAR;
    XcdBarrier bar; bar.bar = barw; bar.x = 0; bar.st = nullptr;
    if (single) bar = xcd_barrier_post(barw, MISC + 8);
#define IN(k) (lo <= (k) && (k) < hi)
#define SEAM(k) do { if (IN(k) && IN((k) + 1)) xcd_barrier(bar); } while (0)
#ifndef MK_REPMASK
#define MK_REPMASK 0u
#endif
#define REPS(k) ((((unsigned)(MK_REPMASK) >> (k)) & 1u) ? 2 : 1)
#define RUN(k) for (int rep_ = (IN(k) ? REPS(k) : 0); rep_ > 0; (--rep_ > 0 ? xcd_barrier(bar) : (void)0))
#define PH const Ctx P = phase_ctx(F); const char* wsc = (const char*)P.ws; bf16_t* X1 = (bf16_t*)(P.ws + WS_X1); bf16_t* X2 = (bf16_t*)(P.ws + WS_X2); bf16_t* X3 = X1; (void)wsc; (void)X1; (void)X2; (void)X3

#ifdef MK_XBAR
    if (single) for (int xb_ = 0; xb_ < MK_XBAR; ++xb_) xcd_barrier(bar);
#endif
    RUN(0) { phase_prologue(F); } SEAM(0);
    RUN(1) { phase_norm1(F); } SEAM(1);
    RUN(2) { PH;
        pg8::DenseSched S; S.init(3072, 1024, F.G, (int)blockIdx.x, (unsigned)WS_XN, P.ws + WS_WQKV);
        pg8::EpiQKV E{(bf16_t*)(P.ws + WS_QB), P.in[8], P.in[9]};
        pg8::gemm_phase<pg8::EpiQKV, pg8::DenseSched, true>(F.lds, wsc, 1024, S, E);
    } SEAM(2);
    if (IN(3) || IN(4)) {
        PH;
        int tid3 = threadIdx.x; asm volatile("" : "+v"(tid3));
        const int half = __builtin_amdgcn_readfirstlane(tid3 >> 8), hw = __builtin_amdgcn_readfirstlane((tid3 >> 6) & 3), lane3 = tid3 & 63;
        LAS unsigned char* hl = F.lds + half * 65536; LAS float* xs = (LAS float*)(F.lds + XS_OFF + half * 2048);
        const bf16_t* QB = (const bf16_t*)(P.ws + WS_QB); const bf16_t* KB = (const bf16_t*)(P.ws + WS_KB); const bf16_t* VB = (const bf16_t*)(P.ws + WS_VB);
        bf16_t* PART = (bf16_t*)(P.ws + WS_PART); float* LSE = (float*)(P.ws + WS_LSE); const int* pos = (const int*)P.in[2];
#define DIL_RUN(MERGEV, FIRST, LAST, DECODE, PARTG, LSEG, P0V, P1V, L0V, L1V, OBV, BGH) do { \
            constexpr bool PF_ = !(MERGEV);                          \
            at::DilStage st; at::DilU u; int pair = (FIRST); \
            _Pragma("unroll") for (int z_ = 0; z_ < 8; ++z_) { st.kk[z_] = (u32x4){0u, 0u, 0u, 0u}; st.vv[z_] = (u32x4){0u, 0u, 0u, 0u}; } st.pk = 0; \
            if (PF_ && pair < (LAST)) { DECODE(pair, u); at::dil_load_k(st, u, hw, lane3, KB, pos); at::dil_load_v(st, u, hw, lane3, VB); } \
            _Pragma("unroll 1") for (; pair < (LAST); ++pair) { \
                int ln_ = lane3; asm volatile("" : "+v"(ln_));     \
                if (!PF_) { DECODE(pair, u); if (!(ABL3 & 2)) { at::dil_load_k(st, u, hw, ln_, KB, pos); at::dil_load_v(st, u, hw, ln_, VB); } } \
                at::dil_write(st, u, hl, xs, hw, ln_); \
                const int tokq_ = (128 * u.n + 32 * hw + (ln_ & 31)) * u.dil + u.r; \
                bf16x8 qr_[4]; \
                _Pragma("unroll") for (int d0 = 0; d0 < 4; ++d0) qr_[d0] = *(const GAS bf16x8*)(QB + (size_t)(u.b * SEQ + tokq_) * 1024 + u.h * 64 + 16 * d0 + 8 * (ln_ >> 5)); \
                const float posq_ = (float)pos[u.b * SEQ + tokq_]; \
                __syncthreads(); \
                asm volatile("" :: "v"(qr_[0]), "v"(qr_[1]), "v"(qr_[2]), "v"(qr_[3]), "v"(posq_));     \
                BGH; \
                const at::DilU uc = u; \
                const bool more_ = PF_ && (pair + 1 < (LAST)) && !(ABL3 & 2); \
                if (more_) { DECODE(pair + 1, u); at::dil_load_k(st, u, hw, ln_, KB, pos); }     \
                at::dil_compute<MERGEV, false>(hl, xs, hw, 0, ln_, uc, qr_, posq_, PARTG(uc), LSEG(uc), P0V, P1V, L0V, L1V, OBV, ABL3); \
                if (more_) at::dil_load_v(st, u, hw, ln_, VB);                                    \
                BGH; \
                __syncthreads(); \
            } } while (0)
#define DEC3(pr, uu) do { const int u_ = (pr) * 2 + half, bh_ = u_ >> 5, rem_ = u_ & 31, g_ = rem_ >> 4, idx_ = rem_ & 15; \
            (uu).b = bh_ >> 4; (uu).h = bh_ & 15; (uu).dil = g_ ? 4 : 1; (uu).r = g_ ? (idx_ >> 2) : 0; (uu).n = g_ ? (idx_ & 3) : idx_; } while (0)
#define DEC4(pr, uu) do { const int u_ = (pr) * 2 + half, bh_ = u_ >> 4; (uu).b = bh_ >> 4; (uu).h = bh_ & 15; (uu).dil = 16; (uu).r = u_ & 15; (uu).n = 0; } while (0)
#define PART3(uu) (PART + (size_t)((uu).dil == 4 ? 1 : 0) * NT * 1024)
#define LSE3(uu) (LSE + (size_t)((uu).dil == 4 ? 1 : 0) * NT * 16)
#define NULLP(uu) nullptr
#ifndef MK_ABL3
#define MK_ABL3 0
#endif
        RUN(3) {
            const int ABL3 = (rep_ == 2) ? MK_ABL3 : 0;
            const int per3 = (2048 + F.G - 1) / F.G, first3 = F.vcu * per3, last3 = min((F.vcu + 1) * per3, 2048);
            const int wv3 = half * 4 + hw;
            LAS float* xsr = (LAS float*)(F.lds + XS_OFF);
#define DEC3H(pr, hh, uu) do { const int u_ = (pr) * 2 + (hh), bh_ = u_ >> 5, rem_ = u_ & 31, g_ = rem_ >> 4, idx_ = rem_ & 15; \
            (uu).b = bh_ >> 4; (uu).h = bh_ & 15; (uu).dil = g_ ? 4 : 1; (uu).r = g_ ? (idx_ >> 2) : 0; (uu).n = g_ ? (idx_ & 3) : idx_; } while (0)
            at::RingStage st; at::DilU u0; int pair = first3;
            if (pair < last3) { DEC3H(pair, 0, u0); at::ring_load(st, u0, wv3, lane3, KB, VB, pos); }
#pragma unroll 1
            for (; pair < last3; ++pair) {
                int ln_ = lane3; asm volatile("" : "+v"(ln_));
                at::DilU u; DEC3H(pair, half, u); DEC3H(pair, 0, u0);
                at::ring_write(st, u0, F.lds, xsr, wv3, ln_);
                const int tokq_ = (128 * u.n + 32 * hw + (ln_ & 31)) * u.dil + u.r;
                bf16x8 qr_[4];
#pragma unroll
                for (int d0 = 0; d0 < 4; ++d0) qr_[d0] = *(const GAS bf16x8*)(QB + (size_t)(u.b * SEQ + tokq_) * 1024 + u.h * 64 + 16 * d0 + 8 * (ln_ >> 5));
                const float posq_ = (float)pos[u.b * SEQ + tokq_];
                __syncthreads();
                asm volatile("" :: "v"(qr_[0]), "v"(qr_[1]), "v"(qr_[2]), "v"(qr_[3]), "v"(posq_));
                if (pair + 1 < last3 && !(ABL3 & 2)) { at::DilU un; DEC3H(pair + 1, 0, un); at::ring_load(st, un, wv3, ln_, KB, VB, pos); }
                at::dil_compute<false, true>(F.lds, xsr, hw, wv3, ln_, u, qr_, posq_, PART3(u), LSE3(u), nullptr, nullptr, nullptr, nullptr, nullptr, ABL3);
                __syncthreads();
            }
#undef DEC3H
        }
        SEAM(3);
        RUN(4) {
            const int ABL3 = 0;
            const int per4 = (1024 + F.G - 1) / F.G;
            const bool bgw = hw < 2;
            BgConv bg; bg.init(P, 0, F.vcu * 4 + half * 2 + hw, I_DNL, F.G * 4, (LAS float*)(hl + (hw ? 32768 : 0))); bg.base = I_GUL;
            DIL_RUN(true, F.vcu * per4, min((F.vcu + 1) * per4, 1024), DEC4, NULLP, NULLP, PART, PART + (size_t)NT * 1024, LSE, LSE + (size_t)NT * 16, (bf16_t*)(P.ws + WS_OB), if (bgw) bg.step());
            if (bgw) bg.drain();
        }
#undef DIL_RUN
#undef DEC3
#undef DEC4
#undef PART3
#undef LSE3
#undef NULLP
    }
    SEAM(4);
    RUN(5) { PH;
        pg8::DenseSched S; S.init(1024, 1024, F.G, (int)blockIdx.x, (unsigned)WS_OB, P.ws + WS_WO0);
        pg8::EpiResid<false> E{P.in[0], (const float*)(P.ws + WS_MOD), 2048, X1};
        pg8::gemm_phase<pg8::EpiResid<false>, pg8::DenseSched, true>(F.lds, wsc, 1024, S, E);
    } SEAM(5);
    RUN(6) { PH; phase_route(F, 0, X1); } SEAM(6);
    RUN(7) { PH;
        load_tables(F, 0);
        pg8::MoeSched<2, true> S{(const LAS int*)(F.lds + LDSCTL_OFF), (const int*)(P.ws + WS_LT2), F.G, F.vcu, 1024, (unsigned)WS_XN, wsc + WS_WGU + (size_t)0 * 65 * 512 * 1024 * 2};
        pg8::EpiSwiglu E{(bf16_t*)(P.ws + WS_ACT), (const LAS int*)(F.lds + LDSCTL_OFF)};
#ifdef MK_ABL7
        const int ABL7 = (rep_ == 2) ? MK_ABL7 : 0;
#else
        const int ABL7 = 0;
#endif
        pg8::gemm_phase<pg8::EpiSwiglu, pg8::MoeSched<2, true>, true>(F.lds, wsc, 1024, S, E, ABL7);
    } SEAM(7);
    RUN(8) { PH;
        load_tables(F, 0);
        pg8::MoeSched<4, false> S{(const LAS int*)(F.lds + LDSCTL_OFF), (const int*)(P.ws + WS_LT2), F.G, F.vcu, 256, (unsigned)WS_ACT, wsc + WS_WDN + (size_t)0 * 65 * 1024 * 256 * 2};
        pg8::EpiYB E{(unsigned char*)(P.ws + WS_YB), (const LAS int*)(F.lds + LDSCTL_OFF), (unsigned char*)(P.ws + WS_DUMP)};
#ifdef MK_ABL8
        const int ABL8 = (rep_ == 2) ? MK_ABL8 : 0;
#else
        const int ABL8 = 0;
#endif
        pg8::gemm_phase<pg8::EpiYB, pg8::MoeSched<4, false>, true>(F.lds, wsc, 256, S, E, ABL8);
    } SEAM(8);
    RUN(9) { PH; phase_combine<false>(F, 0, X1, X2); } SEAM(9);
        RUN(10) { PH;
            pg8::DualSched S; S.G = F.G; S.c = (int)blockIdx.x; S.a0 = (unsigned)WS_X2; S.Bt = wsc + WS_W8;
            pg8::EpiDown E{(bf16_t*)(P.ws + WS_DKV), (const float*)(P.ws + WS_RSTD), (const float*)(P.ws + WS_CB), (float*)(P.ws + WS_SSQ), (float*)(P.ws + WS_KPSS), (float*)(P.ws + WS_KPR), (const float*)(P.ws + WS_ROPE), P.in[18]};
            pg8::gemm_phase<pg8::EpiDown, pg8::DualSched, true>(F.lds, wsc, 1024, S, E);
        } SEAM(10);
        RUN(12) { PH;
            { pg8::DenseSched S; S.init(2048, 256, F.G, (int)blockIdx.x, (unsigned)WS_DKV, P.ws + WS_WUKV, 512);
              pg8::EpiKV E{(bf16_t*)(P.ws + WS_KM), (bf16_t*)(P.ws + WS_VM), (const float*)(P.ws + WS_KPSS), (const float*)(P.ws + WS_KPR), P.in[18], (const float*)(P.ws + WS_SSQ)};
              pg8::gemm_phase<pg8::EpiKV, pg8::DenseSched, true>(F.lds, wsc, 256, S, E, 0, 512); }
            { pg8::DenseSched S; S.init(1536, 384, F.G, (int)blockIdx.x, (unsigned)WS_DQ, P.ws + WS_WUQ, 512);
              pg8::EpiQ E{(bf16_t*)(P.ws + WS_QR), (const float*)(P.ws + WS_SSQ)};
              pg8::gemm_phase<pg8::EpiQ, pg8::DenseSched, true>(F.lds, wsc, 384, S, E, 0, 512); }
        } SEAM(12);
        RUN(13) { PH;
#ifdef MK_ABL13
            const int ABL13 = (rep_ == 2) ? MK_ABL13 : 0;
#else
            const int ABL13 = 0;
#endif
            BgConv bg; bg.init(P, 1, F.vcu * NWAVES + F.wave, I_MOEL, F.G * NWAVES, (LAS float*)(F.lds + 49152 + F.wave * 8448));
            for (int v = F.vcu; v < 256; v += F.G) {
                const int bh = v >> 1, odd = v & 1;
#pragma unroll 1
                for (int i = 0; i < 4; ++i) {
                    const int qb = odd ? (i == 0 ? 1 : i == 1 ? 6 : i == 2 ? 2 : 5) : (i == 0 ? 0 : i == 1 ? 7 : i == 2 ? 3 : 4);
                    at::mla_unit(F.lds, bh >> 4, bh & 15, qb, (const bf16_t*)(P.ws + WS_QR), (const bf16_t*)(P.ws + WS_KM), (const bf16_t*)(P.ws + WS_VM), (const float*)(P.ws + WS_ROPE), P.in[22], (bf16_t*)(P.ws + WS_OB), bg, ABL13);
                }
            }
            if (!(ABL13 & 4)) bg.drain();
        } SEAM(13);
        RUN(14) { PH;
            pg8::DenseSched S; S.init(1024, 1024, F.G, (int)blockIdx.x, (unsigned)WS_OB, P.ws + WS_WO1);
            pg8::EpiResid<true> E{X2, (const float*)(P.ws + WS_MOD), 6144 + 2048, X3};
            pg8::gemm_phase<pg8::EpiResid<true>, pg8::DenseSched, true>(F.lds, wsc, 1024, S, E);
        } SEAM(14);

    RUN(15) { PH; phase_route(F, 1, X3); } SEAM(15);
    RUN(16) { PH;
        load_tables(F, 1);
        pg8::MoeSched<2, true> S{(const LAS int*)(F.lds + LDSCTL_OFF), (const int*)(P.ws + WS_LT2), F.G, F.vcu, 1024, (unsigned)WS_XN, wsc + WS_WGU + (size_t)1 * 65 * 512 * 1024 * 2};
        pg8::EpiSwiglu E{(bf16_t*)(P.ws + WS_ACT), (const LAS int*)(F.lds + LDSCTL_OFF)};
        pg8::gemm_phase<pg8::EpiSwiglu, pg8::MoeSched<2, true>, true>(F.lds, wsc, 1024, S, E);
    } SEAM(16);
    RUN(17) { PH;
        load_tables(F, 1);
        pg8::MoeSched<4, false> S{(const LAS int*)(F.lds + LDSCTL_OFF), (const int*)(P.ws + WS_LT2), F.G, F.vcu, 256, (unsigned)WS_ACT, wsc + WS_WDN + (size_t)1 * 65 * 1024 * 256 * 2};
        pg8::EpiYB E{(unsigned char*)(P.ws + WS_YB), (const LAS int*)(F.lds + LDSCTL_OFF), (unsigned char*)(P.ws + WS_DUMP)};
        pg8::gemm_phase<pg8::EpiYB, pg8::MoeSched<4, false>, true>(F.lds, wsc, 256, S, E);
    } SEAM(17);
    RUN(18) { PH; phase_combine<true>(F, 1, X3, P.out); } SEAM(18);
#undef IN
#undef SEAM
#undef RUN
#undef REPS
#undef PH
}
}
static int g_grid = 0;
static void mk_setup() {
    if (g_grid) return;
    int dev = 0, cus = 0, per_cu = 0;
    (void)hipGetDevice(&dev);
    (void)hipDeviceGetAttribute(&cus, hipDeviceAttributeMultiprocessorCount, dev);
    (void)hipFuncSetAttribute((const void*)mk::fwd, hipFuncAttributeMaxDynamicSharedMemorySize, mk::LDS_BYTES);
    if (hipOccupancyMaxActiveBlocksPerMultiprocessor(&per_cu, (const void*)mk::fwd, mk::NTHREADS, mk::LDS_BYTES) != hipSuccess) per_cu = 0;
    (void)hipGetLastError();
    if (per_cu < 1) fprintf(stderr, "kernel_launch: the occupancy query reports %d resident workgroups per CU for %d threads + %d B of LDS; launching one per CU anyway\n", per_cu, mk::NTHREADS, mk::LDS_BYTES);
    g_grid = cus;
    if (g_grid <= 0) g_grid = 256;
}
static void mk_launch(hipStream_t s, void* const* d_in, void* d_out, void* d_ws, int lo, int hi) {
    mk::Args a{};
    for (int i = 0; i < 30; ++i) a.in[i] = (const float*)d_in[i];
    a.out = (float*)d_out; a.ws = (unsigned char*)d_ws; a.ph_lo = lo; a.ph_hi = hi;
    hipLaunchKernelGGL(mk::fwd, dim3(g_grid), dim3(mk::NTHREADS), mk::LDS_BYTES, s, a);
}

extern "C" void kernel_launch(void* const* d_in, const int* in_sizes, int n_in, void* d_out, int out_size, void* d_ws, size_t ws_size,
                              hipStream_t stream) {
    if (n_in != 30 || ws_size < WS_END || out_size != NT * DM) { fprintf(stderr, "kernel_launch: unexpected n_in %d / out %d / ws %zu\n", n_in, out_size, ws_size); return; }
    (void)in_sizes;
    mk_setup();
    (void)hipMemsetAsync((unsigned char*)d_ws + WS_CTL, 0, 1 * MiB, stream);
#ifndef MK_PER_PHASE
    mk_launch(stream, d_in, d_out, d_ws, 0, mk::NPHASE);
#else
    for (int k = 0; k < mk::NPHASE; ++k) mk_launch(stream, d_in, d_out, d_ws, k, k + 1);
#endif
}
```

```cpp
#include <hip/hip_runtime.h>
#include <stdint.h>
#include <cstdio>
#include <cmath>

typedef unsigned short bf16_t;

constexpr int NB = 8, SEQ = 2048, DM = 1024, NT = NB * SEQ, NH = 16;
constexpr int NE = 64, TOPK = 6, PMAX = 114688  , AROWS = PMAX + NT;
constexpr int MODW = 14336;
constexpr float EPS = 1e-6f;
constexpr float LOG2E = 1.4426950408889634f;
constexpr float C2 = 0.125f * LOG2E;
constexpr float C3 = 0.10206207261596577f * LOG2E;

constexpr size_t MiB = 1u << 20;
constexpr size_t WS_CTL = 0;
constexpr size_t WS_MOD = 1 * MiB;
constexpr size_t WS_TOPI = 2 * MiB;
constexpr size_t WS_TOPW = 2 * MiB + 512 * 1024;
constexpr size_t WS_PPOS = 3 * MiB;
constexpr size_t WS_LTOK = 3 * MiB + 512 * 1024;
constexpr size_t WS_KPSS = 4 * MiB;
constexpr size_t WS_KPR = 4 * MiB + 512 * 1024;
constexpr size_t WS_XN = 8 * MiB;
constexpr size_t WS_XKV = 40 * MiB;
constexpr size_t WS_OB = 72 * MiB;
constexpr size_t WS_X1 = 104 * MiB;
constexpr size_t WS_X2 = 168 * MiB;
constexpr size_t WS_ACT = 232 * MiB;
constexpr size_t WS_YB = 296 * MiB;
constexpr size_t WS_R0 = 552 * MiB;
constexpr size_t WS_QB = WS_R0, WS_KB = WS_R0 + 32 * MiB, WS_VB = WS_R0 + 64 * MiB;
constexpr size_t WS_DKV = WS_R0, WS_DQ = WS_R0 + 16 * MiB, WS_CKV = WS_R0 + 32 * MiB, WS_CQ = WS_R0 + 40 * MiB;
constexpr size_t WS_KM = WS_R0 + 52 * MiB, WS_VM = WS_R0 + 100 * MiB, WS_QR = WS_R0 + 132 * MiB;
constexpr size_t WS_END = 1024 * MiB;

constexpr int CW_ECNT = 1024, CW_EOFF = 1024 + 128, CW_CUR = 1024 + 256;

__device__ __forceinline__ float bf2f(bf16_t v) { return __uint_as_float(((unsigned)v) << 16); }
__device__ __forceinline__ bf16_t f2bf(float f) { unsigned u = __float_as_uint(f); return (bf16_t)((u + 0x7fffu + ((u >> 16) & 1u)) >> 16); }


__device__ __forceinline__ float dppf(float v, const int ctrl_sel) {
    const int iv = __float_as_int(v); int r;
    if (ctrl_sel == 0) r = __builtin_amdgcn_update_dpp(iv, iv, 0xB1, 0xF, 0xF, false);
    else if (ctrl_sel == 1) r = __builtin_amdgcn_update_dpp(iv, iv, 0x4E, 0xF, 0xF, false);
    else if (ctrl_sel == 2) r = __builtin_amdgcn_update_dpp(iv, iv, 0x141, 0xF, 0xF, false);
    else r = __builtin_amdgcn_update_dpp(iv, iv, 0x140, 0xF, 0xF, false);
    return __int_as_float(r);
}
__device__ __forceinline__ float sum_x16(float v) { const auto r = __builtin_amdgcn_permlane16_swap(__float_as_int(v), __float_as_int(v), false, false); return __int_as_float(r[0]) + __int_as_float(r[1]); }
__device__ __forceinline__ float sum_x32(float v) { const auto r = __builtin_amdgcn_permlane32_swap(__float_as_int(v), __float_as_int(v), false, false); return __int_as_float(r[0]) + __int_as_float(r[1]); }
__device__ __forceinline__ float max_x16(float v) { const auto r = __builtin_amdgcn_permlane16_swap(__float_as_int(v), __float_as_int(v), false, false); return fmaxf(__int_as_float(r[0]), __int_as_float(r[1])); }
__device__ __forceinline__ float max_x32(float v) { const auto r = __builtin_amdgcn_permlane32_swap(__float_as_int(v), __float_as_int(v), false, false); return fmaxf(__int_as_float(r[0]), __int_as_float(r[1])); }
__device__ __forceinline__ float wave_sum_all(float v) { v += dppf(v, 0); v += dppf(v, 1); v += dppf(v, 2); v += dppf(v, 3); v = sum_x16(v); return sum_x32(v); }
__device__ __forceinline__ float wave_max_all(float v) { v = fmaxf(v, dppf(v, 0)); v = fmaxf(v, dppf(v, 1)); v = fmaxf(v, dppf(v, 2)); v = fmaxf(v, dppf(v, 3)); v = max_x16(v); return max_x32(v); }
__device__ __forceinline__ float max8(float v) { v = fmaxf(v, dppf(v, 0)); v = fmaxf(v, dppf(v, 1)); return fmaxf(v, dppf(v, 2)); }

namespace nv {
__device__ __forceinline__ void route_lane(float score, float bias, int lane, bool& sel, int& jrank, float& w) {
    const float s = score + bias;
    const int g = lane >> 3;
    const float m1 = max8(s);
    unsigned long long bal = __ballot(s == m1);
    const unsigned gm = (unsigned)(bal >> (g * 8)) & 0xffu;
    const int first = __ffs(gm) - 1;
    const float m2 = max8(((lane & 7) == first) ? -INFINITY : s);
    const float gs = m1 + m2;
    int rank = 0;
#pragma unroll
    for (int gg = 0; gg < 8; ++gg) { const float o = __int_as_float(__builtin_amdgcn_readlane(__float_as_int(gs), gg * 8)); rank += ((o > gs) || (o == gs && gg < g)) ? 1 : 0; }
    float v = (rank < 4) ? s : -INFINITY;
    sel = false; jrank = -1;
#pragma unroll
    for (int it = 0; it < TOPK; ++it) {
        const float mx = wave_max_all(v);
        bal = __ballot(v == mx);
        const int f = __ffsll((long long)bal) - 1;
        if (lane == f) { sel = true; jrank = it; v = -INFINITY; }
    }
    const float ssum = wave_sum_all(sel ? score : 0.f);
    w = sel ? score / ssum * 2.5f : 0.f;
}

}

constexpr size_t WS_WQKV = 748 * MiB;
constexpr size_t WS_WO0 = WS_WQKV + 6 * MiB;
constexpr size_t WS_WO1 = WS_WO0 + 2 * MiB;
constexpr size_t WS_WKVD = WS_WO1 + 2 * MiB;
constexpr size_t WS_WDQ = WS_WKVD + 1 * MiB;
constexpr size_t WS_WUKV = WS_WDQ + 1 * MiB;
constexpr size_t WS_WUQ = WS_WUKV + 1 * MiB;
constexpr size_t WS_WR = WS_WUQ + 1536 * 1024;
constexpr size_t WS_WGU = WS_WR + 512 * 1024;
constexpr size_t WS_WDN = WS_WGU + 130 * MiB;
constexpr size_t WS_FAST_END = WS_WDN + 65 * MiB;
static_assert(WS_FAST_END <= WS_END, "d_ws map");
constexpr size_t WS_PART = WS_R0 + 96 * MiB;
constexpr size_t WS_LSE = WS_R0 + 192 * MiB;
constexpr size_t WS_LT2 = 960 * MiB;
constexpr size_t WS_ROPE = 964 * MiB;
constexpr size_t WS_W8 = 968 * MiB;
constexpr size_t WS_PB = 984 * MiB;
constexpr size_t WS_CB = 985 * MiB;
constexpr size_t WS_RSTD = 986 * MiB;
constexpr size_t WS_SSQ = 988 * MiB;
constexpr int CW_ECNTF = 2048;

#define GAS __attribute__((address_space(1)))
#define LAS __attribute__((address_space(3)))
typedef short bf16x8 __attribute__((ext_vector_type(8)));
typedef float f32x4 __attribute__((ext_vector_type(4)));
typedef float f32x2 __attribute__((ext_vector_type(2)));
typedef unsigned u32x4 __attribute__((ext_vector_type(4)));
typedef unsigned u32x2 __attribute__((ext_vector_type(2)));

__device__ __forceinline__ unsigned pk2(float lo, float hi) { return (unsigned)f2bf(lo) | ((unsigned)f2bf(hi) << 16); }
__device__ __forceinline__ unsigned cvt_pk_bf16(float lo, float hi) { unsigned r; asm volatile("v_cvt_pk_bf16_f32 %0, %1, %2" : "=v"(r) : "v"(lo), "v"(hi)); return r; }

namespace pg8 {
constexpr int BM = 256, BK = 64, HALF = 128, HTB = HALF * BK * 2, STAGE_BYTES = 8 * HTB, NXCD = 8, WGM = 8;
__host__ __device__ __forceinline__ int lds_byte(int r, int c) { const int st = (r >> 4) * 2 + (c >> 5), rr = r & 15, cc = c & 31, ob = rr * 64 + cc * 2; return st * 1024 + (ob ^ (((ob >> 9) & 1) << 5)); }
__host__ __device__ __forceinline__ void stage_rc(int b, int& R, int& C) { const int st = b / 1024, sb = b % 1024, swz = sb ^ (((sb >> 9) & 1) << 5); R = (st >> 1) * 16 + swz / 64; C = (st & 1) * 32 + (swz % 64) / 2; }
__host__ __device__ __forceinline__ int perm32(int rho) { const int n = rho >> 4, i = rho & 15; return 8 * (i >> 2) + 4 * n + (i & 3); }

struct Unit { int rowbase; int pn; int aux; int aux2; };

template <class Epi, class Sched, bool ALIGN_EPI>
__device__ __forceinline__ void gemm_phase(LAS unsigned char* lds, const char* Abase, const int K, const Sched& S, const Epi& E, const int abl = 0, const int lda_ = 0) {
    int tid_ = threadIdx.x; asm volatile("" : "+v"(tid_));
    const int tid = tid_, wid = __builtin_amdgcn_readfirstlane(tid >> 6), lane = tid & 63, wr = wid >> 2, wc = wid & 3, fr = lane & 15, fq = lane >> 4;
    const int nt = K / BK;
    int Rr[2]; unsigned Cb[2], voffB[2], lo[2];
#pragma unroll
    for (int i = 0; i < 2; ++i) { int R, C; stage_rc(tid * 16 + i * 8192, R, C); const int Rb = Epi::PERM ? ((R & ~31) + perm32(R & 31)) : R;
        Rr[i] = R; Cb[i] = (unsigned)C * 2u; voffB[i] = (unsigned)(Rb * K + C) * 2u; lo[i] = (unsigned)(R * (lda_ ? lda_ : K) + C) * 2u; }
    const size_t kstep = (size_t)(BK * 2);
    const size_t hstepB = (size_t)HALF * K * 2, hstepA = (size_t)HALF * (lda_ ? lda_ : K) * 2;
    const unsigned ldsw = (unsigned)wid * 1024u;
    const int aoff = lds_byte(wr * 64 + fr, fq * 8), boff = lds_byte(wc * 32 + fr, fq * 8);
#define PG8_SA(b, h) (((b) * 2 + (h)) * HTB)
#define PG8_SB(b, h) ((4 + (b) * 2 + (h)) * HTB)
#define PG8_STAGE_B(bufoff, gbase) do { if (!(abl & 4)) _Pragma("unroll") for (int _i = 0; _i < 2; ++_i) \
        __builtin_amdgcn_global_load_lds((const unsigned*)((const char*)(gbase) + voffB[_i]), (LAS unsigned*)(lds + (bufoff) + ldsw + _i * 8192), 16, 0, 0); } while (0)
#define PG8_STAGE_A(bufoff, h, nx, kb) do { if (abl & 4) break; unsigned _o0, _o1; const char* _b; \
        if constexpr (Sched::GATHER) { _b = Abase + (size_t)(kb); _o0 = (nx) ? ((h) ? an10 : an00) : ((h) ? ac10 : ac00); _o1 = (nx) ? ((h) ? an11 : an01) : ((h) ? ac11 : ac01); } \
        else { _b = Abase + (size_t)(kb) + ((nx) ? nU : cU) + ((h) ? hstepA : (size_t)0); _o0 = lo[0]; _o1 = lo[1]; } \
        __builtin_amdgcn_global_load_lds((const unsigned*)(_b + _o0), (LAS unsigned*)(lds + (bufoff) + ldsw), 16, 0, 0); \
        __builtin_amdgcn_global_load_lds((const unsigned*)(_b + _o1), (LAS unsigned*)(lds + (bufoff) + ldsw + 8192), 16, 0, 0); } while (0)
#define PG8_LDA(dst, b, h) do { _Pragma("unroll") for (int m = 0; m < 4; ++m) _Pragma("unroll") for (int k = 0; k < 2; ++k) dst[m][k] = *(const LAS bf16x8*)(lds + PG8_SA(b, h) + aoff + m * 2048 + k * 1024); } while (0)
#define PG8_LDB(dst, b, h) do { _Pragma("unroll") for (int n = 0; n < 2; ++n) _Pragma("unroll") for (int k = 0; k < 2; ++k) dst[n][k] = *(const LAS bf16x8*)(lds + PG8_SB(b, h) + boff + n * 2048 + k * 1024); } while (0)
#define PG8_MMA(ai, bj, At, Bt) do { if (abl & 2) break; __builtin_amdgcn_s_setprio(1); _Pragma("unroll") for (int m = 0; m < 4; ++m) _Pragma("unroll") for (int n = 0; n < 2; ++n) _Pragma("unroll") for (int k = 0; k < 2; ++k) \
        acc[ai][bj][m][n] = __builtin_amdgcn_mfma_f32_16x16x32_bf16(Bt[n][k], At[m][k], acc[ai][bj][m][n], 0, 0, 0); __builtin_amdgcn_s_setprio(0); } while (0)
#define PG8_WAIT_V(n) asm volatile("s_waitcnt vmcnt(" #n ")" ::: "memory")
#define PG8_WAIT_L(n) asm volatile("s_waitcnt lgkmcnt(" #n ")" ::: "memory")
#define PG8_BAR __builtin_amdgcn_s_barrier()
#define PG8_SCHED __builtin_amdgcn_sched_barrier(0)
    Unit cur, nxt; int ui = 0;
    if (!S.next(0, cur)) return;
    f32x4 acc[2][2][4][2];
#pragma unroll
    for (int a = 0; a < 2; ++a)
#pragma unroll
        for (int b = 0; b < 2; ++b)
#pragma unroll
            for (int m = 0; m < 4; ++m)
#pragma unroll
                for (int n = 0; n < 2; ++n) acc[a][b][m][n] = (f32x4){0.f, 0.f, 0.f, 0.f};
    bf16x8 At[4][2], B0[2][2], B1[2][2];
    unsigned ac00 = 0, ac01 = 0, ac10 = 0, ac11 = 0, an00 = 0, an01 = 0, an10 = 0, an11 = 0; size_t cU = 0, nU = 0;
    if constexpr (Sched::GATHER) { ac00 = S.a_off(cur, Rr[0]) + Cb[0]; ac01 = S.a_off(cur, Rr[1]) + Cb[1]; ac10 = S.a_off(cur, HALF + Rr[0]) + Cb[0]; ac11 = S.a_off(cur, HALF + Rr[1]) + Cb[1]; }
    else cU = S.a_uni(cur);
    const char* cB = S.b_base(cur);
    PG8_STAGE_B(PG8_SB(0, 0), cB); PG8_STAGE_B(PG8_SB(0, 1), cB + hstepB); PG8_STAGE_A(PG8_SA(0, 0), 0, false, 0); PG8_STAGE_A(PG8_SA(0, 1), 1, false, 0);
    if (wr == 1) PG8_BAR;
    PG8_WAIT_V(2); PG8_BAR;
    PG8_STAGE_B(PG8_SB(1, 0), cB + kstep); PG8_STAGE_A(PG8_SA(1, 0), 0, false, kstep); PG8_STAGE_B(PG8_SB(1, 1), cB + hstepB + kstep);
    PG8_WAIT_V(6); PG8_BAR;
    for (;;) {
        const bool has_next = S.next(ui + 1, nxt);
        const char* nB = cB;
        if (has_next) {
            if constexpr (Sched::GATHER) { an00 = S.a_off(nxt, Rr[0]) + Cb[0]; an01 = S.a_off(nxt, Rr[1]) + Cb[1]; an10 = S.a_off(nxt, HALF + Rr[0]) + Cb[0]; an11 = S.a_off(nxt, HALF + Rr[1]) + Cb[1]; }
            else nU = S.a_uni(nxt);
            nB = S.b_base(nxt);
        } else { an00 = ac00; an01 = ac01; an10 = ac10; an11 = ac11; nU = cU; }
#pragma unroll 1
        for (int t = 0; t < nt; t += 2) {
            const bool last = (t == nt - 2);
            const size_t k1 = (size_t)(t + 1) * kstep;
            const size_t k2 = last ? (size_t)0 : (size_t)(t + 2) * kstep;
            const char* b2 = last ? nB : cB + (size_t)(t + 2) * kstep; const char* b3 = b2 + kstep;
            PG8_LDB(B0, 0, 0); PG8_LDB(B1, 0, 1); PG8_SCHED; PG8_LDA(At, 0, 0); PG8_STAGE_A(PG8_SA(1, 1), 1, false, k1);
            PG8_WAIT_V(8); PG8_WAIT_L(0); PG8_BAR; PG8_MMA(0, 0, At, B0); PG8_MMA(0, 1, At, B1); PG8_BAR; PG8_SCHED;
            PG8_LDA(At, 0, 1); PG8_STAGE_B(PG8_SB(0, 0), b2); PG8_STAGE_B(PG8_SB(0, 1), b2 + hstepB); PG8_STAGE_A(PG8_SA(0, 0), 0, last, k2);
            PG8_WAIT_V(8); PG8_WAIT_L(0); PG8_BAR; PG8_MMA(1, 0, At, B0); PG8_MMA(1, 1, At, B1); PG8_BAR; PG8_SCHED;
            PG8_LDB(B0, 1, 0); PG8_LDB(B1, 1, 1); PG8_SCHED; PG8_LDA(At, 1, 0); PG8_STAGE_A(PG8_SA(0, 1), 1, last, k2);
            PG8_WAIT_V(8); PG8_WAIT_L(0); PG8_BAR; PG8_MMA(0, 0, At, B0); PG8_MMA(0, 1, At, B1); PG8_BAR; PG8_SCHED;
            PG8_LDA(At, 1, 1); PG8_STAGE_B(PG8_SB(1, 0), b3); PG8_STAGE_B(PG8_SB(1, 1), b3 + hstepB); PG8_STAGE_A(PG8_SA(1, 0), 0, last, k2 + kstep);
            PG8_WAIT_V(8); PG8_WAIT_L(0); PG8_BAR; PG8_MMA(1, 0, At, B0); PG8_MMA(1, 1, At, B1); PG8_BAR; PG8_SCHED;
        }
        if constexpr (ALIGN_EPI) { if (wr == 0) PG8_BAR; }
        { int fr_e = fr, fq_e = fq; asm volatile("" : "+v"(fr_e), "+v"(fq_e));
          if (!(abl & 1)) E(acc, cur, wr, wc, fr_e, fq_e); }
        if (!has_next) break;
#pragma unroll
        for (int a = 0; a < 2; ++a)
#pragma unroll
            for (int b = 0; b < 2; ++b)
#pragma unroll
                for (int m = 0; m < 4; ++m)
#pragma unroll
                    for (int n = 0; n < 2; ++n) acc[a][b][m][n] = (f32x4){0.f, 0.f, 0.f, 0.f};
        cur = nxt; cB = nB; ac00 = an00; ac01 = an01; ac10 = an10; ac11 = an11; cU = nU; ++ui;
        if constexpr (ALIGN_EPI) { if (wr == 1) PG8_BAR; }
    }
    PG8_WAIT_V(0);
    if constexpr (!ALIGN_EPI) { if (wr == 0) PG8_BAR; }
    PG8_BAR;
#undef PG8_SA
#undef PG8_SB
#undef PG8_STAGE_A
#undef PG8_STAGE_B
#undef PG8_LDA
#undef PG8_LDB
#undef PG8_MMA
#undef PG8_WAIT_V
#undef PG8_WAIT_L
#undef PG8_BAR
#undef PG8_SCHED
}

struct DenseSched {
    static constexpr bool GATHER = false;
    int nN, nwg, G, c, K, lda; unsigned a0; const char* Bt;
    __device__ __forceinline__ void init(int N, int K_, int G_, int c_, unsigned a0_, const void* Bt_, int lda_ = 0) { nN = N / BM; nwg = (NT / BM) * nN; G = G_; c = c_; K = K_; lda = lda_ ? lda_ : K_; a0 = a0_; Bt = (const char*)Bt_; }
    __device__ __forceinline__ bool next(int i, Unit& u) const {
        const int L = i * G + c; if (L >= nwg) return false;
        int wgid = L; { const int q = nwg / NXCD, r = nwg % NXCD, xcd = wgid % NXCD, off = wgid / NXCD; wgid = (xcd < r ? xcd * (q + 1) : r * (q + 1) + (xcd - r) * q) + off; }
        const int nM = NT / BM, nig = WGM * nN, gid = wgid / nig, fm = gid * WGM, gsz = (nM - fm) < WGM ? (nM - fm) : WGM;
        u.rowbase = (fm + ((wgid % nig) % gsz)) * BM; u.pn = (wgid % nig) / gsz; u.aux = 0; u.aux2 = 0; return true;
    }
    __device__ __forceinline__ size_t a_uni(const Unit& u) const { return (size_t)a0 + (size_t)u.rowbase * (size_t)(lda * 2); }
    __device__ __forceinline__ unsigned a_off(const Unit& u, int r) const { return 0u; }
    __device__ __forceinline__ const char* b_base(const Unit& u) const { return Bt + (size_t)u.pn * BM * K * 2; }
};

struct EpiQKV {
    static constexpr bool PERM = true;
    bf16_t *Q; const float *qg, *kg;
    __device__ __forceinline__ void operator()(const f32x4 (&acc)[2][2][4][2], const Unit& u, int wr, int wc, int fr, int fq) const {
        const int part = u.pn >> 2, head = (u.pn & 3) * 4 + wc;
        bf16_t* out = Q + (size_t)part * (size_t)(16 * 1024 * 1024) + head * 64 + 8 * fq;
        f32x4 g[2][2];
#pragma unroll
        for (int bj = 0; bj < 2; ++bj)
#pragma unroll
            for (int n = 0; n < 2; ++n) g[bj][n] = (f32x4){1.f, 1.f, 1.f, 1.f};
        if (part < 2) { const float* gp = (part ? kg : qg) + 8 * fq;
#pragma unroll
            for (int bj = 0; bj < 2; ++bj)
#pragma unroll
                for (int n = 0; n < 2; ++n) g[bj][n] = *(const f32x4*)(gp + 32 * bj + 4 * n); }
        const float rscale = (part == 0) ? C2 : 1.f;
#pragma unroll
        for (int ai = 0; ai < 2; ++ai)
#pragma unroll
            for (int m = 0; m < 4; ++m) {
                const int row = u.rowbase + ai * HALF + wr * 64 + m * 16 + fr;
                f32x4 v[2][2];
#pragma unroll
                for (int bj = 0; bj < 2; ++bj)
#pragma unroll
                    for (int n = 0; n < 2; ++n) v[bj][n] = acc[ai][bj][m][n];
                float ss = 0.f;
#pragma unroll
                for (int bj = 0; bj < 2; ++bj)
#pragma unroll
                    for (int n = 0; n < 2; ++n) { const f32x4 x = v[bj][n]; ss += (x[0] * x[0] + x[1] * x[1]) + (x[2] * x[2] + x[3] * x[3]); }
                ss = sum_x16(ss); ss = sum_x32(ss);
                const float r = (part < 2) ? rsqrtf(ss * (1.f / 64.f) + EPS) * rscale : 1.f;
#pragma unroll
                for (int bj = 0; bj < 2; ++bj)
#pragma unroll
                    for (int n = 0; n < 2; ++n) v[bj][n] = v[bj][n] * r * g[bj][n];
#pragma unroll
                for (int bj = 0; bj < 2; ++bj) { u32x4 w; w.x = cvt_pk_bf16(v[bj][0][0], v[bj][0][1]); w.y = cvt_pk_bf16(v[bj][0][2], v[bj][0][3]); w.z = cvt_pk_bf16(v[bj][1][0], v[bj][1][1]); w.w = cvt_pk_bf16(v[bj][1][2], v[bj][1][3]);
                    *(u32x4*)(out + (size_t)row * 1024 + 32 * bj) = w; }
            }
    }
};

struct DualSched {
    static constexpr bool GATHER = false;
    int G, c; unsigned a0; const char* Bt;
    __device__ __forceinline__ bool next(int i, Unit& u) const {
        const int L = i * G + c; if (L >= 256) return false;
        const int w = L >> 7, idx = L & 127;
        u.rowbase = (idx >> 1) * BM; u.pn = idx & 1; u.aux = w; u.aux2 = 0; return true;
    }
    __device__ __forceinline__ size_t a_uni(const Unit& u) const { return (size_t)a0 + (size_t)u.rowbase * 2048; }
    __device__ __forceinline__ unsigned a_off(const Unit& u, int r) const { return 0u; }
    __device__ __forceinline__ const char* b_base(const Unit& u) const { return Bt + ((size_t)(u.aux * 8 + (u.rowbase >> 11)) * 512 + (size_t)u.pn * BM) * 1024 * 2; }
};

template <int NTILE, bool GATHER_>
struct MoeSched {
    static constexpr bool GATHER = GATHER_;
    const LAS int* tab;
    const int* LT2; int G, c, K; unsigned a0; const char* Bt;
    __device__ __forceinline__ bool next(int i, Unit& u) const {
        const int L = i * G + c;
        const int nrb = tab[64] >> 8;
        if (L >= (nrb + 64) * NTILE) return false;
        const int blk = L / NTILE; u.pn = L % NTILE;
        if (blk < nrb) {
            const int row0 = blk << 8, lane = threadIdx.x & 63;
            const unsigned long long bal = __ballot(tab[lane] <= row0);
            const int e = __builtin_popcountll(bal) - 1;
            u.rowbase = row0; u.aux = e; u.aux2 = row0 - tab[e];
        } else { u.rowbase = PMAX + ((blk - nrb) << 8); u.aux = 64; u.aux2 = (blk - nrb) << 8; }
        return true;
    }
    __device__ __forceinline__ size_t a_uni(const Unit& u) const { return (size_t)a0 + (size_t)u.rowbase * (size_t)(K * 2); }
    __device__ __forceinline__ unsigned a_off(const Unit& u, int r) const {
        int tok;
        if (u.aux < 64) { const int idx = u.aux2 + r; tok = 0; if (idx < tab[128 + u.aux]) tok = LT2[u.aux * 16384 + idx]; }
        else tok = u.aux2 + r;
        return a0 + (unsigned)tok * 2048u;
    }
    __device__ __forceinline__ const char* b_base(const Unit& u) const { return Bt + ((size_t)u.aux * NTILE + u.pn) * BM * K * 2; }
};

template <bool XBF>
struct EpiResid {
    static constexpr bool PERM = true;
    const void* xin; const float* MOD; int gate_off; bf16_t* out;
    __device__ __forceinline__ void operator()(const f32x4 (&acc)[2][2][4][2], const Unit& u, int wr, int wc, int fr, int fq) const {
        const int b = u.rowbase >> 11, col0 = u.pn * BM + wc * 32 + 8 * fq;
        f32x4 gt[2][2];
#pragma unroll
        for (int bj = 0; bj < 2; ++bj)
#pragma unroll
            for (int n = 0; n < 2; ++n) gt[bj][n] = *(const f32x4*)(MOD + b * MODW + gate_off + col0 + bj * HALF + n * 4);
#pragma unroll
        for (int ai = 0; ai < 2; ++ai)
#pragma unroll
            for (int m = 0; m < 4; ++m) { const size_t off = (size_t)(u.rowbase + ai * HALF + wr * 64 + m * 16 + fr) * 1024 + col0;
#pragma unroll
                for (int bj = 0; bj < 2; ++bj) {
                    f32x4 x0, x1;
                    if (XBF) { const u32x4 xw = *(const u32x4*)((const bf16_t*)xin + off + bj * HALF);
                        x0 = (f32x4){__uint_as_float(xw.x << 16), __uint_as_float(xw.x & 0xffff0000u), __uint_as_float(xw.y << 16), __uint_as_float(xw.y & 0xffff0000u)};
                        x1 = (f32x4){__uint_as_float(xw.z << 16), __uint_as_float(xw.z & 0xffff0000u), __uint_as_float(xw.w << 16), __uint_as_float(xw.w & 0xffff0000u)}; }
                    else { x0 = *(const f32x4*)((const float*)xin + off + bj * HALF); x1 = *(const f32x4*)((const float*)xin + off + bj * HALF + 4); }
                    const f32x4 v0 = x0 + gt[bj][0] * acc[ai][bj][m][0], v1 = x1 + gt[bj][1] * acc[ai][bj][m][1];
                    u32x4 w; w.x = cvt_pk_bf16(v0[0], v0[1]); w.y = cvt_pk_bf16(v0[2], v0[3]); w.z = cvt_pk_bf16(v1[0], v1[1]); w.w = cvt_pk_bf16(v1[2], v1[3]);
                    *(u32x4*)(out + off + bj * HALF) = w; } }
    }
};
struct EpiBf16 {
    static constexpr bool PERM = true;
    bf16_t* O; int ldo; size_t sel_stride; const LAS int* tab;
    __device__ __forceinline__ void operator()(const f32x4 (&acc)[2][2][4][2], const Unit& u, int wr, int wc, int fr, int fq) const {
        bf16_t* base = O + (size_t)u.aux * sel_stride + u.pn * BM + wc * 32 + 8 * fq;
        const int nvalid = (tab && u.aux < 64) ? tab[128 + u.aux] - u.aux2 : 256;
#pragma unroll
        for (int ai = 0; ai < 2; ++ai)
#pragma unroll
            for (int m = 0; m < 4; ++m) { const int lr = ai * HALF + wr * 64 + m * 16 + fr; if (lr >= nvalid) continue; bf16_t* rowp = base + (size_t)(u.rowbase + lr) * ldo;
#pragma unroll
                for (int bj = 0; bj < 2; ++bj) { const f32x4 v0 = acc[ai][bj][m][0], v1 = acc[ai][bj][m][1];
                    u32x4 w; w.x = cvt_pk_bf16(v0[0], v0[1]); w.y = cvt_pk_bf16(v0[2], v0[3]); w.z = cvt_pk_bf16(v1[0], v1[1]); w.w = cvt_pk_bf16(v1[2], v1[3]);
                    *(u32x4*)(rowp + bj * HALF) = w; } }
    }
};
struct EpiDown {
    static constexpr bool PERM = true, DEFER = false;
    bf16_t* O; const float* RSTD; const float* CB; float* SSQ; float* KPSS; float* KPR; const float* ROPE; const float* gk;
    __device__ __forceinline__ void operator()(const f32x4 (&acc)[2][2][4][2], const Unit& u, int wr, int wc, int fr, int fq) const {
        const int col0 = u.pn * BM + wc * 32 + 8 * fq;
        bf16_t* base = O + (size_t)u.aux * (size_t)(8 * 1024 * 1024) + col0;
        const float* cb = CB + ((u.rowbase >> 11) * 2 + u.aux) * 512 + col0;
        f32x4 bs[2][2];
#pragma unroll
        for (int bj = 0; bj < 2; ++bj)
#pragma unroll
            for (int n = 0; n < 2; ++n) bs[bj][n] = *(const f32x4*)(cb + bj * HALF + n * 4);
        const bool ropew = (u.aux == 0) && (u.pn == 1) && (wc == 0);
        f32x4 g0 = (f32x4){0.f, 0.f, 0.f, 0.f}, g1 = g0;
        if (ropew) { g0 = *(const f32x4*)(gk + 64 + 8 * fq); g1 = *(const f32x4*)(gk + 64 + 8 * fq + 4); }
#pragma unroll
        for (int ai = 0; ai < 2; ++ai)
#pragma unroll
            for (int m = 0; m < 4; ++m) { const int row = u.rowbase + ai * HALF + wr * 64 + m * 16 + fr; const float r = RSTD[row]; bf16_t* rowp = base + (size_t)row * 512;
                f32x4 v[2][2];
#pragma unroll
                for (int bj = 0; bj < 2; ++bj) { v[bj][0] = acc[ai][bj][m][0] * r + bs[bj][0]; v[bj][1] = acc[ai][bj][m][1] * r + bs[bj][1];
                    u32x4 w; w.x = cvt_pk_bf16(v[bj][0][0], v[bj][0][1]); w.y = cvt_pk_bf16(v[bj][0][2], v[bj][0][3]); w.z = cvt_pk_bf16(v[bj][1][0], v[bj][1][1]); w.w = cvt_pk_bf16(v[bj][1][2], v[bj][1][3]);
                    *(u32x4*)(rowp + bj * HALF) = w; }
                float ss = ((v[0][0][0] * v[0][0][0] + v[0][0][1] * v[0][0][1]) + (v[0][0][2] * v[0][0][2] + v[0][0][3] * v[0][0][3])) + ((v[0][1][0] * v[0][1][0] + v[0][1][1] * v[0][1][1]) + (v[0][1][2] * v[0][1][2] + v[0][1][3] * v[0][1][3]));
                if (u.pn == 0) ss += ((v[1][0][0] * v[1][0][0] + v[1][0][1] * v[1][0][1]) + (v[1][0][2] * v[1][0][2] + v[1][0][3] * v[1][0][3])) + ((v[1][1][0] * v[1][1][0] + v[1][1][1] * v[1][1][1]) + (v[1][1][2] * v[1][1][2] + v[1][1][3] * v[1][1][3]));
                ss = sum_x16(ss); ss = sum_x32(ss);
                if (!(u.aux == 0 && u.pn == 1)) { if (fq == 0) SSQ[(size_t)row * 16 + u.aux * 8 + u.pn * 4 + wc] = ss; }
                else if (ropew) {
                    if (fq == 0) KPSS[row] = ss;
                    const f32x4 kg0 = v[0][0] * g0, kg1 = v[0][1] * g1;
                    f32x4 kx0, kx1;
#pragma unroll
                    for (int j = 0; j < 4; ++j) {
                        const auto a = __builtin_amdgcn_permlane32_swap(__float_as_int(kg0[j]), __float_as_int(kg0[j]), false, false);
                        const auto b = __builtin_amdgcn_permlane32_swap(__float_as_int(kg1[j]), __float_as_int(kg1[j]), false, false);
                        kx0[j] = (fq & 2) ? __int_as_float(a[0]) : __int_as_float(a[1]); kx1[j] = (fq & 2) ? __int_as_float(b[0]) : __int_as_float(b[1]); }
                    const float* cp = ROPE + (size_t)row * 16 + 8 * (fq & 1); const float* sp = cp + (size_t)NT * 16;
                    const f32x4 c0 = *(const f32x4*)cp, c1 = *(const f32x4*)(cp + 4), s0 = *(const f32x4*)sp, s1 = *(const f32x4*)(sp + 4);
                    const float sg = (fq & 2) ? 1.f : -1.f;
                    *(f32x4*)(KPR + (size_t)row * 32 + 8 * fq) = kg0 * c0 + kx0 * s0 * sg;
                    *(f32x4*)(KPR + (size_t)row * 32 + 8 * fq + 4) = kg1 * c1 + kx1 * s1 * sg;
                } }
    }
};
struct EpiQ {
    static constexpr bool PERM = true, DEFER = false;
    bf16_t* O; const float* SSQ;
    __device__ __forceinline__ void operator()(const f32x4 (&acc)[2][2][4][2], const Unit& u, int wr, int wc, int fr, int fq) const {
        bf16_t* base = O + u.pn * BM + wc * 32 + 8 * fq;
#pragma unroll
        for (int ai = 0; ai < 2; ++ai)
#pragma unroll
            for (int m = 0; m < 4; ++m) { const int row = u.rowbase + ai * HALF + wr * 64 + m * 16 + fr; bf16_t* rowp = base + (size_t)row * 1536;
                const f32x4 sa = *(const f32x4*)(SSQ + (size_t)row * 16 + 8), sb = *(const f32x4*)(SSQ + (size_t)row * 16 + 12);
                const float r = rsqrtf((((sa[0] + sa[1]) + (sa[2] + sa[3])) + ((sb[0] + sb[1]) + (sb[2] + sb[3]))) * (1.f / 384.f) + EPS);
#pragma unroll
                for (int bj = 0; bj < 2; ++bj) { const f32x4 v0 = acc[ai][bj][m][0] * r, v1 = acc[ai][bj][m][1] * r;
                    u32x4 w; w.x = cvt_pk_bf16(v0[0], v0[1]); w.y = cvt_pk_bf16(v0[2], v0[3]); w.z = cvt_pk_bf16(v1[0], v1[1]); w.w = cvt_pk_bf16(v1[2], v1[3]);
                    *(u32x4*)(rowp + bj * HALF) = w; } }
    }
};
constexpr float YB_SCALE = 8.f, YB_CLAMP = 440.f;
struct EpiYB {
    static constexpr bool PERM = true;
    unsigned char* O; const LAS int* tab;
    __device__ __forceinline__ void operator()(const f32x4 (&acc)[2][2][4][2], const Unit& u, int wr, int wc, int fr, int fq) const {
        unsigned char* base = O + u.pn * BM + wc * 64 + 16 * fq;
        const int nvalid = (u.aux < 64) ? tab[128 + u.aux] - u.aux2 : 256;
#pragma unroll
        for (int ai = 0; ai < 2; ++ai)
#pragma unroll
            for (int m = 0; m < 4; ++m) { const int lr = ai * HALF + wr * 64 + m * 16 + fr; if (lr >= nvalid) continue;
                int w[4];
#pragma unroll
                for (int bj = 0; bj < 2; ++bj)
#pragma unroll
                    for (int n = 0; n < 2; ++n) { f32x4 v = acc[ai][bj][m][n] * YB_SCALE;
#pragma unroll
                        for (int j = 0; j < 4; ++j) v[j] = __builtin_amdgcn_fmed3f(v[j], -YB_CLAMP, YB_CLAMP);
                        int q = 0; q = __builtin_amdgcn_cvt_pk_fp8_f32(v[0], v[1], q, false); q = __builtin_amdgcn_cvt_pk_fp8_f32(v[2], v[3], q, true); w[bj * 2 + n] = q; }
                u32x4 o; o.x = (unsigned)w[0]; o.y = (unsigned)w[1]; o.z = (unsigned)w[2]; o.w = (unsigned)w[3];
                *(u32x4*)(base + (size_t)(u.rowbase + lr) * 1024) = o; }
    }
};
struct EpiSwiglu {
    static constexpr bool PERM = true;
    bf16_t* ACT; const LAS int* tab;
    __device__ __forceinline__ void operator()(const f32x4 (&acc)[2][2][4][2], const Unit& u, int wr, int wc, int fr, int fq) const {
        bf16_t* base = ACT + u.pn * 128 + wc * 32 + 8 * fq;
        const int nvalid = (u.aux < 64) ? tab[128 + u.aux] - u.aux2 : 256;
#pragma unroll
        for (int ai = 0; ai < 2; ++ai)
#pragma unroll
            for (int m = 0; m < 4; ++m) { const int lr = ai * HALF + wr * 64 + m * 16 + fr; if (lr >= nvalid) continue; bf16_t* rowp = base + (size_t)(u.rowbase + lr) * 256;
                f32x4 a[2];
#pragma unroll
                for (int n = 0; n < 2; ++n) { const f32x4 g = acc[ai][0][m][n], uu = acc[ai][1][m][n];
#pragma unroll
                    for (int j = 0; j < 4; ++j) a[n][j] = g[j] * __builtin_amdgcn_rcpf(1.f + __expf(-g[j])) * uu[j]; }
                u32x4 w; w.x = cvt_pk_bf16(a[0][0], a[0][1]); w.y = cvt_pk_bf16(a[0][2], a[0][3]); w.z = cvt_pk_bf16(a[1][0], a[1][1]); w.w = cvt_pk_bf16(a[1][2], a[1][3]);
                *(u32x4*)rowp = w; }
    }
};
struct EpiKV {
    static constexpr bool PERM = true;
    bf16_t *KM, *VM; const float *KPSS, *KPR, *gk, *SSQ;
    __device__ __forceinline__ void operator()(const f32x4 (&acc)[2][2][4][2], const Unit& u, int wr, int wc, int fr, int fq) const {
        const bool isk = u.pn < 4; const int head = (u.pn & 3) * 4 + wc;
        f32x4 g[2][2];
#pragma unroll
        for (int bj = 0; bj < 2; ++bj)
#pragma unroll
            for (int n = 0; n < 2; ++n) g[bj][n] = isk ? *(const f32x4*)(gk + 32 * bj + 8 * fq + 4 * n) : (f32x4){1.f, 1.f, 1.f, 1.f};
#pragma unroll
        for (int ai = 0; ai < 2; ++ai)
#pragma unroll
            for (int m = 0; m < 4; ++m) {
                const int row = u.rowbase + ai * HALF + wr * 64 + m * 16 + fr;
                float ss = 0.f;
#pragma unroll
                for (int bj = 0; bj < 2; ++bj)
#pragma unroll
                    for (int n = 0; n < 2; ++n) { const f32x4 x = acc[ai][bj][m][n]; ss += (x[0] * x[0] + x[1] * x[1]) + (x[2] * x[2] + x[3] * x[3]); }
                ss = sum_x16(ss); ss = sum_x32(ss);
                const f32x4 sl = *(const f32x4*)(SSQ + (size_t)row * 16);
                const float rl = rsqrtf(((sl[0] + sl[1]) + (sl[2] + sl[3])) * (1.f / 256.f) + EPS);
                const float rk = isk ? rsqrtf((ss * rl * rl + KPSS[row]) * (1.f / 96.f) + EPS) : 1.f, r = rl * rk;
                bf16_t* o = isk ? KM + ((size_t)row * 16 + head) * 96 + 8 * fq : VM + (size_t)row * 1024 + head * 64 + 8 * fq;
#pragma unroll
                for (int bj = 0; bj < 2; ++bj) { const f32x4 v0 = acc[ai][bj][m][0] * r * g[bj][0], v1 = acc[ai][bj][m][1] * r * g[bj][1];
                    u32x4 w; w.x = cvt_pk_bf16(v0[0], v0[1]); w.y = cvt_pk_bf16(v0[2], v0[3]); w.z = cvt_pk_bf16(v1[0], v1[1]); w.w = cvt_pk_bf16(v1[2], v1[3]);
                    *(u32x4*)(o + 32 * bj) = w; }
                if (isk) { const f32x4 p0 = *(const f32x4*)(KPR + (size_t)row * 32 + 8 * fq) * rk, p1 = *(const f32x4*)(KPR + (size_t)row * 32 + 8 * fq + 4) * rk;
                    u32x4 w; w.x = cvt_pk_bf16(p0[0], p0[1]); w.y = cvt_pk_bf16(p0[2], p0[3]); w.z = cvt_pk_bf16(p1[0], p1[1]); w.w = cvt_pk_bf16(p1[2], p1[3]);
                    *(u32x4*)(o + 64) = w; }
            }
    }
};
}

#define XB_TMO      128
#define XB_XCNT(j)  (256  + 64 * (j))
#define XB_XSUB(j)  (1280 + 64 * (j))
#define XB_XGEN(j)  (2304 + 64 * (j))
#define XB_TOP      3328
#define XB_TOPGEN   3392
#define XCD_BAR_WORDS 3456
#define XB_SPIN_CAP (1u << 18)
__device__ __forceinline__ unsigned xb_ld(unsigned* p)              { return __hip_atomic_load(p, __ATOMIC_RELAXED, __HIP_MEMORY_SCOPE_AGENT); }
__device__ __forceinline__ unsigned xb_add(unsigned* p, unsigned v) { return __hip_atomic_fetch_add(p, v, __ATOMIC_RELAXED, __HIP_MEMORY_SCOPE_AGENT); }
__device__ __forceinline__ unsigned xb_xcc_id() { return (unsigned)__builtin_amdgcn_s_getreg((3 << 11) | 20) & 0xFu; }
#define XB_SPIN(cond, bar) do { unsigned _sp = 0; while (cond) { __builtin_amdgcn_s_sleep(1); \
    if ((++_sp & 255u) == 0u) { if (xb_ld(&(bar)[XB_TMO])) break; if (_sp > XB_SPIN_CAP) { atomicAdd(&(bar)[XB_TMO], 1u); break; } } } } while (0)
struct XcdBarrier { unsigned* bar; unsigned x; volatile LAS unsigned* st; };
__device__ __forceinline__ XcdBarrier xcd_barrier_post(unsigned* bar, volatile LAS unsigned* st) {
    XcdBarrier b; b.bar = bar; b.x = xb_xcc_id(); b.st = st;
    if (threadIdx.x == 0) (void)xb_add(&bar[XB_XCNT(b.x)], 1u);
    return b;
}
__device__ __forceinline__ void xcd_barrier_complete(unsigned* bar, unsigned x, unsigned& nloc, unsigned& nx) {
    const unsigned G = gridDim.x * gridDim.y * gridDim.z;
    unsigned sum, cnt, mine, sp = 0u;
    for (;;) {
        sum = 0u; cnt = 0u; mine = 0u;
#pragma unroll
        for (unsigned j = 0; j < 16; ++j) { const unsigned c = xb_ld(&bar[XB_XCNT(j)]); sum += c; cnt += (c > 0u) ? 1u : 0u; mine = (j == x) ? c : mine; }
        if (sum == G) break;
        __builtin_amdgcn_s_sleep(1);
        if ((++sp & 255u) == 0u) { if (xb_ld(&bar[XB_TMO])) break; if (sp > XB_SPIN_CAP) { atomicAdd(&bar[XB_TMO], 1u); break; } }
    }
    nloc = mine > 0u ? mine : 1u; nx = cnt > 0u ? cnt : 1u;
}
__device__ __forceinline__ void xcd_barrier(const XcdBarrier& b) {
    asm volatile("s_waitcnt vmcnt(0)" ::: "memory");
    __syncthreads();
    if (threadIdx.x == 0) {
        unsigned* bar = b.bar;
        __builtin_amdgcn_s_waitcnt(0);
        unsigned nloc = b.st[0], nx = b.st[1];
        if (nloc == 0u) { xcd_barrier_complete(bar, b.x, nloc, nx); b.st[0] = nloc; b.st[1] = nx; }
        const unsigned old = xb_add(&bar[XB_XSUB(b.x)], 1u);
        const unsigned gen = old / nloc;
        if (old + 1u == (gen + 1u) * nloc) {
            __builtin_amdgcn_fence(__ATOMIC_RELEASE, "agent");
            asm volatile("s_waitcnt vmcnt(0)" ::: "memory");
            const unsigned og = xb_add(&bar[XB_TOP], 1u);
            const unsigned tg = og / nx;
            if (og + 1u == (tg + 1u) * nx) xb_add(&bar[XB_TOPGEN], 1u);
            else XB_SPIN(xb_ld(&bar[XB_TOPGEN]) == tg, bar);
            __builtin_amdgcn_fence(__ATOMIC_ACQUIRE, "agent");
            xb_add(&bar[XB_XGEN(b.x)], 1u);
            asm volatile("s_waitcnt vmcnt(0)" ::: "memory");
        } else {
            XB_SPIN(xb_ld(&bar[XB_XGEN(b.x)]) == gen, bar);
            __builtin_amdgcn_fence(__ATOMIC_ACQUIRE, "agent");
            asm volatile("s_waitcnt vmcnt(0)" ::: "memory");
        }
    }
    __syncthreads();
}


namespace at {
typedef float f32x16 __attribute__((ext_vector_type(16)));
typedef short s16x4 __attribute__((ext_vector_type(4)));
__device__ __forceinline__ int crow(int r, int hi) { return (r & 3) + 8 * (r >> 2) + 4 * hi; }
__device__ __forceinline__ s16x4 vtr(const LAS unsigned char* p) { return __builtin_bit_cast(s16x4, __builtin_amdgcn_ds_read_tr16_b64_v4i16((LAS s16x4*)p)); }
__device__ __forceinline__ float bflo(unsigned u) { return __uint_as_float(u << 16); }
__device__ __forceinline__ float bfhi(unsigned u) { return __uint_as_float(u & 0xffff0000u); }

__device__ __forceinline__ void v_frags(bf16x8 (&vf)[8], const LAS unsigned char* vlane) {
#pragma unroll
    for (int d0 = 0; d0 < 2; ++d0)
#pragma unroll
        for (int ks = 0; ks < 4; ++ks) {
            const s16x4 lo = vtr(vlane + d0 * 4096 + ks * 1024), hi = vtr(vlane + d0 * 4096 + ks * 1024 + 512);
            vf[d0 * 4 + ks] = (bf16x8){lo[0], lo[1], lo[2], lo[3], hi[0], hi[1], hi[2], hi[3]};
        }
}
__device__ __forceinline__ void v_frags_half(bf16x8 (&vf)[4], const LAS unsigned char* vlane, int d0) {
#pragma unroll
    for (int ks = 0; ks < 4; ++ks) {
        const s16x4 lo = vtr(vlane + d0 * 4096 + ks * 1024), hi = vtr(vlane + d0 * 4096 + ks * 1024 + 512);
        vf[ks] = (bf16x8){lo[0], lo[1], lo[2], lo[3], hi[0], hi[1], hi[2], hi[3]};
    }
}
__device__ __forceinline__ void pv_mma_half(f32x16& o, const bf16x8 (&vf)[4], const u32x4 (&pw)[4]) {
    __builtin_amdgcn_s_setprio(1);
#pragma unroll
    for (int ks = 0; ks < 4; ++ks) o = __builtin_amdgcn_mfma_f32_32x32x16_bf16(__builtin_bit_cast(bf16x8, pw[ks]), vf[ks], o, 0, 0, 0);
    __builtin_amdgcn_s_setprio(0);
}
__device__ __forceinline__ void pv_mma(f32x16 (&o)[2], const bf16x8 (&vf)[8], const u32x4 (&pw)[4]) {
    __builtin_amdgcn_s_setprio(1);
#pragma unroll
    for (int ks = 0; ks < 4; ++ks)
#pragma unroll
        for (int d0 = 0; d0 < 2; ++d0) o[d0] = __builtin_amdgcn_mfma_f32_32x32x16_bf16(__builtin_bit_cast(bf16x8, pw[ks]), vf[d0 * 4 + ks], o[d0], 0, 0, 0);
    __builtin_amdgcn_s_setprio(0);
}
constexpr float SM_THR = 8.f;
__device__ __forceinline__ bool softmax_step(f32x16& p0, f32x16& p1, float& mhat, float& l, f32x16 (&o)[2], u32x4 (&pw)[4], LAS float* wsf, int r32, int hi, bool first) {
    float a = fmaxf(fmaxf(p0[0], p1[0]), fmaxf(p0[1], p1[1]));
#pragma unroll
    for (int r = 2; r < 16; r += 2) a = fmaxf(a, fmaxf(fmaxf(p0[r], p1[r]), fmaxf(p0[r + 1], p1[r + 1])));
    a = max_x32(a);
    const bool moved = first || __any(a > SM_THR);
    if (moved) {
        const float dl = first ? a : fmaxf(a, 0.f);
        mhat += dl;
#pragma unroll
        for (int r = 0; r < 16; ++r) { p0[r] -= dl; p1[r] -= dl; }
        if (!first) {
            const float f = __builtin_amdgcn_exp2f(-dl);
            l *= f;
            if (hi == 0) wsf[r32] = f;
            asm volatile("s_waitcnt lgkmcnt(0)" ::: "memory");
#pragma unroll
            for (int g = 0; g < 4; ++g) { const f32x4 al = *(const LAS f32x4*)(wsf + 8 * g + 4 * hi);
#pragma unroll
                for (int j = 0; j < 4; ++j) { o[0][4 * g + j] *= al[j]; o[1][4 * g + j] *= al[j]; } }
        }
    }
    f32x2 sa = (f32x2){0.f, 0.f}, sb = (f32x2){0.f, 0.f};
#pragma unroll
    for (int r = 0; r < 16; r += 2) {
        p0[r] = __builtin_amdgcn_exp2f(p0[r]); p0[r + 1] = __builtin_amdgcn_exp2f(p0[r + 1]); p1[r] = __builtin_amdgcn_exp2f(p1[r]); p1[r + 1] = __builtin_amdgcn_exp2f(p1[r + 1]);
        sa += (f32x2){p0[r], p0[r + 1]}; sb += (f32x2){p1[r], p1[r + 1]};
    }
    sa += sb; l += sa.x + sa.y;
#pragma unroll
    for (int k = 0; k < 2; ++k) {
        pw[k].x = cvt_pk_bf16(p0[8 * k + 0], p0[8 * k + 1]); pw[k].y = cvt_pk_bf16(p0[8 * k + 2], p0[8 * k + 3]); pw[k].z = cvt_pk_bf16(p0[8 * k + 4], p0[8 * k + 5]); pw[k].w = cvt_pk_bf16(p0[8 * k + 6], p0[8 * k + 7]);
        pw[2 + k].x = cvt_pk_bf16(p1[8 * k + 0], p1[8 * k + 1]); pw[2 + k].y = cvt_pk_bf16(p1[8 * k + 2], p1[8 * k + 3]); pw[2 + k].z = cvt_pk_bf16(p1[8 * k + 4], p1[8 * k + 5]); pw[2 + k].w = cvt_pk_bf16(p1[8 * k + 6], p1[8 * k + 7]);
    }    return moved;
}
__device__ __forceinline__ void finish_store(const f32x16 (&o)[2], float l, LAS float* wsf, int r32, int hi, bf16_t* Orow0, size_t ostride) {
    l = sum_x32(l);
    if (hi == 0) wsf[32 + r32] = l;
    asm volatile("s_waitcnt lgkmcnt(0)" ::: "memory");
#pragma unroll
    for (int g = 0; g < 4; ++g) { const f32x4 lv = *(const LAS f32x4*)(wsf + 32 + 8 * g + 4 * hi);
#pragma unroll
        for (int j = 0; j < 4; ++j) { const float rl = __builtin_amdgcn_rcpf(lv[j]); const int row = 8 * g + 4 * hi + j;
            Orow0[(size_t)row * ostride + r32] = f2bf(o[0][4 * g + j] * rl); Orow0[(size_t)row * ostride + 32 + r32] = f2bf(o[1][4 * g + j] * rl); } }
}

constexpr int MLA_KB = 12288, MLA_BUF = 20480;
template <class BG>
__device__ __forceinline__ void mla_unit(LAS unsigned char* lds, int b, int h, int qb, const bf16_t* QR, const bf16_t* KM, const bf16_t* VM, const float* ROPE, const float* gq, bf16_t* OB, BG& bg, const int abl = 0) {
    int tid = threadIdx.x; asm volatile("" : "+v"(tid));
    const int lane = tid & 63, r32 = lane & 31, hi = lane >> 5, wid = __builtin_amdgcn_readfirstlane(tid >> 6);
    const int q0 = qb * 256, NTL = 4 * (qb + 1), rowbase = b * SEQ;
    LAS float* wsf = (LAS float*)(lds + 2 * MLA_BUF) + wid * 64;
    const bf16_t* kg0 = KM + ((size_t)(rowbase + lane) * 16 + h) * 96 + wid * 8;
    const bf16_t* kg1 = KM + ((size_t)(rowbase + lane) * 16 + h) * 96 + (8 + (wid & 3)) * 8;
    const bf16_t* vg = VM + (size_t)(rowbase + 16 * (wid & 3) + (lane >> 2)) * 1024 + h * 64 + (wid >> 2) * 32 + (lane & 3) * 8;
    const int kl0 = wid * 1024 + lane * 16, kl1 = (8 + (wid & 3)) * 1024 + lane * 16, vl = MLA_KB + wid * 1024 + lane * 16;
    u32x4 ak0, ak1, av, bk0, bk1, bv; ak1 = (u32x4){0u, 0u, 0u, 0u}; bk1 = ak1;
#define MLA_LOAD(S, t) do { S##k0 = *(const GAS u32x4*)(kg0 + (size_t)(t) * 64 * 1536); if (wid < 4) S##k1 = *(const GAS u32x4*)(kg1 + (size_t)(t) * 64 * 1536); S##v = *(const GAS u32x4*)(vg + (size_t)(t) * 64 * 1024); } while (0)
#define MLA_WRITE(S, buf) do { *(LAS u32x4*)(lds + (buf) * MLA_BUF + kl0) = S##k0; if (wid < 4) *(LAS u32x4*)(lds + (buf) * MLA_BUF + kl1) = S##k1; *(LAS u32x4*)(lds + (buf) * MLA_BUF + vl) = S##v; } while (0)
    MLA_LOAD(a, 0);
    bf16x8 qr[6];
    {
        const int qrow = rowbase + q0 + wid * 32 + r32;
        const bf16_t* qp = QR + (size_t)qrow * 1536 + h * 96 + hi * 8;
        float qf[6][8]; float ss = 0.f;
#pragma unroll
        for (int d0 = 0; d0 < 6; ++d0) { const u32x4 w = *(const GAS u32x4*)(qp + 16 * d0);
            qf[d0][0] = bflo(w.x); qf[d0][1] = bfhi(w.x); qf[d0][2] = bflo(w.y); qf[d0][3] = bfhi(w.y); qf[d0][4] = bflo(w.z); qf[d0][5] = bfhi(w.z); qf[d0][6] = bflo(w.w); qf[d0][7] = bfhi(w.w);
#pragma unroll
            for (int j = 0; j < 8; ++j) ss += qf[d0][j] * qf[d0][j]; }
        ss = sum_x32(ss);
        const float rn = rsqrtf(ss * (1.f / 96.f) + EPS) * C3;
#pragma unroll
        for (int d0 = 0; d0 < 6; ++d0) { const f32x4 g0 = *(const GAS f32x4*)(gq + 16 * d0 + 8 * hi), g1 = *(const GAS f32x4*)(gq + 16 * d0 + 8 * hi + 4);
#pragma unroll
            for (int j = 0; j < 4; ++j) { qf[d0][j] *= rn * g0[j]; qf[d0][4 + j] *= rn * g1[j]; } }
        { const f32x4 c0 = *(const GAS f32x4*)(ROPE + (size_t)qrow * 16 + 8 * hi), c1 = *(const GAS f32x4*)(ROPE + (size_t)qrow * 16 + 8 * hi + 4);
          const f32x4 s0 = *(const GAS f32x4*)(ROPE + (size_t)NT * 16 + (size_t)qrow * 16 + 8 * hi), s1 = *(const GAS f32x4*)(ROPE + (size_t)NT * 16 + (size_t)qrow * 16 + 8 * hi + 4);
#pragma unroll
          for (int j = 0; j < 8; ++j) { const float cs = j < 4 ? c0[j & 3] : c1[j & 3], sn = j < 4 ? s0[j & 3] : s1[j & 3]; const float t1 = qf[4][j], t2 = qf[5][j];
              qf[4][j] = t1 * cs - t2 * sn; qf[5][j] = t1 * sn + t2 * cs; } }
#pragma unroll
        for (int d0 = 0; d0 < 6; ++d0) { u32x4 w; w.x = cvt_pk_bf16(qf[d0][0], qf[d0][1]); w.y = cvt_pk_bf16(qf[d0][2], qf[d0][3]); w.z = cvt_pk_bf16(qf[d0][4], qf[d0][5]); w.w = cvt_pk_bf16(qf[d0][6], qf[d0][7]);
            qr[d0] = __builtin_bit_cast(bf16x8, w); }
    }
    MLA_WRITE(a, 0);
    MLA_LOAD(a, 1);
    __syncthreads();
    float m = 0.f, l = 0.f; f32x16 o[2], negm;
#pragma unroll
    for (int r = 0; r < 16; ++r) { o[0][r] = 0.f; o[1][r] = 0.f; negm[r] = 0.f; }
    const int qabs = q0 + wid * 32 + r32, qmax_w = q0 + wid * 32 + 31;
    const int voff = MLA_KB + ((lane >> 4) & 1) * 32 + (lane & 3) * 8 + (4 * hi + ((lane & 15) >> 2)) * 64;
#define MLA_STEP(t, buf, LS, WS) do { \
        if (!(abl & 4)) bg.tick();                                   \
        if ((t) + 2 < NTL && !(abl & 2)) MLA_LOAD(LS, (t) + 2); \
        if (64 * (t) <= qmax_w && !(abl & 1)) {                      \
            const LAS unsigned char* kb = lds + (buf) * MLA_BUF + hi * 1024 + r32 * 16; \
            bf16x8 kf[12]; \
            _Pragma("unroll") for (int d0 = 0; d0 < 6; ++d0) { kf[2 * d0] = *(const LAS bf16x8*)(kb + d0 * 2048); kf[2 * d0 + 1] = *(const LAS bf16x8*)(kb + d0 * 2048 + 512); } \
            f32x16 p0, p1; \
            __builtin_amdgcn_sched_barrier(0); \
            __builtin_amdgcn_s_setprio(1); \
            p0 = __builtin_amdgcn_mfma_f32_32x32x16_bf16(kf[0], qr[0], negm, 0, 0, 0);     \
            p1 = __builtin_amdgcn_mfma_f32_32x32x16_bf16(kf[1], qr[0], negm, 0, 0, 0); \
            _Pragma("unroll") for (int d0 = 1; d0 < 6; ++d0) { \
                p0 = __builtin_amdgcn_mfma_f32_32x32x16_bf16(kf[2 * d0], qr[d0], p0, 0, 0, 0); \
                p1 = __builtin_amdgcn_mfma_f32_32x32x16_bf16(kf[2 * d0 + 1], qr[d0], p1, 0, 0, 0); } \
            __builtin_amdgcn_s_setprio(0); \
            bf16x8 vf[8]; \
            v_frags(vf, lds + (buf) * MLA_BUF + voff); \
            __builtin_amdgcn_sched_barrier(0); \
            if (64 * (t) + 63 > q0 + wid * 32) {                     \
                _Pragma("unroll") for (int r = 0; r < 16; ++r) { const int kv = 64 * (t) + crow(r, hi); if (kv > qabs) p0[r] = -INFINITY; if (kv + 32 > qabs) p1[r] = -INFINITY; } } \
            u32x4 pw[4]; \
            if (softmax_step(p0, p1, m, l, o, pw, wsf, r32, hi, (t) == 0)) { _Pragma("unroll") for (int r = 0; r < 16; ++r) negm[r] = -m; } \
            __builtin_amdgcn_sched_barrier(0); \
            pv_mma(o, vf, pw); \
        } \
        if ((t) + 1 < NTL && !(abl & 2)) MLA_WRITE(WS, (buf) ^ 1); \
        __syncthreads(); } while (0)
#pragma unroll 1
    for (int t = 0; t < NTL; t += 2) {
        MLA_STEP(t, 0, b, a);
        MLA_STEP(t + 1, 1, a, b);
    }
#undef MLA_STEP
#undef MLA_LOAD
#undef MLA_WRITE
    finish_store(o, l, wsf, r32, hi, OB + (size_t)(rowbase + q0 + wid * 32) * 1024 + h * 64, 1024);
    __syncthreads();
}

struct DilU { int b, h, dil, r, n; };
struct DilStage { u32x4 kk[8], vv[8]; int pk; };
__device__ __forceinline__ void dil_load_k(DilStage& st, const DilU& u, int hw, int lane, const bf16_t* K, const int* pos) {
    if (hw >= ((u.n == 0) ? 2 : 0)) {
        const int rowbase = u.b * SEQ, ci = 64 * hw + lane, tokk = (128 * (u.n - 1) + ci) * u.dil + u.r;
        const bf16_t* kg = K + (size_t)(rowbase + tokk) * 1024 + u.h * 64;
#pragma unroll
        for (int c = 0; c < 8; ++c) st.kk[c] = *(const GAS u32x4*)(kg + c * 8);
        st.pk = pos[rowbase + tokk];
    }
}
__device__ __forceinline__ void dil_load_v(DilStage& st, const DilU& u, int hw, int lane, const bf16_t* V) {
    if (hw >= ((u.n == 0) ? 2 : 0)) {
        const int rowbase = u.b * SEQ;
#pragma unroll
        for (int pc = 0; pc < 8; ++pc) { const int rg = pc & 3, dh = pc >> 2; const int cv = 64 * hw + 16 * rg + (lane >> 2); const int tokv = (128 * (u.n - 1) + cv) * u.dil + u.r;
            st.vv[pc] = *(const GAS u32x4*)(V + (size_t)(rowbase + tokv) * 1024 + u.h * 64 + dh * 32 + (lane & 3) * 8); }
    }
}
__device__ __forceinline__ void dil_write(const DilStage& st, const DilU& u, LAS unsigned char* hl, LAS float* xs, int hw, int lane) {
    if (hw >= ((u.n == 0) ? 2 : 0)) {
#pragma unroll
        for (int c = 0; c < 8; ++c) *(LAS u32x4*)(hl + hw * 8192 + c * 1024 + lane * 16) = st.kk[c];
#pragma unroll
        for (int pc = 0; pc < 8; ++pc) *(LAS u32x4*)(hl + 32768 + hw * 8192 + pc * 1024 + lane * 16) = st.vv[pc];
        xs[64 * hw + lane] = (float)st.pk;
    }
}
struct RingStage { u32x4 d[8]; int pk; };
__device__ __forceinline__ void ring_load(RingStage& st, const DilU& u0, int wv, int lane, const bf16_t* K, const bf16_t* V, const int* pos) {
    const int j = wv >> 1, rowbase = u0.b * SEQ, key0 = 128 * (u0.n + (j >> 1)) + 64 * (j & 1);
    if (!(wv & 1)) {
        const int tok = (key0 + lane) * u0.dil + u0.r;
        const bf16_t* kg = K + (size_t)(rowbase + tok) * 1024 + u0.h * 64;
#pragma unroll
        for (int c = 0; c < 8; ++c) st.d[c] = *(const GAS u32x4*)(kg + c * 8);
        st.pk = pos[rowbase + tok];
    } else {
#pragma unroll
        for (int pc = 0; pc < 8; ++pc) { const int rg = pc & 3, dh = pc >> 2; const int tok = (key0 + 16 * rg + (lane >> 2)) * u0.dil + u0.r;
            st.d[pc] = *(const GAS u32x4*)(V + (size_t)(rowbase + tok) * 1024 + u0.h * 64 + dh * 32 + (lane & 3) * 8); }
    }
}
__device__ __forceinline__ void ring_write(const RingStage& st, const DilU& u0, LAS unsigned char* lds, LAS float* xs, int wv, int lane) {
    const int j = wv >> 1, slot = (u0.n + (j >> 1)) & 3;
    LAS unsigned char* base = lds + slot * 32768 + (j & 1) * 8192 + ((wv & 1) ? 16384 : 0);
#pragma unroll
    for (int c = 0; c < 8; ++c) *(LAS u32x4*)(base + c * 1024 + lane * 16) = st.d[c];
    if (!(wv & 1)) xs[slot * 128 + (j & 1) * 64 + lane] = (float)st.pk;
}
template <bool MERGE, bool RING>
__device__ __forceinline__ void dil_compute(LAS unsigned char* hl, LAS float* xs, int hw, int wv, int lane, const DilU& u, const bf16x8 (&qr)[4], float posq,
                                            bf16_t* PARTg, float* LSEg, const bf16_t* P0, const bf16_t* P1, const float* L0, const float* L1, bf16_t* OB, const int abl = 0) {
    const int b = u.b, h = u.h, dil = u.dil, r = u.r, n = u.n;
    const int r32 = lane & 31, hi = lane >> 5;
    const int rowbase = b * SEQ, first_tile = (n == 0) ? 2 : 0;
    LAS float* wsf = RING ? xs + 512 + wv * 64 : xs + 256 + hw * 64;
    const int a = 32 * hw + r32;
    const int tokq = (128 * n + a) * dil + r;
    const float slope2 = exp2f(-0.5f * (float)(h + 1)) * LOG2E;
    float m = 0.f, l = 0.f; f32x16 o[2], negm;
#pragma unroll
    for (int rr = 0; rr < 16; ++rr) { o[0][rr] = 0.f; o[1][rr] = 0.f; negm[rr] = 0.f; }
    const int tlo = max((32 * hw) >> 6, first_tile), thi = (abl & 1) ? -1 : min((32 * hw + 159) >> 6, 3);
    const int voff = ((lane >> 4) & 1) * 32 + (lane & 3) * 8 + (4 * hi + ((lane & 15) >> 2)) * 64;
#pragma unroll 1
    for (int T = tlo; T <= thi; ++T) {
        const int slot = (n - 1 + (T >> 1)) & 3;
        const int kofs = RING ? slot * 32768 + (T & 1) * 8192 : T * 8192, vofs = RING ? kofs + 16384 : 32768 + T * 8192;
        const LAS float* posk = RING ? xs + slot * 128 + (T & 1) * 64 : xs + 64 * T;
        const LAS unsigned char* kb = hl + kofs + hi * 1024 + r32 * 16;
        bf16x8 kf[8];
#pragma unroll
        for (int d0 = 0; d0 < 4; ++d0) { kf[2 * d0] = *(const LAS bf16x8*)(kb + d0 * 2048); kf[2 * d0 + 1] = *(const LAS bf16x8*)(kb + d0 * 2048 + 512); }
        f32x16 p0, p1;
        __builtin_amdgcn_sched_barrier(0);
        __builtin_amdgcn_s_setprio(1);
        p0 = __builtin_amdgcn_mfma_f32_32x32x16_bf16(kf[0], qr[0], negm, 0, 0, 0);
        p1 = __builtin_amdgcn_mfma_f32_32x32x16_bf16(kf[1], qr[0], negm, 0, 0, 0);
#pragma unroll
        for (int d0 = 1; d0 < 4; ++d0) {
            p0 = __builtin_amdgcn_mfma_f32_32x32x16_bf16(kf[2 * d0], qr[d0], p0, 0, 0, 0);
            p1 = __builtin_amdgcn_mfma_f32_32x32x16_bf16(kf[2 * d0 + 1], qr[d0], p1, 0, 0, 0);
        }
        __builtin_amdgcn_s_setprio(0);
        bf16x8 vf0[4];
        v_frags_half(vf0, hl + vofs + voff, 0);
        __builtin_amdgcn_sched_barrier(0);
#pragma unroll
        for (int g = 0; g < 4; ++g) { const f32x4 pa = *(const LAS f32x4*)(posk + 8 * g + 4 * hi), pb = *(const LAS f32x4*)(posk + 32 + 8 * g + 4 * hi);
#pragma unroll
            for (int j = 0; j < 4; ++j) { p0[4 * g + j] += slope2 * (pa[j] - posq); p1[4 * g + j] += slope2 * (pb[j] - posq); } }
        if (64 * T < 32 * hw + 31 || 64 * T + 63 > 32 * hw + 128) {
#pragma unroll
            for (int rr = 0; rr < 16; ++rr) { const int c0 = 64 * T + crow(rr, hi), c1 = c0 + 32;
                if (c0 < a || c0 > a + 128) p0[rr] = -INFINITY;
                if (c1 < a || c1 > a + 128) p1[rr] = -INFINITY; }
        }
        u32x4 pw[4];
        if (softmax_step(p0, p1, m, l, o, pw, wsf, r32, hi, T == tlo)) {
#pragma unroll
            for (int rr = 0; rr < 16; ++rr) negm[rr] = -m; }
        bf16x8 vf1[4];
        v_frags_half(vf1, hl + vofs + voff, 1);
        __builtin_amdgcn_sched_barrier(0);
        pv_mma_half(o[0], vf0, pw);
        pv_mma_half(o[1], vf1, pw);
    }
    l = sum_x32(l);
    int r32e = r32, hie = hi; asm volatile("" : "+v"(r32e), "+v"(hie));
    const int tokqe = (128 * n + 32 * hw + r32e) * dil + r;
    if (!MERGE) {
        if (hie == 0) { wsf[32 + r32e] = l; LSEg[(size_t)(rowbase + tokqe) * 16 + h] = m + log2f(l); }
        asm volatile("s_waitcnt lgkmcnt(0)" ::: "memory");
#pragma unroll
        for (int g = 0; g < 4; ++g) { const f32x4 lv = *(const LAS f32x4*)(wsf + 32 + 8 * g + 4 * hie);
#pragma unroll
            for (int j = 0; j < 4; ++j) { const float rl = __builtin_amdgcn_rcpf(lv[j]); const int tok = (128 * n + 32 * hw + 8 * g + 4 * hie + j) * dil + r;
                bf16_t* op = PARTg + (size_t)(rowbase + tok) * 1024 + h * 64 + r32e;
                op[0] = f2bf(o[0][4 * g + j] * rl); op[32] = f2bf(o[1][4 * g + j] * rl); } }
    } else {
        if (hie == 0) { wsf[32 + r32e] = l; wsf[r32e] = m + log2f(l); }
        asm volatile("s_waitcnt lgkmcnt(0)" ::: "memory");
#pragma unroll
        for (int g = 0; g < 4; ++g) {
            float e0[4], e1[4]; bf16_t a0[4], a1[4], b0[4], b1[4];
#pragma unroll
            for (int j = 0; j < 4; ++j) { const int tok = (128 * n + 32 * hw + 8 * g + 4 * hie + j) * dil + r; const size_t rw = (size_t)(rowbase + tok), off = rw * 1024 + h * 64 + r32e;
                e0[j] = L0[rw * 16 + h]; e1[j] = L1[rw * 16 + h]; a0[j] = P0[off]; a1[j] = P0[off + 32]; b0[j] = P1[off]; b1[j] = P1[off + 32]; }
            const f32x4 lv = *(const LAS f32x4*)(wsf + 32 + 8 * g + 4 * hie), ls2 = *(const LAS f32x4*)(wsf + 8 * g + 4 * hie);
#pragma unroll
            for (int j = 0; j < 4; ++j) { const int rr = 4 * g + j; const int tok = (128 * n + 32 * hw + 8 * g + 4 * hie + j) * dil + r; const size_t rw = (size_t)(rowbase + tok);
                const float e2 = ls2[j];
                const float M = fmaxf(fmaxf(e0[j], e1[j]), e2); const float w0 = exp2f(e0[j] - M), w1 = exp2f(e1[j] - M), w2 = exp2f(e2 - M);
                const float rden = __builtin_amdgcn_rcpf(w0 + w1 + w2), w2l = w2 * __builtin_amdgcn_rcpf(lv[j]);
                const size_t off = rw * 1024 + h * 64 + r32e;
                OB[off] = f2bf((w0 * bf2f(a0[j]) + w1 * bf2f(b0[j]) + w2l * o[0][rr]) * rden); OB[off + 32] = f2bf((w0 * bf2f(a1[j]) + w1 * bf2f(b1[j]) + w2l * o[1][rr]) * rden); }
        }
    }
}
}

namespace mk {
constexpr int NWAVES = 8, NTHREADS = 512;
constexpr int RING_BYTES = 131072, LDSCTL_OFF = RING_BYTES, MISC_OFF = LDSCTL_OFF + 2048;
constexpr int XS_OFF = RING_BYTES + 4096;
constexpr int LDS_BYTES = RING_BYTES + 4096 + 4096;
constexpr int CW_BAR = 4096;
constexpr int NPHASE = 19;

struct Args {
    const float* in[30]; float* out; unsigned char* ws; int ph_lo, ph_hi;
};

__device__ __forceinline__ float wave_sum(float v) { return wave_sum_all(v); }

struct TItem { const float* W; int ldw, k0, srccol0; bf16_t* WT; bf16_t* lo; int Kd, dstrow0, spread; const float* ks; };
__device__ __forceinline__ void titem_load(const TItem& it, f32x4 (&v)[8], int lane) {
    const int c = lane & 7, coff = it.spread ? 16 * (c >> 1) + 4 * (c & 1) : 4 * c;
#pragma unroll
    for (int i = 0; i < 8; ++i) v[i] = __builtin_nontemporal_load((const GAS f32x4*)(it.W + (size_t)(it.k0 + 8 * i + (lane >> 3)) * it.ldw + it.srccol0 + coff));
}
__device__ __forceinline__ void titem_finish(const TItem& it, const f32x4 (&v)[8], LAS float* scr, int lane) {
#pragma unroll
    for (int i = 0; i < 8; ++i) { LAS float* d = scr + (8 * i + (lane >> 3)) * 33 + 4 * (lane & 7); d[0] = v[i].x; d[1] = v[i].y; d[2] = v[i].z; d[3] = v[i].w; }
    asm volatile("s_waitcnt lgkmcnt(0)" ::: "memory");
    const int c = lane & 7;
#pragma unroll
    for (int j = 0; j < 4; ++j) { const int n = (lane >> 3) + 8 * j; const LAS float* sp = scr + (8 * c) * 33 + n;
        float f[8];
#pragma unroll
        for (int q = 0; q < 8; ++q) f[q] = sp[q * 33];
        if (it.ks) { const f32x4 s0 = *(const GAS f32x4*)(it.ks + it.k0 + 8 * c), s1 = *(const GAS f32x4*)(it.ks + it.k0 + 8 * c + 4);
            f[0] *= s0.x; f[1] *= s0.y; f[2] *= s0.z; f[3] *= s0.w; f[4] *= s1.x; f[5] *= s1.y; f[6] *= s1.z; f[7] *= s1.w; }
        u32x4 o; o.x = pk2(f[0], f[1]); o.y = pk2(f[2], f[3]); o.z = pk2(f[4], f[5]); o.w = pk2(f[6], f[7]);
        __builtin_nontemporal_store(o, (GAS u32x4*)(it.WT + (size_t)(it.dstrow0 + n) * it.Kd + it.k0 + 8 * c));
        if (it.lo) {
            float rs[8];
#pragma unroll
            for (int q = 0; q < 8; ++q) rs[q] = f[q] - bf2f(f2bf(f[q]));
            u32x4 ol; ol.x = pk2(rs[0], rs[1]); ol.y = pk2(rs[2], rs[3]); ol.z = pk2(rs[4], rs[5]); ol.w = pk2(rs[6], rs[7]);
            *(GAS u32x4*)(it.lo + (size_t)(it.dstrow0 + n) * it.Kd + it.k0 + 8 * c) = ol;
        }
    }
    asm volatile("s_waitcnt lgkmcnt(0)" ::: "memory");
}

__device__ __forceinline__ int hpw_src_block(int db) { const int pn = db >> 3, q = db & 7, bj = q >> 2, wc = q & 3; return (4 * pn + wc) * 2 + bj; }

__device__ __forceinline__ int opaque(int v) { asm volatile("" : "+v"(v)); return v; }
struct Ctx {
    LAS unsigned char* lds; int tid, lane, wave, G, vcu;
    unsigned char* ws; const float* const* in; float* out;
};
template <class T> __device__ __forceinline__ T* opaque_uniform_ptr(T* p) {
    const unsigned long long u = (unsigned long long)p;
    unsigned lo = __builtin_amdgcn_readfirstlane((unsigned)u), hi = __builtin_amdgcn_readfirstlane((unsigned)(u >> 32));
    asm volatile("" : "+s"(lo), "+s"(hi));
    return (T*)(((unsigned long long)hi << 32) | lo);
}
__device__ __forceinline__ Ctx phase_ctx(const Ctx& F0) {
    Ctx F = F0; F.lane = opaque(F0.lane); F.tid = opaque(F0.tid);
    F.ws = opaque_uniform_ptr(F0.ws); F.out = opaque_uniform_ptr(F0.out); return F;
}

constexpr int I_QKV = 16 * 96, I_O = 16 * 32, I_KVD = 0, I_DQ = 0  , I_UK = 4 * 32, I_UQ = 6 * 48, I_R = 2 * 16 * 2;
constexpr int I_GU1 = 16 * 16, I_DN1 = 4 * 32, I_GUL = 65 * I_GU1, I_DNL = 65 * I_DN1, I_MOEL = I_GUL + I_DNL;
constexpr int NITEMS_P0 = I_MOEL + I_QKV + 2 * I_O + I_KVD + I_DQ + 2 * I_UK + I_UQ + I_R;
__device__ __forceinline__ TItem decode_item(const Ctx& F, int it, int l) {
    bf16_t* Wqkv = (bf16_t*)(F.ws + WS_WQKV); bf16_t* Wo0 = (bf16_t*)(F.ws + WS_WO0); bf16_t* Wo1 = (bf16_t*)(F.ws + WS_WO1);
    bf16_t* Wkvd = (bf16_t*)(F.ws + WS_WKVD); bf16_t* Wdq = (bf16_t*)(F.ws + WS_WDQ); bf16_t* Wukv = (bf16_t*)(F.ws + WS_WUKV); bf16_t* Wuq = (bf16_t*)(F.ws + WS_WUQ);
    bf16_t* Wr = (bf16_t*)(F.ws + WS_WR); bf16_t* Wgu = (bf16_t*)(F.ws + WS_WGU); bf16_t* Wdn = (bf16_t*)(F.ws + WS_WDN);
    TItem t; t.lo = nullptr; t.spread = 0; t.ks = nullptr;
    int r = it;
    if (r < I_GUL) {
        const int e = r / I_GU1, rr = r % I_GU1, kb = rr >> 4, db = rr & 15, tl = db >> 3, q = db & 7, sb = (q >> 2) * 8 + tl * 4 + (q & 3), le = l * 65 + e;
        t.W = (e < 64) ? F.in[26] + ((size_t)l * 64 + e) * 1024 * 512 : F.in[28] + (size_t)l * 1024 * 512;
        t.ldw = 512; t.k0 = kb * 64; t.srccol0 = sb * 32; t.WT = Wgu + (size_t)le * 512 * 1024; t.Kd = 1024; t.dstrow0 = db * 32; return t; }
    r -= I_GUL;
    if (r < I_DNL) {
        const int e = r / I_DN1, rr = r % I_DN1, kb = rr >> 5, db = rr & 31, le = l * 65 + e;
        t.W = (e < 64) ? F.in[27] + ((size_t)l * 64 + e) * 256 * 1024 : F.in[29] + (size_t)l * 256 * 1024;
        { const int pn = db >> 3, q = db & 7, bj = q >> 2, wc = q & 3; t.srccol0 = pn * 256 + 64 * wc + 8 * bj; t.spread = 1; }
        t.ldw = 1024; t.k0 = kb * 64; t.WT = Wdn + (size_t)le * 1024 * 256; t.Kd = 256; t.dstrow0 = db * 32; return t; }
    r -= I_DNL;
    if (r < I_QKV) { const int kb = r / 96, db = r % 96, sct = db >> 5; t.W = F.in[7]; t.ldw = 3072; t.k0 = kb * 64; t.srccol0 = (sct * 32 + hpw_src_block(db & 31)) * 32; t.WT = Wqkv; t.Kd = 1024; t.dstrow0 = db * 32; return t; }
    r -= I_QKV;
    if (r < 2 * I_O) { const int w = r / I_O, rr = r % I_O, kb = rr >> 5, db = rr & 31; t.W = w ? F.in[23] : F.in[10]; t.ldw = 1024; t.k0 = kb * 64; t.srccol0 = db * 32; t.WT = w ? Wo1 : Wo0; t.Kd = 1024; t.dstrow0 = db * 32; return t; }
    r -= 2 * I_O;
    if (r < I_KVD) { const int kb = r / 9, db = r % 9; t.W = F.in[14]; t.ldw = 288; t.k0 = kb * 64; t.srccol0 = db * 32; t.WT = Wkvd; t.Kd = 1024; t.dstrow0 = db * 32; return t; }
    r -= I_KVD;
    if (r < I_DQ) { const int kb = r / 12, db = r % 12; t.W = F.in[19]; t.ldw = 384; t.k0 = kb * 64; t.srccol0 = db * 32; t.WT = Wdq; t.Kd = 1024; t.dstrow0 = db * 32; return t; }
    r -= I_DQ;
    if (r < 2 * I_UK) { const int w = r / I_UK, rr = r % I_UK, kb = rr >> 5, db = rr & 31; t.W = w ? F.in[17] : F.in[16]; t.ldw = 1024; t.k0 = kb * 64; t.srccol0 = hpw_src_block(db) * 32; t.WT = Wukv; t.Kd = 256; t.dstrow0 = w * 1024 + db * 32; t.ks = F.in[15]; return t; }
    r -= 2 * I_UK;
    if (r < I_UQ) { const int kb = r / 48, db = r % 48; t.W = F.in[21]; t.ldw = 1536; t.k0 = kb * 64; t.srccol0 = db * 32; t.WT = Wuq; t.Kd = 384; t.dstrow0 = db * 32; t.ks = F.in[20]; return t; }
    r -= I_UQ;
    { const int l = r >> 5, rr = r & 31, kb = rr >> 1, db = rr & 1;
      t.W = F.in[24] + (size_t)l * 1024 * 64; t.ldw = 64; t.k0 = kb * 64; t.srccol0 = db * 32; t.WT = Wr + (size_t)(l * 2 + 0) * 64 * 1024; t.lo = Wr + (size_t)(l * 2 + 1) * 64 * 1024; t.Kd = 1024; t.dstrow0 = db * 32; return t; }
}


struct BgConv {
    Ctx F; int l, idx, end, stride, cnt, base; bool pend; LAS float* scr; TItem it; f32x4 v[8];
    static constexpr int BG_PERIOD = 2;
    __device__ __forceinline__ void init(const Ctx& F_, int l_, int first, int end_, int stride_, LAS float* scr_) { F = F_; l = l_; idx = first; end = end_; stride = stride_; cnt = 0; base = 0; pend = false; scr = scr_; }
    __device__ __forceinline__ void tick() {
        if (++cnt < BG_PERIOD) return;
        cnt = 0;
        if (pend) { titem_finish(it, v, scr, F.lane); pend = false; }
        if (idx < end) { it = decode_item(F, base + idx, l); titem_load(it, v, F.lane); pend = true; idx += stride; }
    }
    __device__ __forceinline__ void step() {
        if (pend) { titem_finish(it, v, scr, F.lane); pend = false; }
        if (idx < end) { it = decode_item(F, base + idx, l); titem_load(it, v, F.lane); pend = true; idx += stride; }
    }
    __device__ __forceinline__ void drain() {
        for (;;) {
            if (pend) { titem_finish(it, v, scr, F.lane); pend = false; }
            if (idx >= end) break;
            it = decode_item(F, base + idx, l); titem_load(it, v, F.lane); pend = true; idx += stride;
        }
    }
};
struct BgNone { __device__ __forceinline__ void tick() {} };

__device__ __forceinline__ void phase_prologue(const Ctx& F0) {
    const Ctx F = phase_ctx(F0);
    LAS float* sc = (LAS float*)(F.lds + 8 * 16384 - 32768);
    LAS int* qctl = (LAS int*)(F.lds + XS_OFF);
    const float* c = F.in[1];
    if (F.tid < 3) qctl[F.tid] = 0;
    for (int i = F.tid; i < 8 * 1024; i += NTHREADS) { const float cv = c[i]; sc[i] = cv / (1.f + expf(-cv)); }
    __syncthreads();
    float* MOD = (float*)(F.ws + WS_MOD);
    LAS float* red = (LAS float*)(F.lds + 67584);
    if (F.wave < 4) {
        int seq = 0;
        for (int task = F.vcu; task < MODW / 64; task += F.G) {
            ++seq;
            const int j = task * 64 + F.lane;
            const float* W; int nc, jj; float bias;
            if (j < 12288) { const int l = j / 6144; jj = j % 6144; W = F.in[3] + (size_t)l * 1024 * 6144; nc = 6144; bias = F.in[4][l * 6144 + jj]; }
            else { jj = j - 12288; W = F.in[11]; nc = 2048; bias = F.in[12][jj]; }
            float acc[8];
#pragma unroll
            for (int b = 0; b < 8; ++b) acc[b] = 0.f;
            const int kbeg = F.wave * 256;
#pragma unroll 1
            for (int k0 = kbeg; k0 < kbeg + 256; k0 += 16) {
                float w[16];
#pragma unroll
                for (int q = 0; q < 16; ++q) w[q] = __builtin_nontemporal_load(W + (size_t)(k0 + q) * nc + jj);
#pragma unroll
                for (int q4 = 0; q4 < 4; ++q4)
#pragma unroll
                    for (int b = 0; b < 8; ++b) { const f32x4 s4 = *(const LAS f32x4*)(sc + b * 1024 + k0 + 4 * q4);
                        acc[b] += s4.x * w[4 * q4]; acc[b] += s4.y * w[4 * q4 + 1]; acc[b] += s4.z * w[4 * q4 + 2]; acc[b] += s4.w * w[4 * q4 + 3]; }
            }
            if (F.wave != 0) {
                while (__hip_atomic_load(qctl + 2, __ATOMIC_RELAXED, __HIP_MEMORY_SCOPE_WORKGROUP) != seq - 1) __builtin_amdgcn_s_sleep(2);
#pragma unroll
                for (int b = 0; b < 8; ++b) red[((F.wave - 1) * 8 + b) * 64 + F.lane] = acc[b];
                asm volatile("s_waitcnt lgkmcnt(0)" ::: "memory");
                if (F.lane == 0) __hip_atomic_fetch_add(qctl + 1, 1, __ATOMIC_RELEASE, __HIP_MEMORY_SCOPE_WORKGROUP);
            } else {
                while (__hip_atomic_load(qctl + 1, __ATOMIC_ACQUIRE, __HIP_MEMORY_SCOPE_WORKGROUP) != 3 * seq) __builtin_amdgcn_s_sleep(2);
#pragma unroll
                for (int b = 0; b < 8; ++b) MOD[b * MODW + j] = (((acc[b] + red[(0 * 8 + b) * 64 + F.lane]) + red[(1 * 8 + b) * 64 + F.lane]) + red[(2 * 8 + b) * 64 + F.lane]) + bias;
                asm volatile("s_waitcnt lgkmcnt(0)" ::: "memory");
                if (F.lane == 0) __hip_atomic_store(qctl + 2, seq, __ATOMIC_RELEASE, __HIP_MEMORY_SCOPE_WORKGROUP);
            }
        }
    }
    LAS float* scr = (LAS float*)(F.lds + F.wave * 8448);
    {
        constexpr int NITEMS = NITEMS_P0 - I_DNL;
#define P0_IDX(i) ((i) < I_GUL ? (i) : (i) + I_DNL)
#define P0_GRAB(dst) do { int s_ = 0; if (F.lane == 0) s_ = __hip_atomic_fetch_add(qctl, 1, __ATOMIC_RELAXED, __HIP_MEMORY_SCOPE_WORKGROUP); s_ = __builtin_amdgcn_readfirstlane(s_); dst = (F.vcu + (s_ >> 3) * F.G) * 8 + (s_ & 7); } while (0)
        f32x4 va[8], vb[8]; TItem ta, tb;
        int it; P0_GRAB(it);
        if (it < NITEMS) { ta = decode_item(F, P0_IDX(it), 0); titem_load(ta, va, F.lane); }
        while (it < NITEMS) {
            int itn; P0_GRAB(itn);
            if (itn < NITEMS) { tb = decode_item(F, P0_IDX(itn), 0); titem_load(tb, vb, F.lane); }
            titem_finish(ta, va, scr, F.lane);
            if (itn >= NITEMS) break;
            int itn2; P0_GRAB(itn2);
            if (itn2 < NITEMS) { ta = decode_item(F, P0_IDX(itn2), 0); titem_load(ta, va, F.lane); }
            titem_finish(tb, vb, scr, F.lane);
            it = itn2;
        }
#undef P0_GRAB
    }
}

__device__ __forceinline__ void modnorm_row(const float* xrow, const float* g, const float* sc, const float* sh, bf16_t* orow, int lane) {
    const GAS f32x4* xr = (const GAS f32x4*)xrow + lane;
    f32x4 v[4]; float s2 = 0.f;
#pragma unroll
    for (int j = 0; j < 4; ++j) { v[j] = xr[64 * j]; s2 += (v[j].x * v[j].x + v[j].y * v[j].y) + (v[j].z * v[j].z + v[j].w * v[j].w); }
    const float rstd = rsqrtf(wave_sum(s2) * (1.f / 1024.f) + EPS);
    GAS u32x2* o8 = (GAS u32x2*)orow + lane;
#pragma unroll
    for (int j = 0; j < 4; ++j) {
        const f32x4 gg = ((const GAS f32x4*)g)[lane + 64 * j], ss = ((const GAS f32x4*)sc)[lane + 64 * j], hh = ((const GAS f32x4*)sh)[lane + 64 * j];
        const f32x4 o = v[j] * rstd * gg * (ss + 1.f) + hh;
        u32x2 w; w.x = pk2(o.x, o.y); w.y = pk2(o.z, o.w); o8[64 * j] = w;
    }
}
constexpr int I_FOLD1 = 16 * 9 + 16 * 12, I_FOLD = 8 * I_FOLD1;
__device__ __forceinline__ float sum8(float v) { v += dppf(v, 0); v += dppf(v, 1); return v + dppf(v, 2); }
__device__ __forceinline__ void fold_item(const Ctx& F, int idx, LAS float* scr) {
    const int lane = F.lane, b = idx / I_FOLD1; int r = idx % I_FOLD1;
    const float* MOD = (const float*)(F.ws + WS_MOD) + b * MODW;
    int w, kb, db, ldw; const float *W, *sg, *ssc, *ssh;
    if (r < 144) { w = 0; kb = r / 9; db = r % 9; W = F.in[14]; ldw = 288; sg = F.in[13]; ssc = MOD + 12288 + 1024; ssh = MOD + 12288; }
    else { r -= 144; w = 1; kb = r / 12; db = r % 12; W = F.in[19]; ldw = 384; sg = F.in[5] + 1024; ssc = MOD + 6144 + 1024; ssh = MOD + 6144; }
    const int k0 = kb * 64, c = lane & 7;
    f32x4 v[8];
#pragma unroll
    for (int i = 0; i < 8; ++i) v[i] = *(const GAS f32x4*)(W + (size_t)(k0 + 8 * i + (lane >> 3)) * ldw + db * 32 + 4 * c);
    float A[8], H[8];
    { const f32x4 g0 = *(const GAS f32x4*)(sg + k0 + 8 * c), g1 = *(const GAS f32x4*)(sg + k0 + 8 * c + 4), s0 = *(const GAS f32x4*)(ssc + k0 + 8 * c), s1 = *(const GAS f32x4*)(ssc + k0 + 8 * c + 4);
      const f32x4 h0 = *(const GAS f32x4*)(ssh + k0 + 8 * c), h1 = *(const GAS f32x4*)(ssh + k0 + 8 * c + 4);
      const f32x4 a0 = g0 * (s0 + 1.f), a1 = g1 * (s1 + 1.f);
      A[0] = a0.x; A[1] = a0.y; A[2] = a0.z; A[3] = a0.w; A[4] = a1.x; A[5] = a1.y; A[6] = a1.z; A[7] = a1.w;
      H[0] = h0.x; H[1] = h0.y; H[2] = h0.z; H[3] = h0.w; H[4] = h1.x; H[5] = h1.y; H[6] = h1.z; H[7] = h1.w; }
#pragma unroll
    for (int i = 0; i < 8; ++i) { LAS float* d = scr + (8 * i + (lane >> 3)) * 33 + 4 * c; d[0] = v[i].x; d[1] = v[i].y; d[2] = v[i].z; d[3] = v[i].w; }
    asm volatile("s_waitcnt lgkmcnt(0)" ::: "memory");
    bf16_t* WT = (bf16_t*)(F.ws + WS_W8) + (size_t)(w * 8 + b) * 512 * 1024;
    float* PB = (float*)(F.ws + WS_PB) + ((size_t)((b * 2 + w) * 16 + kb)) * 512 + db * 32;
#pragma unroll
    for (int j = 0; j < 4; ++j) { const int n = (lane >> 3) + 8 * j; const LAS float* sp = scr + (8 * c) * 33 + n;
        float f[8];
#pragma unroll
        for (int q = 0; q < 8; ++q) f[q] = sp[q * 33];
        float pb = 0.f;
#pragma unroll
        for (int q = 0; q < 8; ++q) { pb += f[q] * H[q]; f[q] *= A[q]; }
        u32x4 o; o.x = pk2(f[0], f[1]); o.y = pk2(f[2], f[3]); o.z = pk2(f[4], f[5]); o.w = pk2(f[6], f[7]);
        *(GAS u32x4*)(WT + (size_t)(db * 32 + n) * 1024 + k0 + 8 * c) = o;
        pb = sum8(pb);
        if (c == 0) PB[n] = pb;
    }
    asm volatile("s_waitcnt lgkmcnt(0)" ::: "memory");
}

__device__ __forceinline__ void phase_norm1(const Ctx& F0) {
    const Ctx F = phase_ctx(F0);
    const int gw = F.vcu * NWAVES + F.wave, NGW = F.G * NWAVES, lane = F.lane;
    const float* MOD = (const float*)(F.ws + WS_MOD);
    bf16_t* XN = (bf16_t*)(F.ws + WS_XN);
    const float* x = F.in[0]; const float* g = F.in[5];
    for (int idx = gw; idx < I_FOLD; idx += NGW) fold_item(F, idx, (LAS float*)(F.lds + F.wave * 8448));
    for (int base = gw * 8; base < NT; base += NGW * 8) {
        const int b = base / SEQ;
        const float* sc = MOD + b * MODW + 1024; const float* sh = MOD + b * MODW;
        f32x4 Aw[4], Bw[4];
#pragma unroll
        for (int q = 0; q < 4; ++q) { const int c0 = 16 * lane + 4 * q;
            const f32x4 gg = *(const GAS f32x4*)(g + c0), ss = *(const GAS f32x4*)(sc + c0);
            Aw[q] = gg * (ss + 1.f); Bw[q] = *(const GAS f32x4*)(sh + c0); }
        f32x4 v[4];
#pragma unroll
        for (int q = 0; q < 4; ++q) v[q] = *(const GAS f32x4*)(x + (size_t)base * 1024 + 16 * lane + 4 * q);
#pragma unroll 1
        for (int ti = 0; ti < 8; ++ti) {
            const int m = base + ti, mn = ti < 7 ? m + 1 : m;
            f32x4 vn[4];
#pragma unroll
            for (int q = 0; q < 4; ++q) vn[q] = *(const GAS f32x4*)(x + (size_t)mn * 1024 + 16 * lane + 4 * q);
            float s2 = 0.f;
#pragma unroll
            for (int q = 0; q < 4; ++q) s2 += (v[q].x * v[q].x + v[q].y * v[q].y) + (v[q].z * v[q].z + v[q].w * v[q].w);
            const float rstd = rsqrtf(wave_sum(s2) * (1.f / 1024.f) + EPS);
            unsigned wq[8];
#pragma unroll
            for (int q = 0; q < 4; ++q) { const f32x4 o = v[q] * rstd * Aw[q] + Bw[q]; wq[2 * q] = pk2(o.x, o.y); wq[2 * q + 1] = pk2(o.z, o.w); }
            u32x4 w0, w1; w0.x = wq[0]; w0.y = wq[1]; w0.z = wq[2]; w0.w = wq[3]; w1.x = wq[4]; w1.y = wq[5]; w1.z = wq[6]; w1.w = wq[7];
            bf16_t* o = XN + (size_t)m * 1024 + 16 * lane;
            *(GAS u32x4*)(o) = w0; *(GAS u32x4*)(o + 8) = w1;
#pragma unroll
            for (int q = 0; q < 4; ++q) v[q] = vn[q];
        }
    }
}


__device__ __forceinline__ void load_tables(const Ctx& F0, int l) {
    const Ctx F = phase_ctx(F0);
    LAS int* tab = (LAS int*)(F.lds + LDSCTL_OFF);
    const int* ctl = (const int*)(F.ws + WS_CTL);
    __syncthreads();
    if (F.wave == 0) {
        const int c = ctl[CW_ECNTF + 128 * l + F.lane];
        const int pc = ((c + 255) >> 8) << 8;
        tab[256 + F.lane] = pc; tab[128 + F.lane] = c;
        asm volatile("s_waitcnt lgkmcnt(0)" ::: "memory");
        int x = 0;
        for (int j = 0; j < 64; ++j) { const int y = tab[256 + j]; if (j < F.lane) x += y; }
        tab[F.lane] = x; if (F.lane == 63) tab[64] = x + pc;
    }
    __syncthreads();
}

__device__ __forceinline__ void phase_route(const Ctx& F0, int l, const bf16_t* X) {
    const Ctx F = phase_ctx(F0);
    const float* MOD = (const float*)(F.ws + WS_MOD);
    const float* g = F.in[6] + l * 1024; const float* rb = F.in[25] + l * 64;
    bf16_t* XN = (bf16_t*)(F.ws + WS_XN);
    const bf16_t* Whi = (const bf16_t*)(F.ws + WS_WR) + (size_t)(l * 2) * 64 * 1024; const bf16_t* Wlo = Whi + 64 * 1024;
    int* TOPI = (int*)(F.ws + WS_TOPI); float* TOPW = (float*)(F.ws + WS_TOPW); int* LP = (int*)(F.ws + WS_PPOS); int* LT2 = (int*)(F.ws + WS_LT2);
    unsigned* ecnt = (unsigned*)(F.ws + WS_CTL) + CW_ECNTF + 128 * l;
    LAS float* part = (LAS float*)(F.lds);
    LAS int* hist = (LAS int*)(F.lds + 65536); LAS int* gbase = (LAS int*)(F.lds + 65536 + 256);
    const int lane = F.lane;
    for (int bt = F.vcu; bt < NT / 64; bt += F.G) {
        if (F.tid < 64) hist[F.tid] = 0;
        const int tokb = bt * 64, tok0 = tokb + F.wave * 8, b = tok0 / SEQ;
        const float* sc = MOD + b * MODW + l * 6144 + 4096; const float* sh = MOD + b * MODW + l * 6144 + 3072;
        {
            f32x4 Aw[4], Bw[4];
#pragma unroll
            for (int q = 0; q < 4; ++q) { const int c0 = 16 * lane + 4 * q;
                const f32x4 gg = *(const GAS f32x4*)(g + c0), ss = *(const GAS f32x4*)(sc + c0);
                Aw[q] = gg * (ss + 1.f); Bw[q] = *(const GAS f32x4*)(sh + c0); }
            u32x4 xa = *(const GAS u32x4*)(X + (size_t)tok0 * 1024 + 16 * lane), xb = *(const GAS u32x4*)(X + (size_t)tok0 * 1024 + 16 * lane + 8);
#pragma unroll 1
            for (int ti = 0; ti < 8; ++ti) {
                const int tok = tok0 + ti, tokn = ti < 7 ? tok + 1 : tok;
                const u32x4 xan = *(const GAS u32x4*)(X + (size_t)tokn * 1024 + 16 * lane), xbn = *(const GAS u32x4*)(X + (size_t)tokn * 1024 + 16 * lane + 8);
                const unsigned xw[8] = {xa.x, xa.y, xa.z, xa.w, xb.x, xb.y, xb.z, xb.w};
                f32x4 v[4]; float s2 = 0.f;
#pragma unroll
                for (int q = 0; q < 4; ++q) { v[q] = (f32x4){__uint_as_float(xw[2 * q] << 16), __uint_as_float(xw[2 * q] & 0xffff0000u), __uint_as_float(xw[2 * q + 1] << 16), __uint_as_float(xw[2 * q + 1] & 0xffff0000u)};
                    s2 += (v[q].x * v[q].x + v[q].y * v[q].y) + (v[q].z * v[q].z + v[q].w * v[q].w); }
                const float rstd = rsqrtf(wave_sum(s2) * (1.f / 1024.f) + EPS);
                unsigned wq[8];
#pragma unroll
                for (int q = 0; q < 4; ++q) { const f32x4 o = v[q] * rstd * Aw[q] + Bw[q]; wq[2 * q] = pk2(o.x, o.y); wq[2 * q + 1] = pk2(o.z, o.w); }
                u32x4 w0, w1; w0.x = wq[0]; w0.y = wq[1]; w0.z = wq[2]; w0.w = wq[3]; w1.x = wq[4]; w1.y = wq[5]; w1.z = wq[6]; w1.w = wq[7];
                bf16_t* o = XN + (size_t)tok * 1024 + 16 * lane;
                *(GAS u32x4*)(o) = w0; *(GAS u32x4*)(o + 8) = w1;
                xa = xan; xb = xbn;
            }
        }
        asm volatile("s_waitcnt vmcnt(0)" ::: "memory");
        __syncthreads();
        {
            const int ksl = F.wave & 3, th = F.wave >> 2;
            f32x4 acc[2][4];
#pragma unroll
            for (int tt = 0; tt < 2; ++tt)
#pragma unroll
                for (int et = 0; et < 4; ++et) acc[tt][et] = (f32x4){0.f, 0.f, 0.f, 0.f};
            const size_t aoffs = (size_t)(tokb + th * 32 + (lane & 15)) * 1024 + ksl * 256 + 8 * (lane >> 4);
            const size_t boffs = (size_t)(lane & 15) * 1024 + ksl * 256 + 8 * (lane >> 4);
#pragma unroll 2
            for (int ks = 0; ks < 8; ++ks) {
                bf16x8 ah[2];
#pragma unroll
                for (int tt = 0; tt < 2; ++tt) ah[tt] = *(const GAS bf16x8*)(XN + aoffs + (size_t)tt * 16 * 1024 + ks * 32);
#pragma unroll
                for (int et = 0; et < 4; ++et) {
                    const bf16x8 bh = *(const GAS bf16x8*)(Whi + boffs + (size_t)et * 16 * 1024 + ks * 32), bl = *(const GAS bf16x8*)(Wlo + boffs + (size_t)et * 16 * 1024 + ks * 32);
#pragma unroll
                    for (int tt = 0; tt < 2; ++tt) {
                        acc[tt][et] = __builtin_amdgcn_mfma_f32_16x16x32_bf16(ah[tt], bh, acc[tt][et], 0, 0, 0);
                        acc[tt][et] = __builtin_amdgcn_mfma_f32_16x16x32_bf16(ah[tt], bl, acc[tt][et], 0, 0, 0);
                    }
                }
            }
#pragma unroll
            for (int tt = 0; tt < 2; ++tt)
#pragma unroll
                for (int et = 0; et < 4; ++et)
#pragma unroll
                    for (int r = 0; r < 4; ++r) part[(ksl * 64 + th * 32 + tt * 16 + (lane >> 4) * 4 + r) * 64 + et * 16 + (lane & 15)] = acc[tt][et][r];
        }
        __syncthreads();
        const float bias = rb[lane];
        LAS unsigned* pk = (LAS unsigned*)(F.lds + 69632 + F.wave * 4096);
        LAS float* wf = (LAS float*)(F.lds + 69632 + F.wave * 4096 + 2048);
        int running = 0;
#pragma unroll 1
        for (int ti = 0; ti < 8; ++ti) {
            const int tl = F.wave * 8 + ti;
            const float logit = ((part[(0 * 64 + tl) * 64 + lane] + part[(1 * 64 + tl) * 64 + lane]) + part[(2 * 64 + tl) * 64 + lane]) + part[(3 * 64 + tl) * 64 + lane];
            const float score = 1.f / (1.f + expf(-logit));
            bool sel; int jr; float w;
            nv::route_lane(score, bias, lane, sel, jr, w);
            pk[ti * 64 + lane] = sel ? (0x80000000u | ((unsigned)jr << 16) | (unsigned)running) : 0u; wf[ti * 64 + lane] = w;
            running += sel ? 1 : 0;
        }
        const int wbase = __hip_atomic_fetch_add(hist + lane, running, __ATOMIC_RELAXED, __HIP_MEMORY_SCOPE_WORKGROUP);
        __syncthreads();
        if (F.wave == 0) { const int h = hist[lane]; gbase[lane] = (int)__hip_atomic_fetch_add(ecnt + lane, (unsigned)h, __ATOMIC_RELAXED, __HIP_MEMORY_SCOPE_AGENT); }
        __syncthreads();
        const int gb = gbase[lane] + wbase;
#pragma unroll 1
        for (int ti = 0; ti < 8; ++ti) {
            const unsigned v = pk[ti * 64 + lane];
            if (v & 0x80000000u) {
                const int tok = tok0 + ti, jr = (int)((v >> 16) & 0xffu), lp = gb + (int)(v & 0xffffu);
                TOPI[tok * 6 + jr] = lane; TOPW[tok * 6 + jr] = wf[ti * 64 + lane]; LP[tok * 6 + jr] = lp; LT2[lane * 16384 + lp] = tok;
            }
        }
        __syncthreads();
    }
}

template <bool LAST>
__device__ __forceinline__ void phase_combine(const Ctx& F0, int l, const bf16_t* Xin, void* Xout) {
    const Ctx F = phase_ctx(F0);
    load_tables(F, l);
    const LAS int* tab = (const LAS int*)(F.lds + LDSCTL_OFF);
    const float* MOD = (const float*)(F.ws + WS_MOD);
    const unsigned char* YB = (const unsigned char*)(F.ws + WS_YB);
    const int* TOPI = (const int*)(F.ws + WS_TOPI); const float* TOPW = (const float*)(F.ws + WS_TOPW); const int* LP = (const int*)(F.ws + WS_PPOS);
    float* RSTD = (float*)(F.ws + WS_RSTD); float* ROPE = (float*)(F.ws + WS_ROPE); const int* posp = (const int*)F.in[2];
    const int gw = F.vcu * NWAVES + F.wave, NGW = F.G * NWAVES, lane = F.lane;
    const float inv = powf(10000.f, -(float)(lane & 15) / 16.f);
    if (!LAST && F.wave == 0) {
        const float* PB = (const float*)(F.ws + WS_PB); float* CB = (float*)(F.ws + WS_CB);
        for (int t = F.vcu; t < 128; t += F.G) { const int o = t * 64 + lane, n = o & 511, w = (o >> 9) & 1;
            float sacc = 0.f;
            if (n < (w ? 384 : 288)) {
#pragma unroll
                for (int kb = 0; kb < 16; ++kb) sacc += PB[((size_t)(o >> 9) * 16 + kb) * 512 + n]; }
            CB[o] = sacc; }
    }
    for (int base = gw * 8; base < NT; base += NGW * 8) {
        const int b = base / SEQ;
        f32x4 gate[4];
#pragma unroll
        for (int q = 0; q < 4; ++q) gate[q] = *(const GAS f32x4*)(MOD + b * MODW + l * 6144 + 5120 + 16 * lane + 4 * q);
        u32x4 y[7], xa, xb; float w[7];
#define CMB_LOAD(TOK, Y, W, XA, XB) do { const int tk_ = (TOK); _Pragma("unroll") for (int j = 0; j < 7; ++j) { int p; \
            if (j < 6) { const int e = TOPI[tk_ * 6 + j]; p = tab[e] + LP[tk_ * 6 + j]; W[j] = TOPW[tk_ * 6 + j] * (1.f / pg8::YB_SCALE); } else { p = PMAX + tk_; W[j] = 1.f / pg8::YB_SCALE; } \
            Y[j] = __builtin_nontemporal_load((const GAS u32x4*)(YB + (size_t)p * 1024 + 16 * lane)); }     \
            { const size_t off_ = (size_t)tk_ * 1024 + 16 * lane; XA = *(const GAS u32x4*)(Xin + off_); XB = *(const GAS u32x4*)(Xin + off_ + 8); } } while (0)
        CMB_LOAD(base, y, w, xa, xb);
#pragma unroll 1
        for (int ti = 0; ti < 8; ++ti) {
            const int tok = base + ti;
            u32x4 yn[7], xan, xbn; float wn[7];
            CMB_LOAD(ti < 7 ? tok + 1 : tok, yn, wn, xan, xbn);
            f32x4 a[4];
#pragma unroll
            for (int q = 0; q < 4; ++q) a[q] = (f32x4){0.f, 0.f, 0.f, 0.f};
#pragma unroll
            for (int j = 0; j < 7; ++j) {
                const unsigned yw[4] = {y[j].x, y[j].y, y[j].z, y[j].w};
#pragma unroll
                for (int q = 0; q < 4; ++q) { const f32x2 lo = __builtin_amdgcn_cvt_pk_f32_fp8((int)yw[q], false), hi = __builtin_amdgcn_cvt_pk_f32_fp8((int)yw[q], true);
                    a[q][0] += w[j] * lo.x; a[q][1] += w[j] * lo.y; a[q][2] += w[j] * hi.x; a[q][3] += w[j] * hi.y; }
            }
            float s2 = 0.f;
            { const size_t off = (size_t)tok * 1024 + 16 * lane;
              const unsigned xw[8] = {xa.x, xa.y, xa.z, xa.w, xb.x, xb.y, xb.z, xb.w};
#pragma unroll
              for (int q = 0; q < 4; ++q) {
                  const f32x4 xi = (f32x4){__uint_as_float(xw[2 * q] << 16), __uint_as_float(xw[2 * q] & 0xffff0000u), __uint_as_float(xw[2 * q + 1] << 16), __uint_as_float(xw[2 * q + 1] & 0xffff0000u)};
                  const f32x4 xo = xi + gate[q] * a[q];
                  a[q] = xo;
                  if (LAST) *(GAS f32x4*)((float*)Xout + off + 4 * q) = xo;
                  s2 += (xo.x * xo.x + xo.y * xo.y) + (xo.z * xo.z + xo.w * xo.w);
              }
              if (!LAST) { u32x4 w0, w1; w0.x = pk2(a[0].x, a[0].y); w0.y = pk2(a[0].z, a[0].w); w0.z = pk2(a[1].x, a[1].y); w0.w = pk2(a[1].z, a[1].w);
                  w1.x = pk2(a[2].x, a[2].y); w1.y = pk2(a[2].z, a[2].w); w1.z = pk2(a[3].x, a[3].y); w1.w = pk2(a[3].z, a[3].w);
                  *(GAS u32x4*)((bf16_t*)Xout + off) = w0; *(GAS u32x4*)((bf16_t*)Xout + off + 8) = w1; }
            }
            if (!LAST) {
                const float rstd = rsqrtf(wave_sum(s2) * (1.f / 1024.f) + EPS);
                if (lane == 0) RSTD[tok] = rstd;
                if (lane < 16) { const float ang = (float)posp[tok] * inv; ROPE[(size_t)tok * 16 + lane] = cosf(ang); ROPE[(size_t)NT * 16 + (size_t)tok * 16 + lane] = sinf(ang); }
            }
#pragma unroll
            for (int j = 0; j < 7; ++j) { y[j] = yn[j]; w[j] = wn[j]; }
            xa = xan; xb = xbn;
        }
#undef CMB_LOAD
    }
}

__global__ void __launch_bounds__(NTHREADS, 2) fwd(Args args) {
    extern __shared__ __attribute__((aligned(16))) unsigned char lds_raw[];
    Ctx F;
    F.lds = (LAS unsigned char*)lds_raw;
    F.tid = threadIdx.x; F.lane = F.tid & 63; F.wave = __builtin_amdgcn_readfirstlane(F.tid >> 6);
    F.G = gridDim.x; { const int bx = blockIdx.x; F.vcu = (F.G % 8 == 0) ? (bx % 8) * (F.G / 8) + bx / 8 : bx; }
    F.ws = args.ws; F.in = args.in; F.out = args.out;
    volatile LAS unsigned* MISC = (volatile LAS unsigned*)(F.lds + MISC_OFF);
    for (int u = F.tid; u < (LDS_BYTES - LDSCTL_OFF) / 4; u += NTHREADS) ((LAS unsigned*)(F.lds + LDSCTL_OFF))[u] = 0u;
    __syncthreads();
    const int lo = args.ph_lo, hi = args.ph_hi;
    const bool single = (hi - lo) > 1;
    unsigned* barw = (unsigned*)(F.ws + WS_CTL) + CW_BAR;
    XcdBarrier bar; bar.bar = barw; bar.x = 0; bar.st = nullptr;
    if (single) bar = xcd_barrier_post(barw, MISC + 8);
#define IN(k) (lo <= (k) && (k) < hi)
#define SEAM(k) do { if (IN(k) && IN((k) + 1)) xcd_barrier(bar); } while (0)
#ifndef MK_REPMASK
#define MK_REPMASK 0u
#endif
#define REPS(k) ((((unsigned)(MK_REPMASK) >> (k)) & 1u) ? 2 : 1)
#define RUN(k) for (int rep_ = (IN(k) ? REPS(k) : 0); rep_ > 0; (--rep_ > 0 ? xcd_barrier(bar) : (void)0))
#define PH const Ctx P = phase_ctx(F); const char* wsc = (const char*)P.ws; bf16_t* X1 = (bf16_t*)(P.ws + WS_X1); bf16_t* X2 = (bf16_t*)(P.ws + WS_X2); bf16_t* X3 = X1; (void)wsc; (void)X1; (void)X2; (void)X3

#ifdef MK_XBAR
    if (single) for (int xb_ = 0; xb_ < MK_XBAR; ++xb_) xcd_barrier(bar);
#endif
    RUN(0) { phase_prologue(F); } SEAM(0);
    RUN(1) { phase_norm1(F); } SEAM(1);
    RUN(2) { PH;
        pg8::DenseSched S; S.init(3072, 1024, F.G, (int)blockIdx.x, (unsigned)WS_XN, P.ws + WS_WQKV);
        pg8::EpiQKV E{(bf16_t*)(P.ws + WS_QB), P.in[8], P.in[9]};
        pg8::gemm_phase<pg8::EpiQKV, pg8::DenseSched, true>(F.lds, wsc, 1024, S, E);
    } SEAM(2);
    if (IN(3) || IN(4)) {
        PH;
        int tid3 = threadIdx.x; asm volatile("" : "+v"(tid3));
        const int half = __builtin_amdgcn_readfirstlane(tid3 >> 8), hw = __builtin_amdgcn_readfirstlane((tid3 >> 6) & 3), lane3 = tid3 & 63;
        LAS unsigned char* hl = F.lds + half * 65536; LAS float* xs = (LAS float*)(F.lds + XS_OFF + half * 2048);
        const bf16_t* QB = (const bf16_t*)(P.ws + WS_QB); const bf16_t* KB = (const bf16_t*)(P.ws + WS_KB); const bf16_t* VB = (const bf16_t*)(P.ws + WS_VB);
        bf16_t* PART = (bf16_t*)(P.ws + WS_PART); float* LSE = (float*)(P.ws + WS_LSE); const int* pos = (const int*)P.in[2];
#define DIL_RUN(MERGEV, FIRST, LAST, DECODE, PARTG, LSEG, P0V, P1V, L0V, L1V, OBV, BGH) do { \
            constexpr bool PF_ = !(MERGEV);                          \
            at::DilStage st; at::DilU u; int pair = (FIRST); \
            _Pragma("unroll") for (int z_ = 0; z_ < 8; ++z_) { st.kk[z_] = (u32x4){0u, 0u, 0u, 0u}; st.vv[z_] = (u32x4){0u, 0u, 0u, 0u}; } st.pk = 0; \
            if (PF_ && pair < (LAST)) { DECODE(pair, u); at::dil_load_k(st, u, hw, lane3, KB, pos); at::dil_load_v(st, u, hw, lane3, VB); } \
            _Pragma("unroll 1") for (; pair < (LAST); ++pair) { \
                int ln_ = lane3; asm volatile("" : "+v"(ln_));     \
                if (!PF_) { DECODE(pair, u); if (!(ABL3 & 2)) { at::dil_load_k(st, u, hw, ln_, KB, pos); at::dil_load_v(st, u, hw, ln_, VB); } } \
                at::dil_write(st, u, hl, xs, hw, ln_); \
                const int tokq_ = (128 * u.n + 32 * hw + (ln_ & 31)) * u.dil + u.r; \
                bf16x8 qr_[4]; \
                _Pragma("unroll") for (int d0 = 0; d0 < 4; ++d0) qr_[d0] = *(const GAS bf16x8*)(QB + (size_t)(u.b * SEQ + tokq_) * 1024 + u.h * 64 + 16 * d0 + 8 * (ln_ >> 5)); \
                const float posq_ = (float)pos[u.b * SEQ + tokq_]; \
                __syncthreads(); \
                asm volatile("" :: "v"(qr_[0]), "v"(qr_[1]), "v"(qr_[2]), "v"(qr_[3]), "v"(posq_));     \
                BGH; \
                const at::DilU uc = u; \
                const bool more_ = PF_ && (pair + 1 < (LAST)) && !(ABL3 & 2); \
                if (more_) { DECODE(pair + 1, u); at::dil_load_k(st, u, hw, ln_, KB, pos); }     \
                at::dil_compute<MERGEV, false>(hl, xs, hw, 0, ln_, uc, qr_, posq_, PARTG(uc), LSEG(uc), P0V, P1V, L0V, L1V, OBV, ABL3); \
                if (more_) at::dil_load_v(st, u, hw, ln_, VB);                                    \
                BGH; \
                __syncthreads(); \
            } } while (0)
#define DEC3(pr, uu) do { const int u_ = (pr) * 2 + half, bh_ = u_ >> 5, rem_ = u_ & 31, g_ = rem_ >> 4, idx_ = rem_ & 15; \
            (uu).b = bh_ >> 4; (uu).h = bh_ & 15; (uu).dil = g_ ? 4 : 1; (uu).r = g_ ? (idx_ >> 2) : 0; (uu).n = g_ ? (idx_ & 3) : idx_; } while (0)
#define DEC4(pr, uu) do { const int u_ = (pr) * 2 + half, bh_ = u_ >> 4; (uu).b = bh_ >> 4; (uu).h = bh_ & 15; (uu).dil = 16; (uu).r = u_ & 15; (uu).n = 0; } while (0)
#define PART3(uu) (PART + (size_t)((uu).dil == 4 ? 1 : 0) * NT * 1024)
#define LSE3(uu) (LSE + (size_t)((uu).dil == 4 ? 1 : 0) * NT * 16)
#define NULLP(uu) nullptr
#ifndef MK_ABL3
#define MK_ABL3 0
#endif
        RUN(3) {
            const int ABL3 = (rep_ == 2) ? MK_ABL3 : 0;
            const int per3 = (2048 + F.G - 1) / F.G, first3 = F.vcu * per3, last3 = min((F.vcu + 1) * per3, 2048);
            const int wv3 = half * 4 + hw;
            LAS float* xsr = (LAS float*)(F.lds + XS_OFF);
#define DEC3H(pr, hh, uu) do { const int u_ = (pr) * 2 + (hh), bh_ = u_ >> 5, rem_ = u_ & 31, g_ = rem_ >> 4, idx_ = rem_ & 15; \
            (uu).b = bh_ >> 4; (uu).h = bh_ & 15; (uu).dil = g_ ? 4 : 1; (uu).r = g_ ? (idx_ >> 2) : 0; (uu).n = g_ ? (idx_ & 3) : idx_; } while (0)
            at::RingStage st; at::DilU u0; int pair = first3;
            if (pair < last3) { DEC3H(pair, 0, u0); at::ring_load(st, u0, wv3, lane3, KB, VB, pos); }
#pragma unroll 1
            for (; pair < last3; ++pair) {
                int ln_ = lane3; asm volatile("" : "+v"(ln_));
                at::DilU u; DEC3H(pair, half, u); DEC3H(pair, 0, u0);
                at::ring_write(st, u0, F.lds, xsr, wv3, ln_);
                const int tokq_ = (128 * u.n + 32 * hw + (ln_ & 31)) * u.dil + u.r;
                bf16x8 qr_[4];
#pragma unroll
                for (int d0 = 0; d0 < 4; ++d0) qr_[d0] = *(const GAS bf16x8*)(QB + (size_t)(u.b * SEQ + tokq_) * 1024 + u.h * 64 + 16 * d0 + 8 * (ln_ >> 5));
                const float posq_ = (float)pos[u.b * SEQ + tokq_];
                __syncthreads();
                asm volatile("" :: "v"(qr_[0]), "v"(qr_[1]), "v"(qr_[2]), "v"(qr_[3]), "v"(posq_));
                if (pair + 1 < last3 && !(ABL3 & 2)) { at::DilU un; DEC3H(pair + 1, 0, un); at::ring_load(st, un, wv3, ln_, KB, VB, pos); }
                at::dil_compute<false, true>(F.lds, xsr, hw, wv3, ln_, u, qr_, posq_, PART3(u), LSE3(u), nullptr, nullptr, nullptr, nullptr, nullptr, ABL3);
                __syncthreads();
            }
#undef DEC3H
        }
        SEAM(3);
        RUN(4) {
            const int ABL3 = 0;
            const int per4 = (1024 + F.G - 1) / F.G;
            const bool bgw = hw < 2;
            BgConv bg; bg.init(P, 0, F.vcu * 4 + half * 2 + hw, I_DNL, F.G * 4, (LAS float*)(hl + (hw ? 32768 : 0))); bg.base = I_GUL;
            DIL_RUN(true, F.vcu * per4, min((F.vcu + 1) * per4, 1024), DEC4, NULLP, NULLP, PART, PART + (size_t)NT * 1024, LSE, LSE + (size_t)NT * 16, (bf16_t*)(P.ws + WS_OB), if (bgw) bg.step());
            if (bgw) bg.drain();
        }
#undef DIL_RUN
#undef DEC3
#undef DEC4
#undef PART3
#undef LSE3
#undef NULLP
    }
    SEAM(4);
    RUN(5) { PH;
        pg8::DenseSched S; S.init(1024, 1024, F.G, (int)blockIdx.x, (unsigned)WS_OB, P.ws + WS_WO0);
        pg8::EpiResid<false> E{P.in[0], (const float*)(P.ws + WS_MOD), 2048, X1};
        pg8::gemm_phase<pg8::EpiResid<false>, pg8::DenseSched, true>(F.lds, wsc, 1024, S, E);
    } SEAM(5);
    RUN(6) { PH; phase_route(F, 0, X1); } SEAM(6);
    RUN(7) { PH;
        load_tables(F, 0);
        pg8::MoeSched<2, true> S{(const LAS int*)(F.lds + LDSCTL_OFF), (const int*)(P.ws + WS_LT2), F.G, F.vcu, 1024, (unsigned)WS_XN, wsc + WS_WGU + (size_t)0 * 65 * 512 * 1024 * 2};
        pg8::EpiSwiglu E{(bf16_t*)(P.ws + WS_ACT), (const LAS int*)(F.lds + LDSCTL_OFF)};
#ifdef MK_ABL7
        const int ABL7 = (rep_ == 2) ? MK_ABL7 : 0;
#else
        const int ABL7 = 0;
#endif
        pg8::gemm_phase<pg8::EpiSwiglu, pg8::MoeSched<2, true>, true>(F.lds, wsc, 1024, S, E, ABL7);
    } SEAM(7);
    RUN(8) { PH;
        load_tables(F, 0);
        pg8::MoeSched<4, false> S{(const LAS int*)(F.lds + LDSCTL_OFF), (const int*)(P.ws + WS_LT2), F.G, F.vcu, 256, (unsigned)WS_ACT, wsc + WS_WDN + (size_t)0 * 65 * 1024 * 256 * 2};
        pg8::EpiYB E{(unsigned char*)(P.ws + WS_YB), (const LAS int*)(F.lds + LDSCTL_OFF)};
#ifdef MK_ABL8
        const int ABL8 = (rep_ == 2) ? MK_ABL8 : 0;
#else
        const int ABL8 = 0;
#endif
        pg8::gemm_phase<pg8::EpiYB, pg8::MoeSched<4, false>, true>(F.lds, wsc, 256, S, E, ABL8);
    } SEAM(8);
    RUN(9) { PH; phase_combine<false>(F, 0, X1, X2); } SEAM(9);
        RUN(10) { PH;
            pg8::DualSched S; S.G = F.G; S.c = (int)blockIdx.x; S.a0 = (unsigned)WS_X2; S.Bt = wsc + WS_W8;
            pg8::EpiDown E{(bf16_t*)(P.ws + WS_DKV), (const float*)(P.ws + WS_RSTD), (const float*)(P.ws + WS_CB), (float*)(P.ws + WS_SSQ), (float*)(P.ws + WS_KPSS), (float*)(P.ws + WS_KPR), (const float*)(P.ws + WS_ROPE), P.in[18]};
            pg8::gemm_phase<pg8::EpiDown, pg8::DualSched, true>(F.lds, wsc, 1024, S, E);
        } SEAM(10);
        RUN(12) { PH;
            { pg8::DenseSched S; S.init(2048, 256, F.G, (int)blockIdx.x, (unsigned)WS_DKV, P.ws + WS_WUKV, 512);
              pg8::EpiKV E{(bf16_t*)(P.ws + WS_KM), (bf16_t*)(P.ws + WS_VM), (const float*)(P.ws + WS_KPSS), (const float*)(P.ws + WS_KPR), P.in[18], (const float*)(P.ws + WS_SSQ)};
              pg8::gemm_phase<pg8::EpiKV, pg8::DenseSched, true>(F.lds, wsc, 256, S, E, 0, 512); }
            { pg8::DenseSched S; S.init(1536, 384, F.G, (int)blockIdx.x, (unsigned)WS_DQ, P.ws + WS_WUQ, 512);
              pg8::EpiQ E{(bf16_t*)(P.ws + WS_QR), (const float*)(P.ws + WS_SSQ)};
              pg8::gemm_phase<pg8::EpiQ, pg8::DenseSched, true>(F.lds, wsc, 384, S, E, 0, 512); }
        } SEAM(12);
        RUN(13) { PH;
#ifdef MK_ABL13
            const int ABL13 = (rep_ == 2) ? MK_ABL13 : 0;
#else
            const int ABL13 = 0;
#endif
            BgConv bg; bg.init(P, 1, F.vcu * NWAVES + F.wave, I_MOEL, F.G * NWAVES, (LAS float*)(F.lds + 49152 + F.wave * 8448));
            for (int v = F.vcu; v < 256; v += F.G) {
                const int bh = v >> 1, odd = v & 1;
#pragma unroll 1
                for (int i = 0; i < 4; ++i) {
                    const int qb = odd ? (i == 0 ? 1 : i == 1 ? 6 : i == 2 ? 2 : 5) : (i == 0 ? 0 : i == 1 ? 7 : i == 2 ? 3 : 4);
                    at::mla_unit(F.lds, bh >> 4, bh & 15, qb, (const bf16_t*)(P.ws + WS_QR), (const bf16_t*)(P.ws + WS_KM), (const bf16_t*)(P.ws + WS_VM), (const float*)(P.ws + WS_ROPE), P.in[22], (bf16_t*)(P.ws + WS_OB), bg, ABL13);
                }
            }
            if (!(ABL13 & 4)) bg.drain();
        } SEAM(13);
        RUN(14) { PH;
            pg8::DenseSched S; S.init(1024, 1024, F.G, (int)blockIdx.x, (unsigned)WS_OB, P.ws + WS_WO1);
            pg8::EpiResid<true> E{X2, (const float*)(P.ws + WS_MOD), 6144 + 2048, X3};
            pg8::gemm_phase<pg8::EpiResid<true>, pg8::DenseSched, true>(F.lds, wsc, 1024, S, E);
        } SEAM(14);

    RUN(15) { PH; phase_route(F, 1, X3); } SEAM(15);
    RUN(16) { PH;
        load_tables(F, 1);
        pg8::MoeSched<2, true> S{(const LAS int*)(F.lds + LDSCTL_OFF), (const int*)(P.ws + WS_LT2), F.G, F.vcu, 1024, (unsigned)WS_XN, wsc + WS_WGU + (size_t)1 * 65 * 512 * 1024 * 2};
        pg8::EpiSwiglu E{(bf16_t*)(P.ws + WS_ACT), (const LAS int*)(F.lds + LDSCTL_OFF)};
        pg8::gemm_phase<pg8::EpiSwiglu, pg8::MoeSched<2, true>, true>(F.lds, wsc, 1024, S, E);
    } SEAM(16);
    RUN(17) { PH;
        load_tables(F, 1);
        pg8::MoeSched<4, false> S{(const LAS int*)(F.lds + LDSCTL_OFF), (const int*)(P.ws + WS_LT2), F.G, F.vcu, 256, (unsigned)WS_ACT, wsc + WS_WDN + (size_t)1 * 65 * 1024 * 256 * 2};
        pg8::EpiYB E{(unsigned char*)(P.ws + WS_YB), (const LAS int*)(F.lds + LDSCTL_OFF)};
        pg8::gemm_phase<pg8::EpiYB, pg8::MoeSched<4, false>, true>(F.lds, wsc, 256, S, E);
    } SEAM(17);
    RUN(18) { PH; phase_combine<true>(F, 1, X3, P.out); } SEAM(18);
#undef IN
#undef SEAM
#undef RUN
#undef REPS
#undef PH
}
}
static int g_grid = 0;
static void mk_setup() {
    if (g_grid) return;
    int dev = 0, cus = 0, per_cu = 0;
    (void)hipGetDevice(&dev);
    (void)hipDeviceGetAttribute(&cus, hipDeviceAttributeMultiprocessorCount, dev);
    (void)hipFuncSetAttribute((const void*)mk::fwd, hipFuncAttributeMaxDynamicSharedMemorySize, mk::LDS_BYTES);
    if (hipOccupancyMaxActiveBlocksPerMultiprocessor(&per_cu, (const void*)mk::fwd, mk::NTHREADS, mk::LDS_BYTES) != hipSuccess) per_cu = 0;
    (void)hipGetLastError();
    if (per_cu < 1) fprintf(stderr, "kernel_launch: the occupancy query reports %d resident workgroups per CU for %d threads + %d B of LDS; launching one per CU anyway\n", per_cu, mk::NTHREADS, mk::LDS_BYTES);
    g_grid = cus;
    if (g_grid <= 0) g_grid = 256;
}
static void mk_launch(hipStream_t s, void* const* d_in, void* d_out, void* d_ws, int lo, int hi) {
    mk::Args a{};
    for (int i = 0; i < 30; ++i) a.in[i] = (const float*)d_in[i];
    a.out = (float*)d_out; a.ws = (unsigned char*)d_ws; a.ph_lo = lo; a.ph_hi = hi;
    hipLaunchKernelGGL(mk::fwd, dim3(g_grid), dim3(mk::NTHREADS), mk::LDS_BYTES, s, a);
}

extern "C" void kernel_launch(void* const* d_in, const int* in_sizes, int n_in, void* d_out, int out_size, void* d_ws, size_t ws_size,
                              hipStream_t stream) {
    if (n_in != 30 || ws_size < WS_END || out_size != NT * DM) { fprintf(stderr, "kernel_launch: unexpected n_in %d / out %d / ws %zu\n", n_in, out_size, ws_size); return; }
    (void)in_sizes;
    mk_setup();
    (void)hipMemsetAsync((unsigned char*)d_ws + WS_CTL, 0, 1 * MiB, stream);
#ifndef MK_PER_PHASE
    mk_launch(stream, d_in, d_out, d_ws, 0, mk::NPHASE);
#else
    for (int k = 0; k < mk::NPHASE; ++k) mk_launch(stream, d_in, d_out, d_ws, k, k + 1);
#endif
}
```

```cpp
#include <hip/hip_runtime.h>
#include <stdint.h>
#include <cstdio>
#include <cmath>

typedef unsigned short bf16_t;

constexpr int NB = 8, SEQ = 2048, DM = 1024, NT = NB * SEQ, NH = 16;
constexpr int NE = 64, TOPK = 6, PMAX = 114688  , AROWS = PMAX + NT;
constexpr int MODW = 14336;
constexpr float EPS = 1e-6f;
constexpr float LOG2E = 1.4426950408889634f;
constexpr float C2 = 0.125f * LOG2E;
constexpr float C3 = 0.10206207261596577f * LOG2E;

constexpr size_t MiB = 1u << 20;
constexpr size_t WS_CTL = 0;
constexpr size_t WS_MOD = 1 * MiB;
constexpr size_t WS_TOPI = 2 * MiB;
constexpr size_t WS_TOPW = 2 * MiB + 512 * 1024;
constexpr size_t WS_PPOS = 3 * MiB;
constexpr size_t WS_LTOK = 3 * MiB + 512 * 1024;
constexpr size_t WS_KPSS = 4 * MiB;
constexpr size_t WS_KPR = 4 * MiB + 512 * 1024;
constexpr size_t WS_XN = 8 * MiB;
constexpr size_t WS_XKV = 40 * MiB;
constexpr size_t WS_OB = 72 * MiB;
constexpr size_t WS_X1 = 104 * MiB;
constexpr size_t WS_X2 = 168 * MiB;
constexpr size_t WS_ACT = 232 * MiB;
constexpr size_t WS_YB = 296 * MiB;
constexpr size_t WS_R0 = 552 * MiB;
constexpr size_t WS_QB = WS_R0, WS_KB = WS_R0 + 32 * MiB, WS_VB = WS_R0 + 64 * MiB;
constexpr size_t WS_DKV = WS_R0, WS_DQ = WS_R0 + 16 * MiB, WS_CKV = WS_R0 + 32 * MiB, WS_CQ = WS_R0 + 40 * MiB;
constexpr size_t WS_KM = WS_R0 + 52 * MiB, WS_VM = WS_R0 + 100 * MiB, WS_QR = WS_R0 + 132 * MiB;
constexpr size_t WS_END = 1024 * MiB;

constexpr int CW_ECNT = 1024, CW_EOFF = 1024 + 128, CW_CUR = 1024 + 256;

__device__ __forceinline__ float bf2f(bf16_t v) { return __uint_as_float(((unsigned)v) << 16); }
__device__ __forceinline__ bf16_t f2bf(float f) { unsigned u = __float_as_uint(f); return (bf16_t)((u + 0x7fffu + ((u >> 16) & 1u)) >> 16); }


__device__ __forceinline__ float dppf(float v, const int ctrl_sel) {
    const int iv = __float_as_int(v); int r;
    if (ctrl_sel == 0) r = __builtin_amdgcn_update_dpp(iv, iv, 0xB1, 0xF, 0xF, false);
    else if (ctrl_sel == 1) r = __builtin_amdgcn_update_dpp(iv, iv, 0x4E, 0xF, 0xF, false);
    else if (ctrl_sel == 2) r = __builtin_amdgcn_update_dpp(iv, iv, 0x141, 0xF, 0xF, false);
    else r = __builtin_amdgcn_update_dpp(iv, iv, 0x140, 0xF, 0xF, false);
    return __int_as_float(r);
}
__device__ __forceinline__ float sum_x16(float v) { const auto r = __builtin_amdgcn_permlane16_swap(__float_as_int(v), __float_as_int(v), false, false); return __int_as_float(r[0]) + __int_as_float(r[1]); }
__device__ __forceinline__ float sum_x32(float v) { const auto r = __builtin_amdgcn_permlane32_swap(__float_as_int(v), __float_as_int(v), false, false); return __int_as_float(r[0]) + __int_as_float(r[1]); }
__device__ __forceinline__ float max_x16(float v) { const auto r = __builtin_amdgcn_permlane16_swap(__float_as_int(v), __float_as_int(v), false, false); return fmaxf(__int_as_float(r[0]), __int_as_float(r[1])); }
__device__ __forceinline__ float max_x32(float v) { const auto r = __builtin_amdgcn_permlane32_swap(__float_as_int(v), __float_as_int(v), false, false); return fmaxf(__int_as_float(r[0]), __int_as_float(r[1])); }
__device__ __forceinline__ float wave_sum_all(float v) { v += dppf(v, 0); v += dppf(v, 1); v += dppf(v, 2); v += dppf(v, 3); v = sum_x16(v); return sum_x32(v); }
__device__ __forceinline__ float wave_max_all(float v) { v = fmaxf(v, dppf(v, 0)); v = fmaxf(v, dppf(v, 1)); v = fmaxf(v, dppf(v, 2)); v = fmaxf(v, dppf(v, 3)); v = max_x16(v); return max_x32(v); }
__device__ __forceinline__ float max8(float v) { v = fmaxf(v, dppf(v, 0)); v = fmaxf(v, dppf(v, 1)); return fmaxf(v, dppf(v, 2)); }

namespace nv {
__device__ __forceinline__ void route_lane(float score, float bias, int lane, bool& sel, int& jrank, float& w) {
    const float s = score + bias;
    const int g = lane >> 3;
    const float m1 = max8(s);
    unsigned long long bal = __ballot(s == m1);
    const unsigned gm = (unsigned)(bal >> (g * 8)) & 0xffu;
    const int first = __ffs(gm) - 1;
    const float m2 = max8(((lane & 7) == first) ? -INFINITY : s);
    const float gs = m1 + m2;
    int rank = 0;
#pragma unroll
    for (int gg = 0; gg < 8; ++gg) { const float o = __int_as_float(__builtin_amdgcn_readlane(__float_as_int(gs), gg * 8)); rank += ((o > gs) || (o == gs && gg < g)) ? 1 : 0; }
    float v = (rank < 4) ? s : -INFINITY;
    sel = false; jrank = -1;
#pragma unroll
    for (int it = 0; it < TOPK; ++it) {
        const float mx = wave_max_all(v);
        bal = __ballot(v == mx);
        const int f = __ffsll((long long)bal) - 1;
        if (lane == f) { sel = true; jrank = it; v = -INFINITY; }
    }
    const float ssum = wave_sum_all(sel ? score : 0.f);
    w = sel ? score / ssum * 2.5f : 0.f;
}

}

constexpr size_t WS_WQKV = 748 * MiB;
constexpr size_t WS_WO0 = WS_WQKV + 6 * MiB;
constexpr size_t WS_WO1 = WS_WO0 + 2 * MiB;
constexpr size_t WS_WKVD = WS_WO1 + 2 * MiB;
constexpr size_t WS_WDQ = WS_WKVD + 1 * MiB;
constexpr size_t WS_WUKV = WS_WDQ + 1 * MiB;
constexpr size_t WS_WUQ = WS_WUKV + 1 * MiB;
constexpr size_t WS_WR = WS_WUQ + 1536 * 1024;
constexpr size_t WS_WGU = WS_WR + 512 * 1024;
constexpr size_t WS_WDN = WS_WGU + 130 * MiB;
constexpr size_t WS_FAST_END = WS_WDN + 65 * MiB;
static_assert(WS_FAST_END <= WS_END, "d_ws map");
constexpr size_t WS_PART = WS_R0 + 96 * MiB;
constexpr size_t WS_LSE = WS_R0 + 192 * MiB;
constexpr size_t WS_LT2 = 960 * MiB;
constexpr size_t WS_ROPE = 964 * MiB;
constexpr size_t WS_W8 = 968 * MiB;
constexpr size_t WS_PB = 984 * MiB;
constexpr size_t WS_CB = 985 * MiB;
constexpr size_t WS_RSTD = 986 * MiB;
constexpr size_t WS_SSQ = 988 * MiB;
constexpr int CW_MODCNT = 3000;
constexpr int CW_ECNTF = 2048;

#define GAS __attribute__((address_space(1)))
#define LAS __attribute__((address_space(3)))
typedef short bf16x8 __attribute__((ext_vector_type(8)));
typedef float f32x4 __attribute__((ext_vector_type(4)));
typedef float f32x2 __attribute__((ext_vector_type(2)));
typedef unsigned u32x4 __attribute__((ext_vector_type(4)));
typedef unsigned u32x2 __attribute__((ext_vector_type(2)));

__device__ __forceinline__ unsigned pk2(float lo, float hi) { return (unsigned)f2bf(lo) | ((unsigned)f2bf(hi) << 16); }
__device__ __forceinline__ unsigned cvt_pk_bf16(float lo, float hi) { unsigned r; asm volatile("v_cvt_pk_bf16_f32 %0, %1, %2" : "=v"(r) : "v"(lo), "v"(hi)); return r; }

namespace pg8 {
constexpr int BM = 256, BK = 64, HALF = 128, HTB = HALF * BK * 2, STAGE_BYTES = 8 * HTB, NXCD = 8, WGM = 8;
__host__ __device__ __forceinline__ int lds_byte(int r, int c) { const int st = (r >> 4) * 2 + (c >> 5), rr = r & 15, cc = c & 31, ob = rr * 64 + cc * 2; return st * 1024 + (ob ^ (((ob >> 9) & 1) << 5)); }
__host__ __device__ __forceinline__ void stage_rc(int b, int& R, int& C) { const int st = b / 1024, sb = b % 1024, swz = sb ^ (((sb >> 9) & 1) << 5); R = (st >> 1) * 16 + swz / 64; C = (st & 1) * 32 + (swz % 64) / 2; }
__host__ __device__ __forceinline__ int perm32(int rho) { const int n = rho >> 4, i = rho & 15; return 8 * (i >> 2) + 4 * n + (i & 3); }

struct Unit { int rowbase; int pn; int aux; int aux2; };

template <class Epi, class Sched, bool ALIGN_EPI>
__device__ __forceinline__ void gemm_phase(LAS unsigned char* lds, const char* Abase, const int K, const Sched& S, const Epi& E, const int abl = 0, const int lda_ = 0) {
    int tid_ = threadIdx.x; asm volatile("" : "+v"(tid_));
    const int tid = tid_, wid = __builtin_amdgcn_readfirstlane(tid >> 6), lane = tid & 63, wr = wid >> 2, wc = wid & 3, fr = lane & 15, fq = lane >> 4;
    const int nt = K / BK;
    int Rr[2]; unsigned Cb[2], voffB[2], lo[2];
#pragma unroll
    for (int i = 0; i < 2; ++i) { int R, C; stage_rc(tid * 16 + i * 8192, R, C); const int Rb = Epi::PERM ? ((R & ~31) + perm32(R & 31)) : R;
        Rr[i] = R; Cb[i] = (unsigned)C * 2u; voffB[i] = (unsigned)(Rb * K + C) * 2u; lo[i] = (unsigned)(R * (lda_ ? lda_ : K) + C) * 2u; }
    const size_t kstep = (size_t)(BK * 2);
    const size_t hstepB = (size_t)HALF * K * 2, hstepA = (size_t)HALF * (lda_ ? lda_ : K) * 2;
    const unsigned ldsw = (unsigned)wid * 1024u;
    const int aoff = lds_byte(wr * 64 + fr, fq * 8), boff = lds_byte(wc * 32 + fr, fq * 8);
#define PG8_SA(b, h) (((b) * 2 + (h)) * HTB)
#define PG8_SB(b, h) ((4 + (b) * 2 + (h)) * HTB)
#define PG8_STAGE_B(bufoff, gbase) do { if (!(abl & 4)) _Pragma("unroll") for (int _i = 0; _i < 2; ++_i) \
        __builtin_amdgcn_global_load_lds((const unsigned*)((const char*)(gbase) + voffB[_i]), (LAS unsigned*)(lds + (bufoff) + ldsw + _i * 8192), 16, 0, 0); } while (0)
#define PG8_STAGE_A(bufoff, h, nx, kb) do { if (abl & 4) break; unsigned _o0, _o1; const char* _b; \
        if constexpr (Sched::GATHER) { _b = Abase + (size_t)(kb); _o0 = (nx) ? ((h) ? an10 : an00) : ((h) ? ac10 : ac00); _o1 = (nx) ? ((h) ? an11 : an01) : ((h) ? ac11 : ac01); } \
        else { _b = Abase + (size_t)(kb) + ((nx) ? nU : cU) + ((h) ? hstepA : (size_t)0); _o0 = lo[0]; _o1 = lo[1]; } \
        __builtin_amdgcn_global_load_lds((const unsigned*)(_b + _o0), (LAS unsigned*)(lds + (bufoff) + ldsw), 16, 0, 0); \
        __builtin_amdgcn_global_load_lds((const unsigned*)(_b + _o1), (LAS unsigned*)(lds + (bufoff) + ldsw + 8192), 16, 0, 0); } while (0)
#define PG8_LDA(dst, b, h) do { _Pragma("unroll") for (int m = 0; m < 4; ++m) _Pragma("unroll") for (int k = 0; k < 2; ++k) dst[m][k] = *(const LAS bf16x8*)(lds + PG8_SA(b, h) + aoff + m * 2048 + k * 1024); } while (0)
#define PG8_LDB(dst, b, h) do { _Pragma("unroll") for (int n = 0; n < 2; ++n) _Pragma("unroll") for (int k = 0; k < 2; ++k) dst[n][k] = *(const LAS bf16x8*)(lds + PG8_SB(b, h) + boff + n * 2048 + k * 1024); } while (0)
#define PG8_MMA(ai, bj, At, Bt) do { if (abl & 2) break; __builtin_amdgcn_s_setprio(1); _Pragma("unroll") for (int m = 0; m < 4; ++m) _Pragma("unroll") for (int n = 0; n < 2; ++n) _Pragma("unroll") for (int k = 0; k < 2; ++k) \
        acc[ai][bj][m][n] = __builtin_amdgcn_mfma_f32_16x16x32_bf16(Bt[n][k], At[m][k], acc[ai][bj][m][n], 0, 0, 0); __builtin_amdgcn_s_setprio(0); } while (0)
#define PG8_WAIT_V(n) asm volatile("s_waitcnt vmcnt(" #n ")" ::: "memory")
#define PG8_WAIT_L(n) asm volatile("s_waitcnt lgkmcnt(" #n ")" ::: "memory")
#define PG8_BAR __builtin_amdgcn_s_barrier()
#define PG8_SCHED __builtin_amdgcn_sched_barrier(0)
    Unit cur, nxt; int ui = 0;
    if (!S.next(0, cur)) return;
    f32x4 acc[2][2][4][2];
#pragma unroll
    for (int a = 0; a < 2; ++a)
#pragma unroll
        for (int b = 0; b < 2; ++b)
#pragma unroll
            for (int m = 0; m < 4; ++m)
#pragma unroll
                for (int n = 0; n < 2; ++n) acc[a][b][m][n] = (f32x4){0.f, 0.f, 0.f, 0.f};
    bf16x8 At[4][2], B0[2][2], B1[2][2];
    unsigned ac00 = 0, ac01 = 0, ac10 = 0, ac11 = 0, an00 = 0, an01 = 0, an10 = 0, an11 = 0; size_t cU = 0, nU = 0;
    if constexpr (Sched::GATHER) { ac00 = S.a_off(cur, Rr[0]) + Cb[0]; ac01 = S.a_off(cur, Rr[1]) + Cb[1]; ac10 = S.a_off(cur, HALF + Rr[0]) + Cb[0]; ac11 = S.a_off(cur, HALF + Rr[1]) + Cb[1]; }
    else cU = S.a_uni(cur);
    const char* cB = S.b_base(cur);
    PG8_STAGE_B(PG8_SB(0, 0), cB); PG8_STAGE_B(PG8_SB(0, 1), cB + hstepB); PG8_STAGE_A(PG8_SA(0, 0), 0, false, 0); PG8_STAGE_A(PG8_SA(0, 1), 1, false, 0);
    if (wr == 1) PG8_BAR;
    PG8_WAIT_V(2); PG8_BAR;
    PG8_STAGE_B(PG8_SB(1, 0), cB + kstep); PG8_STAGE_A(PG8_SA(1, 0), 0, false, kstep); PG8_STAGE_B(PG8_SB(1, 1), cB + hstepB + kstep);
    PG8_WAIT_V(6); PG8_BAR;
    for (;;) {
        const bool has_next = S.next(ui + 1, nxt);
        const char* nB = cB;
        if (has_next) {
            if constexpr (Sched::GATHER) { an00 = S.a_off(nxt, Rr[0]) + Cb[0]; an01 = S.a_off(nxt, Rr[1]) + Cb[1]; an10 = S.a_off(nxt, HALF + Rr[0]) + Cb[0]; an11 = S.a_off(nxt, HALF + Rr[1]) + Cb[1]; }
            else nU = S.a_uni(nxt);
            nB = S.b_base(nxt);
        } else { an00 = ac00; an01 = ac01; an10 = ac10; an11 = ac11; nU = cU; }
#pragma unroll 1
        for (int t = 0; t < nt; t += 2) {
            const bool last = (t == nt - 2);
            const size_t k1 = (size_t)(t + 1) * kstep;
            const size_t k2 = last ? (size_t)0 : (size_t)(t + 2) * kstep;
            const char* b2 = last ? nB : cB + (size_t)(t + 2) * kstep; const char* b3 = b2 + kstep;
            PG8_LDB(B0, 0, 0); PG8_LDB(B1, 0, 1); PG8_SCHED; PG8_LDA(At, 0, 0); PG8_STAGE_A(PG8_SA(1, 1), 1, false, k1);
            PG8_WAIT_V(8); PG8_WAIT_L(0); PG8_BAR; PG8_MMA(0, 0, At, B0); PG8_MMA(0, 1, At, B1); PG8_BAR; PG8_SCHED;
            PG8_LDA(At, 0, 1); PG8_STAGE_B(PG8_SB(0, 0), b2); PG8_STAGE_B(PG8_SB(0, 1), b2 + hstepB); PG8_STAGE_A(PG8_SA(0, 0), 0, last, k2);
            PG8_WAIT_V(8); PG8_WAIT_L(0); PG8_BAR; PG8_MMA(1, 0, At, B0); PG8_MMA(1, 1, At, B1); PG8_BAR; PG8_SCHED;
            PG8_LDB(B0, 1, 0); PG8_LDB(B1, 1, 1); PG8_SCHED; PG8_LDA(At, 1, 0); PG8_STAGE_A(PG8_SA(0, 1), 1, last, k2);
            PG8_WAIT_V(8); PG8_WAIT_L(0); PG8_BAR; PG8_MMA(0, 0, At, B0); PG8_MMA(0, 1, At, B1); PG8_BAR; PG8_SCHED;
            PG8_LDA(At, 1, 1); PG8_STAGE_B(PG8_SB(1, 0), b3); PG8_STAGE_B(PG8_SB(1, 1), b3 + hstepB); PG8_STAGE_A(PG8_SA(1, 0), 0, last, k2 + kstep);
            PG8_WAIT_V(8); PG8_WAIT_L(0); PG8_BAR; PG8_MMA(1, 0, At, B0); PG8_MMA(1, 1, At, B1); PG8_BAR; PG8_SCHED;
        }
        if constexpr (ALIGN_EPI) { if (wr == 0) PG8_BAR; }
        { int fr_e = fr, fq_e = fq; asm volatile("" : "+v"(fr_e), "+v"(fq_e));
          if (!(abl & 1)) E(acc, cur, wr, wc, fr_e, fq_e); }
        if (!has_next) break;
#pragma unroll
        for (int a = 0; a < 2; ++a)
#pragma unroll
            for (int b = 0; b < 2; ++b)
#pragma unroll
                for (int m = 0; m < 4; ++m)
#pragma unroll
                    for (int n = 0; n < 2; ++n) acc[a][b][m][n] = (f32x4){0.f, 0.f, 0.f, 0.f};
        cur = nxt; cB = nB; ac00 = an00; ac01 = an01; ac10 = an10; ac11 = an11; cU = nU; ++ui;
        if constexpr (ALIGN_EPI) { if (wr == 1) PG8_BAR; }
    }
    PG8_WAIT_V(0);
    if constexpr (!ALIGN_EPI) { if (wr == 0) PG8_BAR; }
    PG8_BAR;
#undef PG8_SA
#undef PG8_SB
#undef PG8_STAGE_A
#undef PG8_STAGE_B
#undef PG8_LDA
#undef PG8_LDB
#undef PG8_MMA
#undef PG8_WAIT_V
#undef PG8_WAIT_L
#undef PG8_BAR
#undef PG8_SCHED
}

struct DenseSched {
    static constexpr bool GATHER = false;
    int nN, nwg, G, c, K, lda; unsigned a0; const char* Bt;
    __device__ __forceinline__ void init(int N, int K_, int G_, int c_, unsigned a0_, const void* Bt_, int lda_ = 0) { nN = N / BM; nwg = (NT / BM) * nN; G = G_; c = c_; K = K_; lda = lda_ ? lda_ : K_; a0 = a0_; Bt = (const char*)Bt_; }
    __device__ __forceinline__ bool next(int i, Unit& u) const {
        const int L = i * G + c; if (L >= nwg) return false;
        int wgid = L; { const int q = nwg / NXCD, r = nwg % NXCD, xcd = wgid % NXCD, off = wgid / NXCD; wgid = (xcd < r ? xcd * (q + 1) : r * (q + 1) + (xcd - r) * q) + off; }
        const int nM = NT / BM, nig = WGM * nN, gid = wgid / nig, fm = gid * WGM, gsz = (nM - fm) < WGM ? (nM - fm) : WGM;
        u.rowbase = (fm + ((wgid % nig) % gsz)) * BM; u.pn = (wgid % nig) / gsz; u.aux = 0; u.aux2 = 0; return true;
    }
    __device__ __forceinline__ size_t a_uni(const Unit& u) const { return (size_t)a0 + (size_t)u.rowbase * (size_t)(lda * 2); }
    __device__ __forceinline__ unsigned a_off(const Unit& u, int r) const { return 0u; }
    __device__ __forceinline__ const char* b_base(const Unit& u) const { return Bt + (size_t)u.pn * BM * K * 2; }
};

struct EpiQKV {
    static constexpr bool PERM = true;
    bf16_t *Q; const float *qg, *kg;
    __device__ __forceinline__ void operator()(const f32x4 (&acc)[2][2][4][2], const Unit& u, int wr, int wc, int fr, int fq) const {
        const int part = u.pn >> 2, head = (u.pn & 3) * 4 + wc;
        bf16_t* out = Q + (size_t)part * (size_t)(16 * 1024 * 1024) + head * 64 + 8 * fq;
        f32x4 g[2][2];
#pragma unroll
        for (int bj = 0; bj < 2; ++bj)
#pragma unroll
            for (int n = 0; n < 2; ++n) g[bj][n] = (f32x4){1.f, 1.f, 1.f, 1.f};
        if (part < 2) { const float* gp = (part ? kg : qg) + 8 * fq;
#pragma unroll
            for (int bj = 0; bj < 2; ++bj)
#pragma unroll
                for (int n = 0; n < 2; ++n) g[bj][n] = *(const f32x4*)(gp + 32 * bj + 4 * n); }
        const float rscale = (part == 0) ? C2 : 1.f;
#pragma unroll
        for (int ai = 0; ai < 2; ++ai)
#pragma unroll
            for (int m = 0; m < 4; ++m) {
                const int row = u.rowbase + ai * HALF + wr * 64 + m * 16 + fr;
                f32x4 v[2][2];
#pragma unroll
                for (int bj = 0; bj < 2; ++bj)
#pragma unroll
                    for (int n = 0; n < 2; ++n) v[bj][n] = acc[ai][bj][m][n];
                float ss = 0.f;
#pragma unroll
                for (int bj = 0; bj < 2; ++bj)
#pragma unroll
                    for (int n = 0; n < 2; ++n) { const f32x4 x = v[bj][n]; ss += (x[0] * x[0] + x[1] * x[1]) + (x[2] * x[2] + x[3] * x[3]); }
                ss = sum_x16(ss); ss = sum_x32(ss);
                const float r = (part < 2) ? rsqrtf(ss * (1.f / 64.f) + EPS) * rscale : 1.f;
#pragma unroll
                for (int bj = 0; bj < 2; ++bj)
#pragma unroll
                    for (int n = 0; n < 2; ++n) v[bj][n] = v[bj][n] * r * g[bj][n];
#pragma unroll
                for (int bj = 0; bj < 2; ++bj) { u32x4 w; w.x = cvt_pk_bf16(v[bj][0][0], v[bj][0][1]); w.y = cvt_pk_bf16(v[bj][0][2], v[bj][0][3]); w.z = cvt_pk_bf16(v[bj][1][0], v[bj][1][1]); w.w = cvt_pk_bf16(v[bj][1][2], v[bj][1][3]);
                    *(u32x4*)(out + (size_t)row * 1024 + 32 * bj) = w; }
            }
    }
};

struct DualSched {
    static constexpr bool GATHER = false;
    int G, c; unsigned a0; const char* Bt;
    __device__ __forceinline__ bool next(int i, Unit& u) const {
        const int L = i * G + c; if (L >= 256) return false;
        const int w = L >> 7, idx = L & 127;
        u.rowbase = (idx >> 1) * BM; u.pn = idx & 1; u.aux = w; u.aux2 = 0; return true;
    }
    __device__ __forceinline__ size_t a_uni(const Unit& u) const { return (size_t)a0 + (size_t)u.rowbase * 2048; }
    __device__ __forceinline__ unsigned a_off(const Unit& u, int r) const { return 0u; }
    __device__ __forceinline__ const char* b_base(const Unit& u) const { return Bt + ((size_t)(u.aux * 8 + (u.rowbase >> 11)) * 512 + (size_t)u.pn * BM) * 1024 * 2; }
};

template <int NTILE, bool GATHER_>
struct MoeSched {
    static constexpr bool GATHER = GATHER_;
    const LAS int* tab;
    const int* LT2; int G, c, K; unsigned a0; const char* Bt;
    __device__ __forceinline__ bool next(int i, Unit& u) const {
        const int L = i * G + c;
        const int nrb = tab[64] >> 8;
        if (L >= (nrb + 64) * NTILE) return false;
        const int blk = L / NTILE; u.pn = L % NTILE;
        if (blk < nrb) {
            const int row0 = blk << 8, lane = threadIdx.x & 63;
            const unsigned long long bal = __ballot(tab[lane] <= row0);
            const int e = __builtin_popcountll(bal) - 1;
            u.rowbase = row0; u.aux = e; u.aux2 = row0 - tab[e];
        } else { u.rowbase = PMAX + ((blk - nrb) << 8); u.aux = 64; u.aux2 = (blk - nrb) << 8; }
        return true;
    }
    __device__ __forceinline__ size_t a_uni(const Unit& u) const { return (size_t)a0 + (size_t)u.rowbase * (size_t)(K * 2); }
    __device__ __forceinline__ unsigned a_off(const Unit& u, int r) const {
        int tok;
        if (u.aux < 64) { const int idx = u.aux2 + r; tok = 0; if (idx < tab[128 + u.aux]) tok = LT2[u.aux * 16384 + idx]; }
        else tok = u.aux2 + r;
        return a0 + (unsigned)tok * 2048u;
    }
    __device__ __forceinline__ const char* b_base(const Unit& u) const { return Bt + ((size_t)u.aux * NTILE + u.pn) * BM * K * 2; }
};

template <bool XBF>
struct EpiResid {
    static constexpr bool PERM = true;
    const void* xin; const float* MOD; int gate_off; bf16_t* out;
    __device__ __forceinline__ void operator()(const f32x4 (&acc)[2][2][4][2], const Unit& u, int wr, int wc, int fr, int fq) const {
        const int b = u.rowbase >> 11, col0 = u.pn * BM + wc * 32 + 8 * fq;
        f32x4 gt[2][2];
#pragma unroll
        for (int bj = 0; bj < 2; ++bj)
#pragma unroll
            for (int n = 0; n < 2; ++n) gt[bj][n] = *(const f32x4*)(MOD + b * MODW + gate_off + col0 + bj * HALF + n * 4);
#pragma unroll
        for (int ai = 0; ai < 2; ++ai)
#pragma unroll
            for (int m = 0; m < 4; ++m) { const size_t off = (size_t)(u.rowbase + ai * HALF + wr * 64 + m * 16 + fr) * 1024 + col0;
#pragma unroll
                for (int bj = 0; bj < 2; ++bj) {
                    f32x4 x0, x1;
                    if (XBF) { const u32x4 xw = *(const u32x4*)((const bf16_t*)xin + off + bj * HALF);
                        x0 = (f32x4){__uint_as_float(xw.x << 16), __uint_as_float(xw.x & 0xffff0000u), __uint_as_float(xw.y << 16), __uint_as_float(xw.y & 0xffff0000u)};
                        x1 = (f32x4){__uint_as_float(xw.z << 16), __uint_as_float(xw.z & 0xffff0000u), __uint_as_float(xw.w << 16), __uint_as_float(xw.w & 0xffff0000u)}; }
                    else { x0 = *(const f32x4*)((const float*)xin + off + bj * HALF); x1 = *(const f32x4*)((const float*)xin + off + bj * HALF + 4); }
                    const f32x4 v0 = x0 + gt[bj][0] * acc[ai][bj][m][0], v1 = x1 + gt[bj][1] * acc[ai][bj][m][1];
                    u32x4 w; w.x = cvt_pk_bf16(v0[0], v0[1]); w.y = cvt_pk_bf16(v0[2], v0[3]); w.z = cvt_pk_bf16(v1[0], v1[1]); w.w = cvt_pk_bf16(v1[2], v1[3]);
                    *(u32x4*)(out + off + bj * HALF) = w; } }
    }
};
struct EpiBf16 {
    static constexpr bool PERM = true;
    bf16_t* O; int ldo; size_t sel_stride; const LAS int* tab;
    __device__ __forceinline__ void operator()(const f32x4 (&acc)[2][2][4][2], const Unit& u, int wr, int wc, int fr, int fq) const {
        bf16_t* base = O + (size_t)u.aux * sel_stride + u.pn * BM + wc * 32 + 8 * fq;
        const int nvalid = (tab && u.aux < 64) ? tab[128 + u.aux] - u.aux2 : 256;
#pragma unroll
        for (int ai = 0; ai < 2; ++ai)
#pragma unroll
            for (int m = 0; m < 4; ++m) { const int lr = ai * HALF + wr * 64 + m * 16 + fr; if (lr >= nvalid) continue; bf16_t* rowp = base + (size_t)(u.rowbase + lr) * ldo;
#pragma unroll
                for (int bj = 0; bj < 2; ++bj) { const f32x4 v0 = acc[ai][bj][m][0], v1 = acc[ai][bj][m][1];
                    u32x4 w; w.x = cvt_pk_bf16(v0[0], v0[1]); w.y = cvt_pk_bf16(v0[2], v0[3]); w.z = cvt_pk_bf16(v1[0], v1[1]); w.w = cvt_pk_bf16(v1[2], v1[3]);
                    *(u32x4*)(rowp + bj * HALF) = w; } }
    }
};
struct EpiDown {
    static constexpr bool PERM = true, DEFER = false;
    bf16_t* O; const float* RSTD; const float* CB; float* SSQ; float* KPSS; float* KPR; const float* ROPE; const float* gk;
    __device__ __forceinline__ void operator()(const f32x4 (&acc)[2][2][4][2], const Unit& u, int wr, int wc, int fr, int fq) const {
        const int col0 = u.pn * BM + wc * 32 + 8 * fq;
        bf16_t* base = O + (size_t)u.aux * (size_t)(8 * 1024 * 1024) + col0;
        const float* cb = CB + ((u.rowbase >> 11) * 2 + u.aux) * 512 + col0;
        f32x4 bs[2][2];
#pragma unroll
        for (int bj = 0; bj < 2; ++bj)
#pragma unroll
            for (int n = 0; n < 2; ++n) bs[bj][n] = *(const f32x4*)(cb + bj * HALF + n * 4);
        const bool ropew = (u.aux == 0) && (u.pn == 1) && (wc == 0);
        f32x4 g0 = (f32x4){0.f, 0.f, 0.f, 0.f}, g1 = g0;
        if (ropew) { g0 = *(const f32x4*)(gk + 64 + 8 * fq); g1 = *(const f32x4*)(gk + 64 + 8 * fq + 4); }
#pragma unroll
        for (int ai = 0; ai < 2; ++ai)
#pragma unroll
            for (int m = 0; m < 4; ++m) { const int row = u.rowbase + ai * HALF + wr * 64 + m * 16 + fr; const float r = RSTD[row]; bf16_t* rowp = base + (size_t)row * 512;
                f32x4 v[2][2];
#pragma unroll
                for (int bj = 0; bj < 2; ++bj) { v[bj][0] = acc[ai][bj][m][0] * r + bs[bj][0]; v[bj][1] = acc[ai][bj][m][1] * r + bs[bj][1];
                    u32x4 w; w.x = cvt_pk_bf16(v[bj][0][0], v[bj][0][1]); w.y = cvt_pk_bf16(v[bj][0][2], v[bj][0][3]); w.z = cvt_pk_bf16(v[bj][1][0], v[bj][1][1]); w.w = cvt_pk_bf16(v[bj][1][2], v[bj][1][3]);
                    *(u32x4*)(rowp + bj * HALF) = w; }
                float ss = ((v[0][0][0] * v[0][0][0] + v[0][0][1] * v[0][0][1]) + (v[0][0][2] * v[0][0][2] + v[0][0][3] * v[0][0][3])) + ((v[0][1][0] * v[0][1][0] + v[0][1][1] * v[0][1][1]) + (v[0][1][2] * v[0][1][2] + v[0][1][3] * v[0][1][3]));
                if (u.pn == 0) ss += ((v[1][0][0] * v[1][0][0] + v[1][0][1] * v[1][0][1]) + (v[1][0][2] * v[1][0][2] + v[1][0][3] * v[1][0][3])) + ((v[1][1][0] * v[1][1][0] + v[1][1][1] * v[1][1][1]) + (v[1][1][2] * v[1][1][2] + v[1][1][3] * v[1][1][3]));
                ss = sum_x16(ss); ss = sum_x32(ss);
                if (!(u.aux == 0 && u.pn == 1)) { if (fq == 0) SSQ[(size_t)row * 16 + u.aux * 8 + u.pn * 4 + wc] = ss; }
                else if (ropew) {
                    if (fq == 0) KPSS[row] = ss;
                    const f32x4 kg0 = v[0][0] * g0, kg1 = v[0][1] * g1;
                    f32x4 kx0, kx1;
#pragma unroll
                    for (int j = 0; j < 4; ++j) {
                        const auto a = __builtin_amdgcn_permlane32_swap(__float_as_int(kg0[j]), __float_as_int(kg0[j]), false, false);
                        const auto b = __builtin_amdgcn_permlane32_swap(__float_as_int(kg1[j]), __float_as_int(kg1[j]), false, false);
                        kx0[j] = (fq & 2) ? __int_as_float(a[0]) : __int_as_float(a[1]); kx1[j] = (fq & 2) ? __int_as_float(b[0]) : __int_as_float(b[1]); }
                    const float* cp = ROPE + (size_t)row * 16 + 8 * (fq & 1); const float* sp = cp + (size_t)NT * 16;
                    const f32x4 c0 = *(const f32x4*)cp, c1 = *(const f32x4*)(cp + 4), s0 = *(const f32x4*)sp, s1 = *(const f32x4*)(sp + 4);
                    const float sg = (fq & 2) ? 1.f : -1.f;
                    *(f32x4*)(KPR + (size_t)row * 32 + 8 * fq) = kg0 * c0 + kx0 * s0 * sg;
                    *(f32x4*)(KPR + (size_t)row * 32 + 8 * fq + 4) = kg1 * c1 + kx1 * s1 * sg;
                } }
    }
};
struct EpiQ {
    static constexpr bool PERM = true, DEFER = false;
    bf16_t* O; const float* SSQ;
    __device__ __forceinline__ void operator()(const f32x4 (&acc)[2][2][4][2], const Unit& u, int wr, int wc, int fr, int fq) const {
        bf16_t* base = O + u.pn * BM + wc * 32 + 8 * fq;
#pragma unroll
        for (int ai = 0; ai < 2; ++ai)
#pragma unroll
            for (int m = 0; m < 4; ++m) { const int row = u.rowbase + ai * HALF + wr * 64 + m * 16 + fr; bf16_t* rowp = base + (size_t)row * 1536;
                const f32x4 sa = *(const f32x4*)(SSQ + (size_t)row * 16 + 8), sb = *(const f32x4*)(SSQ + (size_t)row * 16 + 12);
                const float r = rsqrtf((((sa[0] + sa[1]) + (sa[2] + sa[3])) + ((sb[0] + sb[1]) + (sb[2] + sb[3]))) * (1.f / 384.f) + EPS);
#pragma unroll
                for (int bj = 0; bj < 2; ++bj) { const f32x4 v0 = acc[ai][bj][m][0] * r, v1 = acc[ai][bj][m][1] * r;
                    u32x4 w; w.x = cvt_pk_bf16(v0[0], v0[1]); w.y = cvt_pk_bf16(v0[2], v0[3]); w.z = cvt_pk_bf16(v1[0], v1[1]); w.w = cvt_pk_bf16(v1[2], v1[3]);
                    *(u32x4*)(rowp + bj * HALF) = w; } }
    }
};
constexpr float YB_SCALE = 8.f, YB_CLAMP = 440.f;
struct EpiYB {
    static constexpr bool PERM = true;
    unsigned char* O; const LAS int* tab;
    __device__ __forceinline__ void operator()(const f32x4 (&acc)[2][2][4][2], const Unit& u, int wr, int wc, int fr, int fq) const {
        unsigned char* base = O + u.pn * BM + wc * 64 + 16 * fq;
        const int nvalid = (u.aux < 64) ? tab[128 + u.aux] - u.aux2 : 256;
#pragma unroll
        for (int ai = 0; ai < 2; ++ai)
#pragma unroll
            for (int m = 0; m < 4; ++m) { const int lr = ai * HALF + wr * 64 + m * 16 + fr; if (lr >= nvalid) continue;
                int w[4];
#pragma unroll
                for (int bj = 0; bj < 2; ++bj)
#pragma unroll
                    for (int n = 0; n < 2; ++n) { f32x4 v = acc[ai][bj][m][n] * YB_SCALE;
#pragma unroll
                        for (int j = 0; j < 4; ++j) v[j] = __builtin_amdgcn_fmed3f(v[j], -YB_CLAMP, YB_CLAMP);
                        int q = 0; q = __builtin_amdgcn_cvt_pk_fp8_f32(v[0], v[1], q, false); q = __builtin_amdgcn_cvt_pk_fp8_f32(v[2], v[3], q, true); w[bj * 2 + n] = q; }
                u32x4 o; o.x = (unsigned)w[0]; o.y = (unsigned)w[1]; o.z = (unsigned)w[2]; o.w = (unsigned)w[3];
                *(u32x4*)(base + (size_t)(u.rowbase + lr) * 1024) = o; }
    }
};
struct EpiSwiglu {
    static constexpr bool PERM = true;
    bf16_t* ACT; const LAS int* tab;
    __device__ __forceinline__ void operator()(const f32x4 (&acc)[2][2][4][2], const Unit& u, int wr, int wc, int fr, int fq) const {
        bf16_t* base = ACT + u.pn * 128 + wc * 32 + 8 * fq;
        const int nvalid = (u.aux < 64) ? tab[128 + u.aux] - u.aux2 : 256;
#pragma unroll
        for (int ai = 0; ai < 2; ++ai)
#pragma unroll
            for (int m = 0; m < 4; ++m) { const int lr = ai * HALF + wr * 64 + m * 16 + fr; if (lr >= nvalid) continue; bf16_t* rowp = base + (size_t)(u.rowbase + lr) * 256;
                f32x4 a[2];
#pragma unroll
                for (int n = 0; n < 2; ++n) { const f32x4 g = acc[ai][0][m][n], uu = acc[ai][1][m][n];
#pragma unroll
                    for (int j = 0; j < 4; ++j) a[n][j] = g[j] * __builtin_amdgcn_rcpf(1.f + __expf(-g[j])) * uu[j]; }
                u32x4 w; w.x = cvt_pk_bf16(a[0][0], a[0][1]); w.y = cvt_pk_bf16(a[0][2], a[0][3]); w.z = cvt_pk_bf16(a[1][0], a[1][1]); w.w = cvt_pk_bf16(a[1][2], a[1][3]);
                *(u32x4*)rowp = w; }
    }
};
struct EpiKV {
    static constexpr bool PERM = true;
    bf16_t *KM, *VM; const float *KPSS, *KPR, *gk, *SSQ;
    __device__ __forceinline__ void operator()(const f32x4 (&acc)[2][2][4][2], const Unit& u, int wr, int wc, int fr, int fq) const {
        const bool isk = u.pn < 4; const int head = (u.pn & 3) * 4 + wc;
        f32x4 g[2][2];
#pragma unroll
        for (int bj = 0; bj < 2; ++bj)
#pragma unroll
            for (int n = 0; n < 2; ++n) g[bj][n] = isk ? *(const f32x4*)(gk + 32 * bj + 8 * fq + 4 * n) : (f32x4){1.f, 1.f, 1.f, 1.f};
#pragma unroll
        for (int ai = 0; ai < 2; ++ai)
#pragma unroll
            for (int m = 0; m < 4; ++m) {
                const int row = u.rowbase + ai * HALF + wr * 64 + m * 16 + fr;
                float ss = 0.f;
#pragma unroll
                for (int bj = 0; bj < 2; ++bj)
#pragma unroll
                    for (int n = 0; n < 2; ++n) { const f32x4 x = acc[ai][bj][m][n]; ss += (x[0] * x[0] + x[1] * x[1]) + (x[2] * x[2] + x[3] * x[3]); }
                ss = sum_x16(ss); ss = sum_x32(ss);
                const f32x4 sl = *(const f32x4*)(SSQ + (size_t)row * 16);
                const float rl = rsqrtf(((sl[0] + sl[1]) + (sl[2] + sl[3])) * (1.f / 256.f) + EPS);
                const float rk = isk ? rsqrtf((ss * rl * rl + KPSS[row]) * (1.f / 96.f) + EPS) : 1.f, r = rl * rk;
                bf16_t* o = isk ? KM + ((size_t)row * 16 + head) * 96 + 8 * fq : VM + (size_t)row * 1024 + head * 64 + 8 * fq;
#pragma unroll
                for (int bj = 0; bj < 2; ++bj) { const f32x4 v0 = acc[ai][bj][m][0] * r * g[bj][0], v1 = acc[ai][bj][m][1] * r * g[bj][1];
                    u32x4 w; w.x = cvt_pk_bf16(v0[0], v0[1]); w.y = cvt_pk_bf16(v0[2], v0[3]); w.z = cvt_pk_bf16(v1[0], v1[1]); w.w = cvt_pk_bf16(v1[2], v1[3]);
                    *(u32x4*)(o + 32 * bj) = w; }
                if (isk) { const f32x4 p0 = *(const f32x4*)(KPR + (size_t)row * 32 + 8 * fq) * rk, p1 = *(const f32x4*)(KPR + (size_t)row * 32 + 8 * fq + 4) * rk;
                    u32x4 w; w.x = cvt_pk_bf16(p0[0], p0[1]); w.y = cvt_pk_bf16(p0[2], p0[3]); w.z = cvt_pk_bf16(p1[0], p1[1]); w.w = cvt_pk_bf16(p1[2], p1[3]);
                    *(u32x4*)(o + 64) = w; }
            }
    }
};
}

#define XB_TMO      128
#define XB_XCNT(j)  (256  + 64 * (j))
#define XB_XSUB(j)  (1280 + 64 * (j))
#define XB_XGEN(j)  (2304 + 64 * (j))
#define XB_TOP      3328
#define XB_TOPGEN   3392
#define XCD_BAR_WORDS 3456
#define XB_SPIN_CAP (1u << 18)
__device__ __forceinline__ unsigned xb_ld(unsigned* p)              { return __hip_atomic_load(p, __ATOMIC_RELAXED, __HIP_MEMORY_SCOPE_AGENT); }
__device__ __forceinline__ unsigned xb_add(unsigned* p, unsigned v) { return __hip_atomic_fetch_add(p, v, __ATOMIC_RELAXED, __HIP_MEMORY_SCOPE_AGENT); }
__device__ __forceinline__ unsigned xb_xcc_id() { return (unsigned)__builtin_amdgcn_s_getreg((3 << 11) | 20) & 0xFu; }
#define XB_SPIN(cond, bar) do { unsigned _sp = 0; while (cond) { __builtin_amdgcn_s_sleep(1); \
    if ((++_sp & 255u) == 0u) { if (xb_ld(&(bar)[XB_TMO])) break; if (_sp > XB_SPIN_CAP) { atomicAdd(&(bar)[XB_TMO], 1u); break; } } } } while (0)
struct XcdBarrier { unsigned* bar; unsigned x; volatile LAS unsigned* st; };
__device__ __forceinline__ XcdBarrier xcd_barrier_post(unsigned* bar, volatile LAS unsigned* st) {
    XcdBarrier b; b.bar = bar; b.x = xb_xcc_id(); b.st = st;
    if (threadIdx.x == 0) (void)xb_add(&bar[XB_XCNT(b.x)], 1u);
    return b;
}
__device__ __forceinline__ void xcd_barrier_complete(unsigned* bar, unsigned x, unsigned& nloc, unsigned& nx) {
    const unsigned G = gridDim.x * gridDim.y * gridDim.z;
    unsigned sum, cnt, mine, sp = 0u;
    for (;;) {
        sum = 0u; cnt = 0u; mine = 0u;
#pragma unroll
        for (unsigned j = 0; j < 16; ++j) { const unsigned c = xb_ld(&bar[XB_XCNT(j)]); sum += c; cnt += (c > 0u) ? 1u : 0u; mine = (j == x) ? c : mine; }
        if (sum == G) break;
        __builtin_amdgcn_s_sleep(1);
        if ((++sp & 255u) == 0u) { if (xb_ld(&bar[XB_TMO])) break; if (sp > XB_SPIN_CAP) { atomicAdd(&bar[XB_TMO], 1u); break; } }
    }
    nloc = mine > 0u ? mine : 1u; nx = cnt > 0u ? cnt : 1u;
}
__device__ __forceinline__ void xcd_barrier(const XcdBarrier& b) {
    asm volatile("s_waitcnt vmcnt(0)" ::: "memory");
    __syncthreads();
    if (threadIdx.x == 0) {
        unsigned* bar = b.bar;
        __builtin_amdgcn_s_waitcnt(0);
        unsigned nloc = b.st[0], nx = b.st[1];
        if (nloc == 0u) { xcd_barrier_complete(bar, b.x, nloc, nx); b.st[0] = nloc; b.st[1] = nx; }
        const unsigned old = xb_add(&bar[XB_XSUB(b.x)], 1u);
        const unsigned gen = old / nloc;
        if (old + 1u == (gen + 1u) * nloc) {
            __builtin_amdgcn_fence(__ATOMIC_RELEASE, "agent");
            asm volatile("s_waitcnt vmcnt(0)" ::: "memory");
            const unsigned og = xb_add(&bar[XB_TOP], 1u);
            const unsigned tg = og / nx;
            if (og + 1u == (tg + 1u) * nx) xb_add(&bar[XB_TOPGEN], 1u);
            else XB_SPIN(xb_ld(&bar[XB_TOPGEN]) == tg, bar);
            __builtin_amdgcn_fence(__ATOMIC_ACQUIRE, "agent");
            xb_add(&bar[XB_XGEN(b.x)], 1u);
            asm volatile("s_waitcnt vmcnt(0)" ::: "memory");
        } else {
            XB_SPIN(xb_ld(&bar[XB_XGEN(b.x)]) == gen, bar);
            __builtin_amdgcn_fence(__ATOMIC_ACQUIRE, "agent");
            asm volatile("s_waitcnt vmcnt(0)" ::: "memory");
        }
    }
    __syncthreads();
}


namespace at {
typedef float f32x16 __attribute__((ext_vector_type(16)));
typedef short s16x4 __attribute__((ext_vector_type(4)));
__device__ __forceinline__ int crow(int r, int hi) { return (r & 3) + 8 * (r >> 2) + 4 * hi; }
__device__ __forceinline__ s16x4 vtr(const LAS unsigned char* p) { return __builtin_bit_cast(s16x4, __builtin_amdgcn_ds_read_tr16_b64_v4i16((LAS s16x4*)p)); }
__device__ __forceinline__ float bflo(unsigned u) { return __uint_as_float(u << 16); }
__device__ __forceinline__ float bfhi(unsigned u) { return __uint_as_float(u & 0xffff0000u); }

__device__ __forceinline__ void v_frags(bf16x8 (&vf)[8], const LAS unsigned char* vlane) {
#pragma unroll
    for (int d0 = 0; d0 < 2; ++d0)
#pragma unroll
        for (int ks = 0; ks < 4; ++ks) {
            const s16x4 lo = vtr(vlane + d0 * 4096 + ks * 1024), hi = vtr(vlane + d0 * 4096 + ks * 1024 + 512);
            vf[d0 * 4 + ks] = (bf16x8){lo[0], lo[1], lo[2], lo[3], hi[0], hi[1], hi[2], hi[3]};
        }
}
__device__ __forceinline__ void v_frags_half(bf16x8 (&vf)[4], const LAS unsigned char* vlane, int d0) {
#pragma unroll
    for (int ks = 0; ks < 4; ++ks) {
        const s16x4 lo = vtr(vlane + d0 * 4096 + ks * 1024), hi = vtr(vlane + d0 * 4096 + ks * 1024 + 512);
        vf[ks] = (bf16x8){lo[0], lo[1], lo[2], lo[3], hi[0], hi[1], hi[2], hi[3]};
    }
}
__device__ __forceinline__ void pv_mma_half(f32x16& o, const bf16x8 (&vf)[4], const u32x4 (&pw)[4]) {
    __builtin_amdgcn_s_setprio(1);
#pragma unroll
    for (int ks = 0; ks < 4; ++ks) o = __builtin_amdgcn_mfma_f32_32x32x16_bf16(__builtin_bit_cast(bf16x8, pw[ks]), vf[ks], o, 0, 0, 0);
    __builtin_amdgcn_s_setprio(0);
}
__device__ __forceinline__ void pv_mma(f32x16 (&o)[2], const bf16x8 (&vf)[8], const u32x4 (&pw)[4]) {
    __builtin_amdgcn_s_setprio(1);
#pragma unroll
    for (int ks = 0; ks < 4; ++ks)
#pragma unroll
        for (int d0 = 0; d0 < 2; ++d0) o[d0] = __builtin_amdgcn_mfma_f32_32x32x16_bf16(__builtin_bit_cast(bf16x8, pw[ks]), vf[d0 * 4 + ks], o[d0], 0, 0, 0);
    __builtin_amdgcn_s_setprio(0);
}
constexpr float SM_THR = 8.f;
__device__ __forceinline__ bool softmax_step(f32x16& p0, f32x16& p1, float& mhat, float& l, f32x16 (&o)[2], u32x4 (&pw)[4], LAS float* wsf, int r32, int hi, bool first) {
    float a = fmaxf(fmaxf(p0[0], p1[0]), fmaxf(p0[1], p1[1]));
#pragma unroll
    for (int r = 2; r < 16; r += 2) a = fmaxf(a, fmaxf(fmaxf(p0[r], p1[r]), fmaxf(p0[r + 1], p1[r + 1])));
    a = max_x32(a);
    const bool moved = first || __any(a > SM_THR);
    if (moved) {
        const float dl = first ? a : fmaxf(a, 0.f);
        mhat += dl;
#pragma unroll
        for (int r = 0; r < 16; ++r) { p0[r] -= dl; p1[r] -= dl; }
        if (!first) {
            const float f = __builtin_amdgcn_exp2f(-dl);
            l *= f;
            if (hi == 0) wsf[r32] = f;
            asm volatile("s_waitcnt lgkmcnt(0)" ::: "memory");
#pragma unroll
            for (int g = 0; g < 4; ++g) { const f32x4 al = *(const LAS f32x4*)(wsf + 8 * g + 4 * hi);
#pragma unroll
                for (int j = 0; j < 4; ++j) { o[0][4 * g + j] *= al[j]; o[1][4 * g + j] *= al[j]; } }
        }
    }
    f32x2 sa = (f32x2){0.f, 0.f}, sb = (f32x2){0.f, 0.f};
#pragma unroll
    for (int r = 0; r < 16; r += 2) {
        p0[r] = __builtin_amdgcn_exp2f(p0[r]); p0[r + 1] = __builtin_amdgcn_exp2f(p0[r + 1]); p1[r] = __builtin_amdgcn_exp2f(p1[r]); p1[r + 1] = __builtin_amdgcn_exp2f(p1[r + 1]);
        sa += (f32x2){p0[r], p0[r + 1]}; sb += (f32x2){p1[r], p1[r + 1]};
    }
    sa += sb; l += sa.x + sa.y;
#pragma unroll
    for (int k = 0; k < 2; ++k) {
        pw[k].x = cvt_pk_bf16(p0[8 * k + 0], p0[8 * k + 1]); pw[k].y = cvt_pk_bf16(p0[8 * k + 2], p0[8 * k + 3]); pw[k].z = cvt_pk_bf16(p0[8 * k + 4], p0[8 * k + 5]); pw[k].w = cvt_pk_bf16(p0[8 * k + 6], p0[8 * k + 7]);
        pw[2 + k].x = cvt_pk_bf16(p1[8 * k + 0], p1[8 * k + 1]); pw[2 + k].y = cvt_pk_bf16(p1[8 * k + 2], p1[8 * k + 3]); pw[2 + k].z = cvt_pk_bf16(p1[8 * k + 4], p1[8 * k + 5]); pw[2 + k].w = cvt_pk_bf16(p1[8 * k + 6], p1[8 * k + 7]);
    }    return moved;
}
__device__ __forceinline__ void finish_store(const f32x16 (&o)[2], float l, LAS float* wsf, int r32, int hi, bf16_t* Orow0, size_t ostride) {
    l = sum_x32(l);
    if (hi == 0) wsf[32 + r32] = l;
    asm volatile("s_waitcnt lgkmcnt(0)" ::: "memory");
#pragma unroll
    for (int g = 0; g < 4; ++g) { const f32x4 lv = *(const LAS f32x4*)(wsf + 32 + 8 * g + 4 * hi);
#pragma unroll
        for (int j = 0; j < 4; ++j) { const float rl = __builtin_amdgcn_rcpf(lv[j]); const int row = 8 * g + 4 * hi + j;
            Orow0[(size_t)row * ostride + r32] = f2bf(o[0][4 * g + j] * rl); Orow0[(size_t)row * ostride + 32 + r32] = f2bf(o[1][4 * g + j] * rl); } }
}

constexpr int MLA_KB = 12288, MLA_BUF = 20480;
template <class BG>
__device__ __forceinline__ void mla_unit(LAS unsigned char* lds, int b, int h, int qb, const bf16_t* QR, const bf16_t* KM, const bf16_t* VM, const float* ROPE, const float* gq, bf16_t* OB, BG& bg, const int abl = 0) {
    int tid = threadIdx.x; asm volatile("" : "+v"(tid));
    const int lane = tid & 63, r32 = lane & 31, hi = lane >> 5, wid = __builtin_amdgcn_readfirstlane(tid >> 6);
    const int q0 = qb * 256, NTL = 4 * (qb + 1), rowbase = b * SEQ;
    LAS float* wsf = (LAS float*)(lds + 2 * MLA_BUF) + wid * 64;
    const bf16_t* kg0 = KM + ((size_t)(rowbase + lane) * 16 + h) * 96 + wid * 8;
    const bf16_t* kg1 = KM + ((size_t)(rowbase + lane) * 16 + h) * 96 + (8 + (wid & 3)) * 8;
    const bf16_t* vg = VM + (size_t)(rowbase + 16 * (wid & 3) + (lane >> 2)) * 1024 + h * 64 + (wid >> 2) * 32 + (lane & 3) * 8;
    const int kl0 = wid * 1024 + lane * 16, kl1 = (8 + (wid & 3)) * 1024 + lane * 16, vl = MLA_KB + wid * 1024 + lane * 16;
    u32x4 ak0, ak1, av, bk0, bk1, bv; ak1 = (u32x4){0u, 0u, 0u, 0u}; bk1 = ak1;
#define MLA_LOAD(S, t) do { S##k0 = *(const GAS u32x4*)(kg0 + (size_t)(t) * 64 * 1536); if (wid < 4) S##k1 = *(const GAS u32x4*)(kg1 + (size_t)(t) * 64 * 1536); S##v = *(const GAS u32x4*)(vg + (size_t)(t) * 64 * 1024); } while (0)
#define MLA_WRITE(S, buf) do { *(LAS u32x4*)(lds + (buf) * MLA_BUF + kl0) = S##k0; if (wid < 4) *(LAS u32x4*)(lds + (buf) * MLA_BUF + kl1) = S##k1; *(LAS u32x4*)(lds + (buf) * MLA_BUF + vl) = S##v; } while (0)
    MLA_LOAD(a, 0);
    bf16x8 qr[6];
    {
        const int qrow = rowbase + q0 + wid * 32 + r32;
        const bf16_t* qp = QR + (size_t)qrow * 1536 + h * 96 + hi * 8;
        float qf[6][8]; float ss = 0.f;
#pragma unroll
        for (int d0 = 0; d0 < 6; ++d0) { const u32x4 w = *(const GAS u32x4*)(qp + 16 * d0);
            qf[d0][0] = bflo(w.x); qf[d0][1] = bfhi(w.x); qf[d0][2] = bflo(w.y); qf[d0][3] = bfhi(w.y); qf[d0][4] = bflo(w.z); qf[d0][5] = bfhi(w.z); qf[d0][6] = bflo(w.w); qf[d0][7] = bfhi(w.w);
#pragma unroll
            for (int j = 0; j < 8; ++j) ss += qf[d0][j] * qf[d0][j]; }
        ss = sum_x32(ss);
        const float rn = rsqrtf(ss * (1.f / 96.f) + EPS) * C3;
#pragma unroll
        for (int d0 = 0; d0 < 6; ++d0) { const f32x4 g0 = *(const GAS f32x4*)(gq + 16 * d0 + 8 * hi), g1 = *(const GAS f32x4*)(gq + 16 * d0 + 8 * hi + 4);
#pragma unroll
            for (int j = 0; j < 4; ++j) { qf[d0][j] *= rn * g0[j]; qf[d0][4 + j] *= rn * g1[j]; } }
        { const f32x4 c0 = *(const GAS f32x4*)(ROPE + (size_t)qrow * 16 + 8 * hi), c1 = *(const GAS f32x4*)(ROPE + (size_t)qrow * 16 + 8 * hi + 4);
          const f32x4 s0 = *(const GAS f32x4*)(ROPE + (size_t)NT * 16 + (size_t)qrow * 16 + 8 * hi), s1 = *(const GAS f32x4*)(ROPE + (size_t)NT * 16 + (size_t)qrow * 16 + 8 * hi + 4);
#pragma unroll
          for (int j = 0; j < 8; ++j) { const float cs = j < 4 ? c0[j & 3] : c1[j & 3], sn = j < 4 ? s0[j & 3] : s1[j & 3]; const float t1 = qf[4][j], t2 = qf[5][j];
              qf[4][j] = t1 * cs - t2 * sn; qf[5][j] = t1 * sn + t2 * cs; } }
#pragma unroll
        for (int d0 = 0; d0 < 6; ++d0) { u32x4 w; w.x = cvt_pk_bf16(qf[d0][0], qf[d0][1]); w.y = cvt_pk_bf16(qf[d0][2], qf[d0][3]); w.z = cvt_pk_bf16(qf[d0][4], qf[d0][5]); w.w = cvt_pk_bf16(qf[d0][6], qf[d0][7]);
            qr[d0] = __builtin_bit_cast(bf16x8, w); }
    }
    MLA_WRITE(a, 0);
    MLA_LOAD(a, 1);
    __syncthreads();
    float m = 0.f, l = 0.f; f32x16 o[2], negm;
#pragma unroll
    for (int r = 0; r < 16; ++r) { o[0][r] = 0.f; o[1][r] = 0.f; negm[r] = 0.f; }
    const int qabs = q0 + wid * 32 + r32, qmax_w = q0 + wid * 32 + 31;
    const int voff = MLA_KB + ((lane >> 4) & 1) * 32 + (lane & 3) * 8 + (4 * hi + ((lane & 15) >> 2)) * 64;
#define MLA_STEP(t, buf, LS, WS) do { \
        if (!(abl & 4)) bg.tick();                                   \
        if ((t) + 2 < NTL && !(abl & 2)) MLA_LOAD(LS, (t) + 2); \
        if (64 * (t) <= qmax_w && !(abl & 1)) {                      \
            const LAS unsigned char* kb = lds + (buf) * MLA_BUF + hi * 1024 + r32 * 16; \
            bf16x8 kf[12]; \
            _Pragma("unroll") for (int d0 = 0; d0 < 6; ++d0) { kf[2 * d0] = *(const LAS bf16x8*)(kb + d0 * 2048); kf[2 * d0 + 1] = *(const LAS bf16x8*)(kb + d0 * 2048 + 512); } \
            f32x16 p0, p1; \
            __builtin_amdgcn_sched_barrier(0); \
            __builtin_amdgcn_s_setprio(1); \
            p0 = __builtin_amdgcn_mfma_f32_32x32x16_bf16(kf[0], qr[0], negm, 0, 0, 0);     \
            p1 = __builtin_amdgcn_mfma_f32_32x32x16_bf16(kf[1], qr[0], negm, 0, 0, 0); \
            _Pragma("unroll") for (int d0 = 1; d0 < 6; ++d0) { \
                p0 = __builtin_amdgcn_mfma_f32_32x32x16_bf16(kf[2 * d0], qr[d0], p0, 0, 0, 0); \
                p1 = __builtin_amdgcn_mfma_f32_32x32x16_bf16(kf[2 * d0 + 1], qr[d0], p1, 0, 0, 0); } \
            __builtin_amdgcn_s_setprio(0); \
            bf16x8 vf[8]; \
            v_frags(vf, lds + (buf) * MLA_BUF + voff); \
            __builtin_amdgcn_sched_barrier(0); \
            if (64 * (t) + 63 > q0 + wid * 32) {                     \
                _Pragma("unroll") for (int r = 0; r < 16; ++r) { const int kv = 64 * (t) + crow(r, hi); if (kv > qabs) p0[r] = -INFINITY; if (kv + 32 > qabs) p1[r] = -INFINITY; } } \
            u32x4 pw[4]; \
            if (softmax_step(p0, p1, m, l, o, pw, wsf, r32, hi, (t) == 0)) { _Pragma("unroll") for (int r = 0; r < 16; ++r) negm[r] = -m; } \
            __builtin_amdgcn_sched_barrier(0); \
            pv_mma(o, vf, pw); \
        } \
        if ((t) + 1 < NTL && !(abl & 2)) MLA_WRITE(WS, (buf) ^ 1); \
        __syncthreads(); } while (0)
#pragma unroll 1
    for (int t = 0; t < NTL; t += 2) {
        MLA_STEP(t, 0, b, a);
        MLA_STEP(t + 1, 1, a, b);
    }
#undef MLA_STEP
#undef MLA_LOAD
#undef MLA_WRITE
    finish_store(o, l, wsf, r32, hi, OB + (size_t)(rowbase + q0 + wid * 32) * 1024 + h * 64, 1024);
    __syncthreads();
}

struct DilU { int b, h, dil, r, n; };
struct DilStage { u32x4 kk[8], vv[8]; int pk; };
__device__ __forceinline__ void dil_load_k(DilStage& st, const DilU& u, int hw, int lane, const bf16_t* K, const int* pos) {
    if (hw >= ((u.n == 0) ? 2 : 0)) {
        const int rowbase = u.b * SEQ, ci = 64 * hw + lane, tokk = (128 * (u.n - 1) + ci) * u.dil + u.r;
        const bf16_t* kg = K + (size_t)(rowbase + tokk) * 1024 + u.h * 64;
#pragma unroll
        for (int c = 0; c < 8; ++c) st.kk[c] = *(const GAS u32x4*)(kg + c * 8);
        st.pk = pos[rowbase + tokk];
    }
}
__device__ __forceinline__ void dil_load_v(DilStage& st, const DilU& u, int hw, int lane, const bf16_t* V) {
    if (hw >= ((u.n == 0) ? 2 : 0)) {
        const int rowbase = u.b * SEQ;
#pragma unroll
        for (int pc = 0; pc < 8; ++pc) { const int rg = pc & 3, dh = pc >> 2; const int cv = 64 * hw + 16 * rg + (lane >> 2); const int tokv = (128 * (u.n - 1) + cv) * u.dil + u.r;
            st.vv[pc] = *(const GAS u32x4*)(V + (size_t)(rowbase + tokv) * 1024 + u.h * 64 + dh * 32 + (lane & 3) * 8); }
    }
}
__device__ __forceinline__ void dil_write(const DilStage& st, const DilU& u, LAS unsigned char* hl, LAS float* xs, int hw, int lane) {
    if (hw >= ((u.n == 0) ? 2 : 0)) {
#pragma unroll
        for (int c = 0; c < 8; ++c) *(LAS u32x4*)(hl + hw * 8192 + c * 1024 + lane * 16) = st.kk[c];
#pragma unroll
        for (int pc = 0; pc < 8; ++pc) *(LAS u32x4*)(hl + 32768 + hw * 8192 + pc * 1024 + lane * 16) = st.vv[pc];
        xs[64 * hw + lane] = (float)st.pk;
    }
}
struct RingStage { u32x4 d[8]; int pk; };
__device__ __forceinline__ void ring_load(RingStage& st, const DilU& u0, int wv, int lane, const bf16_t* K, const bf16_t* V, const int* pos) {
    const int j = wv >> 1, rowbase = u0.b * SEQ, key0 = 128 * (u0.n + (j >> 1)) + 64 * (j & 1);
    if (!(wv & 1)) {
        const int tok = (key0 + lane) * u0.dil + u0.r;
        const bf16_t* kg = K + (size_t)(rowbase + tok) * 1024 + u0.h * 64;
#pragma unroll
        for (int c = 0; c < 8; ++c) st.d[c] = *(const GAS u32x4*)(kg + c * 8);
        st.pk = pos[rowbase + tok];
    } else {
#pragma unroll
        for (int pc = 0; pc < 8; ++pc) { const int rg = pc & 3, dh = pc >> 2; const int tok = (key0 + 16 * rg + (lane >> 2)) * u0.dil + u0.r;
            st.d[pc] = *(const GAS u32x4*)(V + (size_t)(rowbase + tok) * 1024 + u0.h * 64 + dh * 32 + (lane & 3) * 8); }
    }
}
__device__ __forceinline__ void ring_write(const RingStage& st, const DilU& u0, LAS unsigned char* lds, LAS float* xs, int wv, int lane) {
    const int j = wv >> 1, slot = (u0.n + (j >> 1)) & 3;
    LAS unsigned char* base = lds + slot * 32768 + (j & 1) * 8192 + ((wv & 1) ? 16384 : 0);
#pragma unroll
    for (int c = 0; c < 8; ++c) *(LAS u32x4*)(base + c * 1024 + lane * 16) = st.d[c];
    if (!(wv & 1)) xs[slot * 128 + (j & 1) * 64 + lane] = (float)st.pk;
}
template <bool MERGE, bool RING>
__device__ __forceinline__ void dil_compute(LAS unsigned char* hl, LAS float* xs, int hw, int wv, int lane, const DilU& u, const bf16x8 (&qr)[4], float posq,
                                            bf16_t* PARTg, float* LSEg, const bf16_t* P0, const bf16_t* P1, const float* L0, const float* L1, bf16_t* OB, const int abl = 0) {
    const int b = u.b, h = u.h, dil = u.dil, r = u.r, n = u.n;
    const int r32 = lane & 31, hi = lane >> 5;
    const int rowbase = b * SEQ, first_tile = (n == 0) ? 2 : 0;
    LAS float* wsf = RING ? xs + 512 + wv * 64 : xs + 256 + hw * 64;
    const int a = 32 * hw + r32;
    const int tokq = (128 * n + a) * dil + r;
    const float slope2 = exp2f(-0.5f * (float)(h + 1)) * LOG2E;
    float m = 0.f, l = 0.f; f32x16 o[2], negm;
#pragma unroll
    for (int rr = 0; rr < 16; ++rr) { o[0][rr] = 0.f; o[1][rr] = 0.f; negm[rr] = 0.f; }
    const int tlo = max((32 * hw) >> 6, first_tile), thi = (abl & 1) ? -1 : min((32 * hw + 159) >> 6, 3);
    const int voff = ((lane >> 4) & 1) * 32 + (lane & 3) * 8 + (4 * hi + ((lane & 15) >> 2)) * 64;
#pragma unroll 1
    for (int T = tlo; T <= thi; ++T) {
        const int slot = (n - 1 + (T >> 1)) & 3;
        const int kofs = RING ? slot * 32768 + (T & 1) * 8192 : T * 8192, vofs = RING ? kofs + 16384 : 32768 + T * 8192;
        const LAS float* posk = RING ? xs + slot * 128 + (T & 1) * 64 : xs + 64 * T;
        const LAS unsigned char* kb = hl + kofs + hi * 1024 + r32 * 16;
        bf16x8 kf[8];
#pragma unroll
        for (int d0 = 0; d0 < 4; ++d0) { kf[2 * d0] = *(const LAS bf16x8*)(kb + d0 * 2048); kf[2 * d0 + 1] = *(const LAS bf16x8*)(kb + d0 * 2048 + 512); }
        f32x16 p0, p1;
        __builtin_amdgcn_sched_barrier(0);
        __builtin_amdgcn_s_setprio(1);
        p0 = __builtin_amdgcn_mfma_f32_32x32x16_bf16(kf[0], qr[0], negm, 0, 0, 0);
        p1 = __builtin_amdgcn_mfma_f32_32x32x16_bf16(kf[1], qr[0], negm, 0, 0, 0);
#pragma unroll
        for (int d0 = 1; d0 < 4; ++d0) {
            p0 = __builtin_amdgcn_mfma_f32_32x32x16_bf16(kf[2 * d0], qr[d0], p0, 0, 0, 0);
            p1 = __builtin_amdgcn_mfma_f32_32x32x16_bf16(kf[2 * d0 + 1], qr[d0], p1, 0, 0, 0);
        }
        __builtin_amdgcn_s_setprio(0);
        bf16x8 vf0[4];
        v_frags_half(vf0, hl + vofs + voff, 0);
        __builtin_amdgcn_sched_barrier(0);
#pragma unroll
        for (int g = 0; g < 4; ++g) { const f32x4 pa = *(const LAS f32x4*)(posk + 8 * g + 4 * hi), pb = *(const LAS f32x4*)(posk + 32 + 8 * g + 4 * hi);
#pragma unroll
            for (int j = 0; j < 4; ++j) { p0[4 * g + j] += slope2 * (pa[j] - posq); p1[4 * g + j] += slope2 * (pb[j] - posq); } }
        if (64 * T < 32 * hw + 31 || 64 * T + 63 > 32 * hw + 128) {
#pragma unroll
            for (int rr = 0; rr < 16; ++rr) { const int c0 = 64 * T + crow(rr, hi), c1 = c0 + 32;
                if (c0 < a || c0 > a + 128) p0[rr] = -INFINITY;
                if (c1 < a || c1 > a + 128) p1[rr] = -INFINITY; }
        }
        u32x4 pw[4];
        if (softmax_step(p0, p1, m, l, o, pw, wsf, r32, hi, T == tlo)) {
#pragma unroll
            for (int rr = 0; rr < 16; ++rr) negm[rr] = -m; }
        bf16x8 vf1[4];
        v_frags_half(vf1, hl + vofs + voff, 1);
        __builtin_amdgcn_sched_barrier(0);
        pv_mma_half(o[0], vf0, pw);
        pv_mma_half(o[1], vf1, pw);
    }
    l = sum_x32(l);
    int r32e = r32, hie = hi; asm volatile("" : "+v"(r32e), "+v"(hie));
    const int tokqe = (128 * n + 32 * hw + r32e) * dil + r;
    if (!MERGE) {
        if (hie == 0) { wsf[32 + r32e] = l; LSEg[(size_t)(rowbase + tokqe) * 16 + h] = m + log2f(l); }
        asm volatile("s_waitcnt lgkmcnt(0)" ::: "memory");
#pragma unroll
        for (int g = 0; g < 4; ++g) { const f32x4 lv = *(const LAS f32x4*)(wsf + 32 + 8 * g + 4 * hie);
#pragma unroll
            for (int j = 0; j < 4; ++j) { const float rl = __builtin_amdgcn_rcpf(lv[j]); const int tok = (128 * n + 32 * hw + 8 * g + 4 * hie + j) * dil + r;
                bf16_t* op = PARTg + (size_t)(rowbase + tok) * 1024 + h * 64 + r32e;
                op[0] = f2bf(o[0][4 * g + j] * rl); op[32] = f2bf(o[1][4 * g + j] * rl); } }
    } else {
        if (hie == 0) { wsf[32 + r32e] = l; wsf[r32e] = m + log2f(l); }
        asm volatile("s_waitcnt lgkmcnt(0)" ::: "memory");
#pragma unroll
        for (int g = 0; g < 4; ++g) {
            float e0[4], e1[4]; bf16_t a0[4], a1[4], b0[4], b1[4];
#pragma unroll
            for (int j = 0; j < 4; ++j) { const int tok = (128 * n + 32 * hw + 8 * g + 4 * hie + j) * dil + r; const size_t rw = (size_t)(rowbase + tok), off = rw * 1024 + h * 64 + r32e;
                e0[j] = L0[rw * 16 + h]; e1[j] = L1[rw * 16 + h]; a0[j] = P0[off]; a1[j] = P0[off + 32]; b0[j] = P1[off]; b1[j] = P1[off + 32]; }
            const f32x4 lv = *(const LAS f32x4*)(wsf + 32 + 8 * g + 4 * hie), ls2 = *(const LAS f32x4*)(wsf + 8 * g + 4 * hie);
#pragma unroll
            for (int j = 0; j < 4; ++j) { const int rr = 4 * g + j; const int tok = (128 * n + 32 * hw + 8 * g + 4 * hie + j) * dil + r; const size_t rw = (size_t)(rowbase + tok);
                const float e2 = ls2[j];
                const float M = fmaxf(fmaxf(e0[j], e1[j]), e2); const float w0 = exp2f(e0[j] - M), w1 = exp2f(e1[j] - M), w2 = exp2f(e2 - M);
                const float rden = __builtin_amdgcn_rcpf(w0 + w1 + w2), w2l = w2 * __builtin_amdgcn_rcpf(lv[j]);
                const size_t off = rw * 1024 + h * 64 + r32e;
                OB[off] = f2bf((w0 * bf2f(a0[j]) + w1 * bf2f(b0[j]) + w2l * o[0][rr]) * rden); OB[off + 32] = f2bf((w0 * bf2f(a1[j]) + w1 * bf2f(b1[j]) + w2l * o[1][rr]) * rden); }
        }
    }
}
}

namespace mk {
constexpr int NWAVES = 8, NTHREADS = 512;
constexpr int RING_BYTES = 131072, LDSCTL_OFF = RING_BYTES, MISC_OFF = LDSCTL_OFF + 2048;
constexpr int XS_OFF = RING_BYTES + 4096;
constexpr int LDS_BYTES = RING_BYTES + 4096 + 4096;
constexpr int CW_BAR = 4096;
constexpr int NPHASE = 19;

struct Args {
    const float* in[30]; float* out; unsigned char* ws; int ph_lo, ph_hi;
};

__device__ __forceinline__ float wave_sum(float v) { return wave_sum_all(v); }

struct TItem { const float* W; int ldw, k0, srccol0; bf16_t* WT; bf16_t* lo; int Kd, dstrow0, spread; const float* ks; };
__device__ __forceinline__ void titem_load(const TItem& it, f32x4 (&v)[8], int lane) {
    const int c = lane & 7, coff = it.spread ? 16 * (c >> 1) + 4 * (c & 1) : 4 * c;
#pragma unroll
    for (int i = 0; i < 8; ++i) v[i] = __builtin_nontemporal_load((const GAS f32x4*)(it.W + (size_t)(it.k0 + 8 * i + (lane >> 3)) * it.ldw + it.srccol0 + coff));
}
__device__ __forceinline__ void titem_finish(const TItem& it, const f32x4 (&v)[8], LAS float* scr, int lane) {
#pragma unroll
    for (int i = 0; i < 8; ++i) { LAS float* d = scr + (8 * i + (lane >> 3)) * 33 + 4 * (lane & 7); d[0] = v[i].x; d[1] = v[i].y; d[2] = v[i].z; d[3] = v[i].w; }
    asm volatile("s_waitcnt lgkmcnt(0)" ::: "memory");
    const int c = lane & 7;
#pragma unroll
    for (int j = 0; j < 4; ++j) { const int n = (lane >> 3) + 8 * j; const LAS float* sp = scr + (8 * c) * 33 + n;
        float f[8];
#pragma unroll
        for (int q = 0; q < 8; ++q) f[q] = sp[q * 33];
        if (it.ks) { const f32x4 s0 = *(const GAS f32x4*)(it.ks + it.k0 + 8 * c), s1 = *(const GAS f32x4*)(it.ks + it.k0 + 8 * c + 4);
            f[0] *= s0.x; f[1] *= s0.y; f[2] *= s0.z; f[3] *= s0.w; f[4] *= s1.x; f[5] *= s1.y; f[6] *= s1.z; f[7] *= s1.w; }
        u32x4 o; o.x = pk2(f[0], f[1]); o.y = pk2(f[2], f[3]); o.z = pk2(f[4], f[5]); o.w = pk2(f[6], f[7]);
        __builtin_nontemporal_store(o, (GAS u32x4*)(it.WT + (size_t)(it.dstrow0 + n) * it.Kd + it.k0 + 8 * c));
        if (it.lo) {
            float rs[8];
#pragma unroll
            for (int q = 0; q < 8; ++q) rs[q] = f[q] - bf2f(f2bf(f[q]));
            u32x4 ol; ol.x = pk2(rs[0], rs[1]); ol.y = pk2(rs[2], rs[3]); ol.z = pk2(rs[4], rs[5]); ol.w = pk2(rs[6], rs[7]);
            *(GAS u32x4*)(it.lo + (size_t)(it.dstrow0 + n) * it.Kd + it.k0 + 8 * c) = ol;
        }
    }
    asm volatile("s_waitcnt lgkmcnt(0)" ::: "memory");
}

__device__ __forceinline__ int hpw_src_block(int db) { const int pn = db >> 3, q = db & 7, bj = q >> 2, wc = q & 3; return (4 * pn + wc) * 2 + bj; }

__device__ __forceinline__ int opaque(int v) { asm volatile("" : "+v"(v)); return v; }
struct Ctx {
    LAS unsigned char* lds; int tid, lane, wave, G, vcu;
    unsigned char* ws; const float* const* in; float* out;
};
template <class T> __device__ __forceinline__ T* opaque_uniform_ptr(T* p) {
    const unsigned long long u = (unsigned long long)p;
    unsigned lo = __builtin_amdgcn_readfirstlane((unsigned)u), hi = __builtin_amdgcn_readfirstlane((unsigned)(u >> 32));
    asm volatile("" : "+s"(lo), "+s"(hi));
    return (T*)(((unsigned long long)hi << 32) | lo);
}
__device__ __forceinline__ Ctx phase_ctx(const Ctx& F0) {
    Ctx F = F0; F.lane = opaque(F0.lane); F.tid = opaque(F0.tid);
    F.ws = opaque_uniform_ptr(F0.ws); F.out = opaque_uniform_ptr(F0.out); return F;
}

constexpr int I_QKV = 16 * 96, I_O = 16 * 32, I_KVD = 0, I_DQ = 0  , I_UK = 4 * 32, I_UQ = 6 * 48, I_R = 2 * 16 * 2;
constexpr int I_GU1 = 16 * 16, I_DN1 = 4 * 32, I_GUL = 65 * I_GU1, I_DNL = 65 * I_DN1, I_MOEL = I_GUL + I_DNL;
constexpr int NITEMS_P0 = I_MOEL + I_QKV + 2 * I_O + I_KVD + I_DQ + 2 * I_UK + I_UQ + I_R;
__device__ __forceinline__ TItem decode_item(const Ctx& F, int it, int l) {
    bf16_t* Wqkv = (bf16_t*)(F.ws + WS_WQKV); bf16_t* Wo0 = (bf16_t*)(F.ws + WS_WO0); bf16_t* Wo1 = (bf16_t*)(F.ws + WS_WO1);
    bf16_t* Wkvd = (bf16_t*)(F.ws + WS_WKVD); bf16_t* Wdq = (bf16_t*)(F.ws + WS_WDQ); bf16_t* Wukv = (bf16_t*)(F.ws + WS_WUKV); bf16_t* Wuq = (bf16_t*)(F.ws + WS_WUQ);
    bf16_t* Wr = (bf16_t*)(F.ws + WS_WR); bf16_t* Wgu = (bf16_t*)(F.ws + WS_WGU); bf16_t* Wdn = (bf16_t*)(F.ws + WS_WDN);
    TItem t; t.lo = nullptr; t.spread = 0; t.ks = nullptr;
    int r = it;
    if (r < I_GUL) {
        const int e = r / I_GU1, rr = r % I_GU1, kb = rr >> 4, db = rr & 15, tl = db >> 3, q = db & 7, sb = (q >> 2) * 8 + tl * 4 + (q & 3), le = l * 65 + e;
        t.W = (e < 64) ? F.in[26] + ((size_t)l * 64 + e) * 1024 * 512 : F.in[28] + (size_t)l * 1024 * 512;
        t.ldw = 512; t.k0 = kb * 64; t.srccol0 = sb * 32; t.WT = Wgu + (size_t)le * 512 * 1024; t.Kd = 1024; t.dstrow0 = db * 32; return t; }
    r -= I_GUL;
    if (r < I_DNL) {
        const int e = r / I_DN1, rr = r % I_DN1, kb = rr >> 5, db = rr & 31, le = l * 65 + e;
        t.W = (e < 64) ? F.in[27] + ((size_t)l * 64 + e) * 256 * 1024 : F.in[29] + (size_t)l * 256 * 1024;
        { const int pn = db >> 3, q = db & 7, bj = q >> 2, wc = q & 3; t.srccol0 = pn * 256 + 64 * wc + 8 * bj; t.spread = 1; }
        t.ldw = 1024; t.k0 = kb * 64; t.WT = Wdn + (size_t)le * 1024 * 256; t.Kd = 256; t.dstrow0 = db * 32; return t; }
    r -= I_DNL;
    if (r < I_QKV) { const int kb = r / 96, db = r % 96, sct = db >> 5; t.W = F.in[7]; t.ldw = 3072; t.k0 = kb * 64; t.srccol0 = (sct * 32 + hpw_src_block(db & 31)) * 32; t.WT = Wqkv; t.Kd = 1024; t.dstrow0 = db * 32; return t; }
    r -= I_QKV;
    if (r < 2 * I_O) { const int w = r / I_O, rr = r % I_O, kb = rr >> 5, db = rr & 31; t.W = w ? F.in[23] : F.in[10]; t.ldw = 1024; t.k0 = kb * 64; t.srccol0 = db * 32; t.WT = w ? Wo1 : Wo0; t.Kd = 1024; t.dstrow0 = db * 32; return t; }
    r -= 2 * I_O;
    if (r < I_KVD) { const int kb = r / 9, db = r % 9; t.W = F.in[14]; t.ldw = 288; t.k0 = kb * 64; t.srccol0 = db * 32; t.WT = Wkvd; t.Kd = 1024; t.dstrow0 = db * 32; return t; }
    r -= I_KVD;
    if (r < I_DQ) { const int kb = r / 12, db = r % 12; t.W = F.in[19]; t.ldw = 384; t.k0 = kb * 64; t.srccol0 = db * 32; t.WT = Wdq; t.Kd = 1024; t.dstrow0 = db * 32; return t; }
    r -= I_DQ;
    if (r < 2 * I_UK) { const int w = r / I_UK, rr = r % I_UK, kb = rr >> 5, db = rr & 31; t.W = w ? F.in[17] : F.in[16]; t.ldw = 1024; t.k0 = kb * 64; t.srccol0 = hpw_src_block(db) * 32; t.WT = Wukv; t.Kd = 256; t.dstrow0 = w * 1024 + db * 32; t.ks = F.in[15]; return t; }
    r -= 2 * I_UK;
    if (r < I_UQ) { const int kb = r / 48, db = r % 48; t.W = F.in[21]; t.ldw = 1536; t.k0 = kb * 64; t.srccol0 = db * 32; t.WT = Wuq; t.Kd = 384; t.dstrow0 = db * 32; t.ks = F.in[20]; return t; }
    r -= I_UQ;
    { const int l = r >> 5, rr = r & 31, kb = rr >> 1, db = rr & 1;
      t.W = F.in[24] + (size_t)l * 1024 * 64; t.ldw = 64; t.k0 = kb * 64; t.srccol0 = db * 32; t.WT = Wr + (size_t)(l * 2 + 0) * 64 * 1024; t.lo = Wr + (size_t)(l * 2 + 1) * 64 * 1024; t.Kd = 1024; t.dstrow0 = db * 32; return t; }
}


struct BgConv {
    Ctx F; int l, idx, end, stride, cnt, base; bool pend; LAS float* scr; TItem it; f32x4 v[8];
    static constexpr int BG_PERIOD = 2;
    __device__ __forceinline__ void init(const Ctx& F_, int l_, int first, int end_, int stride_, LAS float* scr_) { F = F_; l = l_; idx = first; end = end_; stride = stride_; cnt = 0; base = 0; pend = false; scr = scr_; }
    __device__ __forceinline__ void tick() {
        if (++cnt < BG_PERIOD) return;
        cnt = 0;
        if (pend) { titem_finish(it, v, scr, F.lane); pend = false; }
        if (idx < end) { it = decode_item(F, base + idx, l); titem_load(it, v, F.lane); pend = true; idx += stride; }
    }
    __device__ __forceinline__ void step() {
        if (pend) { titem_finish(it, v, scr, F.lane); pend = false; }
        if (idx < end) { it = decode_item(F, base + idx, l); titem_load(it, v, F.lane); pend = true; idx += stride; }
    }
    __device__ __forceinline__ void drain() {
        for (;;) {
            if (pend) { titem_finish(it, v, scr, F.lane); pend = false; }
            if (idx >= end) break;
            it = decode_item(F, base + idx, l); titem_load(it, v, F.lane); pend = true; idx += stride;
        }
    }
};
struct BgNone { __device__ __forceinline__ void tick() {} };

__device__ __forceinline__ void phase_prologue(const Ctx& F0) {
    const Ctx F = phase_ctx(F0);
    LAS float* sc = (LAS float*)(F.lds + 8 * 16384 - 32768);
    LAS int* qctl = (LAS int*)(F.lds + XS_OFF);
    const float* c = F.in[1];
    if (F.tid < 3) qctl[F.tid] = 0;
    for (int i = F.tid; i < 8 * 1024; i += NTHREADS) { const float cv = c[i]; sc[i] = cv / (1.f + expf(-cv)); }
    __syncthreads();
    float* MOD = (float*)(F.ws + WS_MOD);
    LAS float* red = (LAS float*)(F.lds + 67584);
    if (F.wave < 4) {
        int seq = 0;
        for (int task = F.vcu; task < MODW / 64; task += F.G) {
            ++seq;
            const int j = task * 64 + F.lane;
            const float* W; int nc, jj; float bias;
            if (j < 12288) { const int l = j / 6144; jj = j % 6144; W = F.in[3] + (size_t)l * 1024 * 6144; nc = 6144; bias = F.in[4][l * 6144 + jj]; }
            else { jj = j - 12288; W = F.in[11]; nc = 2048; bias = F.in[12][jj]; }
            float acc[8];
#pragma unroll
            for (int b = 0; b < 8; ++b) acc[b] = 0.f;
            const int kbeg = F.wave * 256;
#pragma unroll 1
            for (int k0 = kbeg; k0 < kbeg + 256; k0 += 16) {
                float w[16];
#pragma unroll
                for (int q = 0; q < 16; ++q) w[q] = __builtin_nontemporal_load(W + (size_t)(k0 + q) * nc + jj);
#pragma unroll
                for (int q4 = 0; q4 < 4; ++q4)
#pragma unroll
                    for (int b = 0; b < 8; ++b) { const f32x4 s4 = *(const LAS f32x4*)(sc + b * 1024 + k0 + 4 * q4);
                        acc[b] += s4.x * w[4 * q4]; acc[b] += s4.y * w[4 * q4 + 1]; acc[b] += s4.z * w[4 * q4 + 2]; acc[b] += s4.w * w[4 * q4 + 3]; }
            }
            if (F.wave != 0) {
                while (__hip_atomic_load(qctl + 2, __ATOMIC_RELAXED, __HIP_MEMORY_SCOPE_WORKGROUP) != seq - 1) __builtin_amdgcn_s_sleep(2);
#pragma unroll
                for (int b = 0; b < 8; ++b) red[((F.wave - 1) * 8 + b) * 64 + F.lane] = acc[b];
                asm volatile("s_waitcnt lgkmcnt(0)" ::: "memory");
                if (F.lane == 0) __hip_atomic_fetch_add(qctl + 1, 1, __ATOMIC_RELEASE, __HIP_MEMORY_SCOPE_WORKGROUP);
            } else {
                while (__hip_atomic_load(qctl + 1, __ATOMIC_ACQUIRE, __HIP_MEMORY_SCOPE_WORKGROUP) != 3 * seq) __builtin_amdgcn_s_sleep(2);
#pragma unroll
                for (int b = 0; b < 8; ++b) __hip_atomic_store(MOD + b * MODW + j, (((acc[b] + red[(0 * 8 + b) * 64 + F.lane]) + red[(1 * 8 + b) * 64 + F.lane]) + red[(2 * 8 + b) * 64 + F.lane]) + bias, __ATOMIC_RELAXED, __HIP_MEMORY_SCOPE_AGENT);
                asm volatile("s_waitcnt vmcnt(0) lgkmcnt(0)" ::: "memory");
                if (F.lane == 0) { __hip_atomic_store(qctl + 2, seq, __ATOMIC_RELEASE, __HIP_MEMORY_SCOPE_WORKGROUP);
                    __hip_atomic_fetch_add((unsigned*)(F.ws + WS_CTL) + CW_MODCNT, 1u, __ATOMIC_RELAXED, __HIP_MEMORY_SCOPE_AGENT); }
            }
        }
    }
    LAS float* scr = (LAS float*)(F.lds + F.wave * 8448);
    {
        constexpr int NITEMS = NITEMS_P0 - I_DNL;
#define P0_IDX(i) ((i) < I_GUL ? (i) : (i) + I_DNL)
#define P0_GRAB(dst) do { int s_ = 0; if (F.lane == 0) s_ = __hip_atomic_fetch_add(qctl, 1, __ATOMIC_RELAXED, __HIP_MEMORY_SCOPE_WORKGROUP); s_ = __builtin_amdgcn_readfirstlane(s_); dst = (F.vcu + (s_ >> 3) * F.G) * 8 + (s_ & 7); } while (0)
        f32x4 va[8], vb[8]; TItem ta, tb;
        int it; P0_GRAB(it);
        if (it < NITEMS) { ta = decode_item(F, P0_IDX(it), 0); titem_load(ta, va, F.lane); }
        while (it < NITEMS) {
            int itn; P0_GRAB(itn);
            if (itn < NITEMS) { tb = decode_item(F, P0_IDX(itn), 0); titem_load(tb, vb, F.lane); }
            titem_finish(ta, va, scr, F.lane);
            if (itn >= NITEMS) break;
            int itn2; P0_GRAB(itn2);
            if (itn2 < NITEMS) { ta = decode_item(F, P0_IDX(itn2), 0); titem_load(ta, va, F.lane); }
            titem_finish(tb, vb, scr, F.lane);
            it = itn2;
        }
#undef P0_GRAB
    }
}

__device__ __forceinline__ void modnorm_row(const float* xrow, const float* g, const float* sc, const float* sh, bf16_t* orow, int lane) {
    const GAS f32x4* xr = (const GAS f32x4*)xrow + lane;
    f32x4 v[4]; float s2 = 0.f;
#pragma unroll
    for (int j = 0; j < 4; ++j) { v[j] = xr[64 * j]; s2 += (v[j].x * v[j].x + v[j].y * v[j].y) + (v[j].z * v[j].z + v[j].w * v[j].w); }
    const float rstd = rsqrtf(wave_sum(s2) * (1.f / 1024.f) + EPS);
    GAS u32x2* o8 = (GAS u32x2*)orow + lane;
#pragma unroll
    for (int j = 0; j < 4; ++j) {
        const f32x4 gg = ((const GAS f32x4*)g)[lane + 64 * j], ss = ((const GAS f32x4*)sc)[lane + 64 * j], hh = ((const GAS f32x4*)sh)[lane + 64 * j];
        const f32x4 o = v[j] * rstd * gg * (ss + 1.f) + hh;
        u32x2 w; w.x = pk2(o.x, o.y); w.y = pk2(o.z, o.w); o8[64 * j] = w;
    }
}
constexpr int I_FOLD1 = 16 * 9 + 16 * 12, I_FOLD = 8 * I_FOLD1;
__device__ __forceinline__ float sum8(float v) { v += dppf(v, 0); v += dppf(v, 1); return v + dppf(v, 2); }
__device__ __forceinline__ void fold_item(const Ctx& F, int idx, LAS float* scr) {
    const int lane = F.lane, b = idx / I_FOLD1; int r = idx % I_FOLD1;
    const float* MOD = (const float*)(F.ws + WS_MOD) + b * MODW;
    int w, kb, db, ldw; const float *W, *sg, *ssc, *ssh;
    if (r < 144) { w = 0; kb = r / 9; db = r % 9; W = F.in[14]; ldw = 288; sg = F.in[13]; ssc = MOD + 12288 + 1024; ssh = MOD + 12288; }
    else { r -= 144; w = 1; kb = r / 12; db = r % 12; W = F.in[19]; ldw = 384; sg = F.in[5] + 1024; ssc = MOD + 6144 + 1024; ssh = MOD + 6144; }
    const int k0 = kb * 64, c = lane & 7;
    f32x4 v[8];
#pragma unroll
    for (int i = 0; i < 8; ++i) v[i] = *(const GAS f32x4*)(W + (size_t)(k0 + 8 * i + (lane >> 3)) * ldw + db * 32 + 4 * c);
    float A[8], H[8];
    { const f32x4 g0 = *(const GAS f32x4*)(sg + k0 + 8 * c), g1 = *(const GAS f32x4*)(sg + k0 + 8 * c + 4), s0 = *(const GAS f32x4*)(ssc + k0 + 8 * c), s1 = *(const GAS f32x4*)(ssc + k0 + 8 * c + 4);
      const f32x4 h0 = *(const GAS f32x4*)(ssh + k0 + 8 * c), h1 = *(const GAS f32x4*)(ssh + k0 + 8 * c + 4);
      const f32x4 a0 = g0 * (s0 + 1.f), a1 = g1 * (s1 + 1.f);
      A[0] = a0.x; A[1] = a0.y; A[2] = a0.z; A[3] = a0.w; A[4] = a1.x; A[5] = a1.y; A[6] = a1.z; A[7] = a1.w;
      H[0] = h0.x; H[1] = h0.y; H[2] = h0.z; H[3] = h0.w; H[4] = h1.x; H[5] = h1.y; H[6] = h1.z; H[7] = h1.w; }
#pragma unroll
    for (int i = 0; i < 8; ++i) { LAS float* d = scr + (8 * i + (lane >> 3)) * 33 + 4 * c; d[0] = v[i].x; d[1] = v[i].y; d[2] = v[i].z; d[3] = v[i].w; }
    asm volatile("s_waitcnt lgkmcnt(0)" ::: "memory");
    bf16_t* WT = (bf16_t*)(F.ws + WS_W8) + (size_t)(w * 8 + b) * 512 * 1024;
    float* PB = (float*)(F.ws + WS_PB) + ((size_t)((b * 2 + w) * 16 + kb)) * 512 + db * 32;
#pragma unroll
    for (int j = 0; j < 4; ++j) { const int n = (lane >> 3) + 8 * j; const LAS float* sp = scr + (8 * c) * 33 + n;
        float f[8];
#pragma unroll
        for (int q = 0; q < 8; ++q) f[q] = sp[q * 33];
        float pb = 0.f;
#pragma unroll
        for (int q = 0; q < 8; ++q) { pb += f[q] * H[q]; f[q] *= A[q]; }
        u32x4 o; o.x = pk2(f[0], f[1]); o.y = pk2(f[2], f[3]); o.z = pk2(f[4], f[5]); o.w = pk2(f[6], f[7]);
        *(GAS u32x4*)(WT + (size_t)(db * 32 + n) * 1024 + k0 + 8 * c) = o;
        pb = sum8(pb);
        if (c == 0) PB[n] = pb;
    }
    asm volatile("s_waitcnt lgkmcnt(0)" ::: "memory");
}

__device__ __forceinline__ void phase_norm1(const Ctx& F0) {
    const Ctx F = phase_ctx(F0);
    {
        __syncthreads();
        if (F.tid == 0) { unsigned* cnt = (unsigned*)(F.ws + WS_CTL) + CW_MODCNT; unsigned sp = 0;
            while (__hip_atomic_load(cnt, __ATOMIC_RELAXED, __HIP_MEMORY_SCOPE_AGENT) < (unsigned)(MODW / 64)) { __builtin_amdgcn_s_sleep(4); if (++sp > (1u << 20)) break; }
            __builtin_amdgcn_fence(__ATOMIC_ACQUIRE, "agent"); asm volatile("s_waitcnt vmcnt(0)" ::: "memory"); }
        __syncthreads();
    }
    const int gw = F.vcu * NWAVES + F.wave, NGW = F.G * NWAVES, lane = F.lane;
    const float* MOD = (const float*)(F.ws + WS_MOD);
    bf16_t* XN = (bf16_t*)(F.ws + WS_XN);
    const float* x = F.in[0]; const float* g = F.in[5];
    for (int idx = gw; idx < I_FOLD; idx += NGW) fold_item(F, idx, (LAS float*)(F.lds + F.wave * 8448));
    for (int base = gw * 8; base < NT; base += NGW * 8) {
        const int b = base / SEQ;
        const float* sc = MOD + b * MODW + 1024; const float* sh = MOD + b * MODW;
        f32x4 Aw[4], Bw[4];
#pragma unroll
        for (int q = 0; q < 4; ++q) { const int c0 = 16 * lane + 4 * q;
            const f32x4 gg = *(const GAS f32x4*)(g + c0), ss = *(const GAS f32x4*)(sc + c0);
            Aw[q] = gg * (ss + 1.f); Bw[q] = *(const GAS f32x4*)(sh + c0); }
        f32x4 v[4];
#pragma unroll
        for (int q = 0; q < 4; ++q) v[q] = *(const GAS f32x4*)(x + (size_t)base * 1024 + 16 * lane + 4 * q);
#pragma unroll 1
        for (int ti = 0; ti < 8; ++ti) {
            const int m = base + ti, mn = ti < 7 ? m + 1 : m;
            f32x4 vn[4];
#pragma unroll
            for (int q = 0; q < 4; ++q) vn[q] = *(const GAS f32x4*)(x + (size_t)mn * 1024 + 16 * lane + 4 * q);
            float s2 = 0.f;
#pragma unroll
            for (int q = 0; q < 4; ++q) s2 += (v[q].x * v[q].x + v[q].y * v[q].y) + (v[q].z * v[q].z + v[q].w * v[q].w);
            const float rstd = rsqrtf(wave_sum(s2) * (1.f / 1024.f) + EPS);
            unsigned wq[8];
#pragma unroll
            for (int q = 0; q < 4; ++q) { const f32x4 o = v[q] * rstd * Aw[q] + Bw[q]; wq[2 * q] = pk2(o.x, o.y); wq[2 * q + 1] = pk2(o.z, o.w); }
            u32x4 w0, w1; w0.x = wq[0]; w0.y = wq[1]; w0.z = wq[2]; w0.w = wq[3]; w1.x = wq[4]; w1.y = wq[5]; w1.z = wq[6]; w1.w = wq[7];
            bf16_t* o = XN + (size_t)m * 1024 + 16 * lane;
            *(GAS u32x4*)(o) = w0; *(GAS u32x4*)(o + 8) = w1;
#pragma unroll
            for (int q = 0; q < 4; ++q) v[q] = vn[q];
        }
    }
}


__device__ __forceinline__ void load_tables(const Ctx& F0, int l) {
    const Ctx F = phase_ctx(F0);
    LAS int* tab = (LAS int*)(F.lds + LDSCTL_OFF);
    const int* ctl = (const int*)(F.ws + WS_CTL);
    __syncthreads();
    if (F.wave == 0) {
        const int c = ctl[CW_ECNTF + 128 * l + F.lane];
        const int pc = ((c + 255) >> 8) << 8;
        tab[256 + F.lane] = pc; tab[128 + F.lane] = c;
        asm volatile("s_waitcnt lgkmcnt(0)" ::: "memory");
        int x = 0;
        for (int j = 0; j < 64; ++j) { const int y = tab[256 + j]; if (j < F.lane) x += y; }
        tab[F.lane] = x; if (F.lane == 63) tab[64] = x + pc;
    }
    __syncthreads();
}

__device__ __forceinline__ void phase_route(const Ctx& F0, int l, const bf16_t* X) {
    const Ctx F = phase_ctx(F0);
    const float* MOD = (const float*)(F.ws + WS_MOD);
    const float* g = F.in[6] + l * 1024; const float* rb = F.in[25] + l * 64;
    bf16_t* XN = (bf16_t*)(F.ws + WS_XN);
    const bf16_t* Whi = (const bf16_t*)(F.ws + WS_WR) + (size_t)(l * 2) * 64 * 1024; const bf16_t* Wlo = Whi + 64 * 1024;
    int* TOPI = (int*)(F.ws + WS_TOPI); float* TOPW = (float*)(F.ws + WS_TOPW); int* LP = (int*)(F.ws + WS_PPOS); int* LT2 = (int*)(F.ws + WS_LT2);
    unsigned* ecnt = (unsigned*)(F.ws + WS_CTL) + CW_ECNTF + 128 * l;
    LAS float* part = (LAS float*)(F.lds);
    LAS int* hist = (LAS int*)(F.lds + 65536); LAS int* gbase = (LAS int*)(F.lds + 65536 + 256);
    const int lane = F.lane;
    for (int bt = F.vcu; bt < NT / 64; bt += F.G) {
        if (F.tid < 64) hist[F.tid] = 0;
        const int tokb = bt * 64, tok0 = tokb + F.wave * 8, b = tok0 / SEQ;
        const float* sc = MOD + b * MODW + l * 6144 + 4096; const float* sh = MOD + b * MODW + l * 6144 + 3072;
        {
            f32x4 Aw[4], Bw[4];
#pragma unroll
            for (int q = 0; q < 4; ++q) { const int c0 = 16 * lane + 4 * q;
                const f32x4 gg = *(const GAS f32x4*)(g + c0), ss = *(const GAS f32x4*)(sc + c0);
                Aw[q] = gg * (ss + 1.f); Bw[q] = *(const GAS f32x4*)(sh + c0); }
            u32x4 xa = *(const GAS u32x4*)(X + (size_t)tok0 * 1024 + 16 * lane), xb = *(const GAS u32x4*)(X + (size_t)tok0 * 1024 + 16 * lane + 8);
#pragma unroll 1
            for (int ti = 0; ti < 8; ++ti) {
                const int tok = tok0 + ti, tokn = ti < 7 ? tok + 1 : tok;
                const u32x4 xan = *(const GAS u32x4*)(X + (size_t)tokn * 1024 + 16 * lane), xbn = *(const GAS u32x4*)(X + (size_t)tokn * 1024 + 16 * lane + 8);
                const unsigned xw[8] = {xa.x, xa.y, xa.z, xa.w, xb.x, xb.y, xb.z, xb.w};
                f32x4 v[4]; float s2 = 0.f;
#pragma unroll
                for (int q = 0; q < 4; ++q) { v[q] = (f32x4){__uint_as_float(xw[2 * q] << 16), __uint_as_float(xw[2 * q] & 0xffff0000u), __uint_as_float(xw[2 * q + 1] << 16), __uint_as_float(xw[2 * q + 1] & 0xffff0000u)};
                    s2 += (v[q].x * v[q].x + v[q].y * v[q].y) + (v[q].z * v[q].z + v[q].w * v[q].w); }
                const float rstd = rsqrtf(wave_sum(s2) * (1.f / 1024.f) + EPS);
                unsigned wq[8];
#pragma unroll
                for (int q = 0; q < 4; ++q) { const f32x4 o = v[q] * rstd * Aw[q] + Bw[q]; wq[2 * q] = pk2(o.x, o.y); wq[2 * q + 1] = pk2(o.z, o.w); }
                u32x4 w0, w1; w0.x = wq[0]; w0.y = wq[1]; w0.z = wq[2]; w0.w = wq[3]; w1.x = wq[4]; w1.y = wq[5]; w1.z = wq[6]; w1.w = wq[7];
                bf16_t* o = XN + (size_t)tok * 1024 + 16 * lane;
                *(GAS u32x4*)(o) = w0; *(GAS u32x4*)(o + 8) = w1;
                xa = xan; xb = xbn;
            }
        }
        asm volatile("s_waitcnt vmcnt(0)" ::: "memory");
        __syncthreads();
        {
            const int ksl = F.wave & 3, th = F.wave >> 2;
            f32x4 acc[2][4];
#pragma unroll
            for (int tt = 0; tt < 2; ++tt)
#pragma unroll
                for (int et = 0; et < 4; ++et) acc[tt][et] = (f32x4){0.f, 0.f, 0.f, 0.f};
            const size_t aoffs = (size_t)(tokb + th * 32 + (lane & 15)) * 1024 + ksl * 256 + 8 * (lane >> 4);
            const size_t boffs = (size_t)(lane & 15) * 1024 + ksl * 256 + 8 * (lane >> 4);
#pragma unroll 2
            for (int ks = 0; ks < 8; ++ks) {
                bf16x8 ah[2];
#pragma unroll
                for (int tt = 0; tt < 2; ++tt) ah[tt] = *(const GAS bf16x8*)(XN + aoffs + (size_t)tt * 16 * 1024 + ks * 32);
#pragma unroll
                for (int et = 0; et < 4; ++et) {
                    const bf16x8 bh = *(const GAS bf16x8*)(Whi + boffs + (size_t)et * 16 * 1024 + ks * 32), bl = *(const GAS bf16x8*)(Wlo + boffs + (size_t)et * 16 * 1024 + ks * 32);
#pragma unroll
                    for (int tt = 0; tt < 2; ++tt) {
                        acc[tt][et] = __builtin_amdgcn_mfma_f32_16x16x32_bf16(ah[tt], bh, acc[tt][et], 0, 0, 0);
                        acc[tt][et] = __builtin_amdgcn_mfma_f32_16x16x32_bf16(ah[tt], bl, acc[tt][et], 0, 0, 0);
                    }
                }
            }
#pragma unroll
            for (int tt = 0; tt < 2; ++tt)
#pragma unroll
                for (int et = 0; et < 4; ++et)
#pragma unroll
                    for (int r = 0; r < 4; ++r) part[(ksl * 64 + th * 32 + tt * 16 + (lane >> 4) * 4 + r) * 64 + et * 16 + (lane & 15)] = acc[tt][et][r];
        }
        __syncthreads();
        const float bias = rb[lane];
        LAS unsigned* pk = (LAS unsigned*)(F.lds + 69632 + F.wave * 4096);
        LAS float* wf = (LAS float*)(F.lds + 69632 + F.wave * 4096 + 2048);
        int running = 0;
#pragma unroll 1
        for (int ti = 0; ti < 8; ++ti) {
            const int tl = F.wave * 8 + ti;
            const float logit = ((part[(0 * 64 + tl) * 64 + lane] + part[(1 * 64 + tl) * 64 + lane]) + part[(2 * 64 + tl) * 64 + lane]) + part[(3 * 64 + tl) * 64 + lane];
            const float score = 1.f / (1.f + expf(-logit));
            bool sel; int jr; float w;
            nv::route_lane(score, bias, lane, sel, jr, w);
            pk[ti * 64 + lane] = sel ? (0x80000000u | ((unsigned)jr << 16) | (unsigned)running) : 0u; wf[ti * 64 + lane] = w;
            running += sel ? 1 : 0;
        }
        const int wbase = __hip_atomic_fetch_add(hist + lane, running, __ATOMIC_RELAXED, __HIP_MEMORY_SCOPE_WORKGROUP);
        __syncthreads();
        if (F.wave == 0) { const int h = hist[lane]; gbase[lane] = (int)__hip_atomic_fetch_add(ecnt + lane, (unsigned)h, __ATOMIC_RELAXED, __HIP_MEMORY_SCOPE_AGENT); }
        __syncthreads();
        const int gb = gbase[lane] + wbase;
#pragma unroll 1
        for (int ti = 0; ti < 8; ++ti) {
            const unsigned v = pk[ti * 64 + lane];
            if (v & 0x80000000u) {
                const int tok = tok0 + ti, jr = (int)((v >> 16) & 0xffu), lp = gb + (int)(v & 0xffffu);
                TOPI[tok * 6 + jr] = lane; TOPW[tok * 6 + jr] = wf[ti * 64 + lane]; LP[tok * 6 + jr] = lp; LT2[lane * 16384 + lp] = tok;
            }
        }
        __syncthreads();
    }
}

template <bool LAST>
__device__ __forceinline__ void phase_combine(const Ctx& F0, int l, const bf16_t* Xin, void* Xout) {
    const Ctx F = phase_ctx(F0);
    load_tables(F, l);
    const LAS int* tab = (const LAS int*)(F.lds + LDSCTL_OFF);
    const float* MOD = (const float*)(F.ws + WS_MOD);
    const unsigned char* YB = (const unsigned char*)(F.ws + WS_YB);
    const int* TOPI = (const int*)(F.ws + WS_TOPI); const float* TOPW = (const float*)(F.ws + WS_TOPW); const int* LP = (const int*)(F.ws + WS_PPOS);
    float* RSTD = (float*)(F.ws + WS_RSTD); float* ROPE = (float*)(F.ws + WS_ROPE); const int* posp = (const int*)F.in[2];
    const int gw = F.vcu * NWAVES + F.wave, NGW = F.G * NWAVES, lane = F.lane;
    const float inv = powf(10000.f, -(float)(lane & 15) / 16.f);
    if (!LAST && F.wave == 0) {
        const float* PB = (const float*)(F.ws + WS_PB); float* CB = (float*)(F.ws + WS_CB);
        for (int t = F.vcu; t < 128; t += F.G) { const int o = t * 64 + lane, n = o & 511, w = (o >> 9) & 1;
            float sacc = 0.f;
            if (n < (w ? 384 : 288)) {
#pragma unroll
                for (int kb = 0; kb < 16; ++kb) sacc += PB[((size_t)(o >> 9) * 16 + kb) * 512 + n]; }
            CB[o] = sacc; }
    }
    for (int base = gw * 8; base < NT; base += NGW * 8) {
        const int b = base / SEQ;
        f32x4 gate[4];
#pragma unroll
        for (int q = 0; q < 4; ++q) gate[q] = *(const GAS f32x4*)(MOD + b * MODW + l * 6144 + 5120 + 16 * lane + 4 * q);
        u32x4 y[7], xa, xb; float w[7];
#define CMB_LOAD(TOK, Y, W, XA, XB) do { const int tk_ = (TOK); _Pragma("unroll") for (int j = 0; j < 7; ++j) { int p; \
            if (j < 6) { const int e = TOPI[tk_ * 6 + j]; p = tab[e] + LP[tk_ * 6 + j]; W[j] = TOPW[tk_ * 6 + j] * (1.f / pg8::YB_SCALE); } else { p = PMAX + tk_; W[j] = 1.f / pg8::YB_SCALE; } \
            Y[j] = __builtin_nontemporal_load((const GAS u32x4*)(YB + (size_t)p * 1024 + 16 * lane)); }     \
            { const size_t off_ = (size_t)tk_ * 1024 + 16 * lane; XA = *(const GAS u32x4*)(Xin + off_); XB = *(const GAS u32x4*)(Xin + off_ + 8); } } while (0)
        CMB_LOAD(base, y, w, xa, xb);
#pragma unroll 1
        for (int ti = 0; ti < 8; ++ti) {
            const int tok = base + ti;
            u32x4 yn[7], xan, xbn; float wn[7];
            CMB_LOAD(ti < 7 ? tok + 1 : tok, yn, wn, xan, xbn);
            f32x4 a[4];
#pragma unroll
            for (int q = 0; q < 4; ++q) a[q] = (f32x4){0.f, 0.f, 0.f, 0.f};
#pragma unroll
            for (int j = 0; j < 7; ++j) {
                const unsigned yw[4] = {y[j].x, y[j].y, y[j].z, y[j].w};
#pragma unroll
                for (int q = 0; q < 4; ++q) { const f32x2 lo = __builtin_amdgcn_cvt_pk_f32_fp8((int)yw[q], false), hi = __builtin_amdgcn_cvt_pk_f32_fp8((int)yw[q], true);
                    a[q][0] += w[j] * lo.x; a[q][1] += w[j] * lo.y; a[q][2] += w[j] * hi.x; a[q][3] += w[j] * hi.y; }
            }
            float s2 = 0.f;
            { const size_t off = (size_t)tok * 1024 + 16 * lane;
              const unsigned xw[8] = {xa.x, xa.y, xa.z, xa.w, xb.x, xb.y, xb.z, xb.w};
#pragma unroll
              for (int q = 0; q < 4; ++q) {
                  const f32x4 xi = (f32x4){__uint_as_float(xw[2 * q] << 16), __uint_as_float(xw[2 * q] & 0xffff0000u), __uint_as_float(xw[2 * q + 1] << 16), __uint_as_float(xw[2 * q + 1] & 0xffff0000u)};
                  const f32x4 xo = xi + gate[q] * a[q];
                  a[q] = xo;
                  if (LAST) *(GAS f32x4*)((float*)Xout + off + 4 * q) = xo;
                  s2 += (xo.x * xo.x + xo.y * xo.y) + (xo.z * xo.z + xo.w * xo.w);
              }
              if (!LAST) { u32x4 w0, w1; w0.x = pk2(a[0].x, a[0].y); w0.y = pk2(a[0].z, a[0].w); w0.z = pk2(a[1].x, a[1].y); w0.w = pk2(a[1].z, a[1].w);
                  w1.x = pk2(a[2].x, a[2].y); w1.y = pk2(a[2].z, a[2].w); w1.z = pk2(a[3].x, a[3].y); w1.w = pk2(a[3].z, a[3].w);
                  *(GAS u32x4*)((bf16_t*)Xout + off) = w0; *(GAS u32x4*)((bf16_t*)Xout + off + 8) = w1; }
            }
            if (!LAST) {
                const float rstd = rsqrtf(wave_sum(s2) * (1.f / 1024.f) + EPS);
                if (lane == 0) RSTD[tok] = rstd;
                if (lane < 16) { const float ang = (float)posp[tok] * inv; ROPE[(size_t)tok * 16 + lane] = cosf(ang); ROPE[(size_t)NT * 16 + (size_t)tok * 16 + lane] = sinf(ang); }
            }
#pragma unroll
            for (int j = 0; j < 7; ++j) { y[j] = yn[j]; w[j] = wn[j]; }
            xa = xan; xb = xbn;
        }
#undef CMB_LOAD
    }
}

__global__ void __launch_bounds__(NTHREADS, 2) fwd(Args args) {
    extern __shared__ __attribute__((aligned(16))) unsigned char lds_raw[];
    Ctx F;
    F.lds = (LAS unsigned char*)lds_raw;
    F.tid = threadIdx.x; F.lane = F.tid & 63; F.wave = __builtin_amdgcn_readfirstlane(F.tid >> 6);
    F.G = gridDim.x; { const int bx = blockIdx.x; F.vcu = (F.G % 8 == 0) ? (bx % 8) * (F.G / 8) + bx / 8 : bx; }
    F.ws = args.ws; F.in = args.in; F.out = args.out;
    volatile LAS unsigned* MISC = (volatile LAS unsigned*)(F.lds + MISC_OFF);
    for (int u = F.tid; u < (LDS_BYTES - LDSCTL_OFF) / 4; u += NTHREADS) ((LAS unsigned*)(F.lds + LDSCTL_OFF))[u] = 0u;
    __syncthreads();
    const int lo = args.ph_lo, hi = args.ph_hi;
    const bool single = (hi - lo) > 1;
    unsigned* barw = (unsigned*)(F.ws + WS_CTL) + CW_BAR;
    XcdBarrier bar; bar.bar = barw; bar.x = 0; bar.st = nullptr;
    if (single) bar = xcd_barrier_post(barw, MISC + 8);
#define IN(k) (lo <= (k) && (k) < hi)
#define SEAM(k) do { if (IN(k) && IN((k) + 1)) xcd_barrier(bar); } while (0)
#ifndef MK_REPMASK
#define MK_REPMASK 0u
#endif
#define REPS(k) ((((unsigned)(MK_REPMASK) >> (k)) & 1u) ? 2 : 1)
#define RUN(k) for (int rep_ = (IN(k) ? REPS(k) : 0); rep_ > 0; (--rep_ > 0 ? xcd_barrier(bar) : (void)0))
#define PH const Ctx P = phase_ctx(F); const char* wsc = (const char*)P.ws; bf16_t* X1 = (bf16_t*)(P.ws + WS_X1); bf16_t* X2 = (bf16_t*)(P.ws + WS_X2); bf16_t* X3 = X1; (void)wsc; (void)X1; (void)X2; (void)X3

#ifdef MK_XBAR
    if (single) for (int xb_ = 0; xb_ < MK_XBAR; ++xb_) xcd_barrier(bar);
#endif
    RUN(0) { phase_prologue(F); phase_norm1(F); } SEAM(0);
    RUN(2) { PH;
        pg8::DenseSched S; S.init(3072, 1024, F.G, (int)blockIdx.x, (unsigned)WS_XN, P.ws + WS_WQKV);
        pg8::EpiQKV E{(bf16_t*)(P.ws + WS_QB), P.in[8], P.in[9]};
        pg8::gemm_phase<pg8::EpiQKV, pg8::DenseSched, true>(F.lds, wsc, 1024, S, E);
    } SEAM(2);
    if (IN(3) || IN(4)) {
        PH;
        int tid3 = threadIdx.x; asm volatile("" : "+v"(tid3));
        const int half = __builtin_amdgcn_readfirstlane(tid3 >> 8), hw = __builtin_amdgcn_readfirstlane((tid3 >> 6) & 3), lane3 = tid3 & 63;
        LAS unsigned char* hl = F.lds + half * 65536; LAS float* xs = (LAS float*)(F.lds + XS_OFF + half * 2048);
        const bf16_t* QB = (const bf16_t*)(P.ws + WS_QB); const bf16_t* KB = (const bf16_t*)(P.ws + WS_KB); const bf16_t* VB = (const bf16_t*)(P.ws + WS_VB);
        bf16_t* PART = (bf16_t*)(P.ws + WS_PART); float* LSE = (float*)(P.ws + WS_LSE); const int* pos = (const int*)P.in[2];
#define DIL_RUN(MERGEV, FIRST, LAST, DECODE, PARTG, LSEG, P0V, P1V, L0V, L1V, OBV, BGH) do { \
            constexpr bool PF_ = !(MERGEV);                          \
            at::DilStage st; at::DilU u; int pair = (FIRST); \
            _Pragma("unroll") for (int z_ = 0; z_ < 8; ++z_) { st.kk[z_] = (u32x4){0u, 0u, 0u, 0u}; st.vv[z_] = (u32x4){0u, 0u, 0u, 0u}; } st.pk = 0; \
            if (PF_ && pair < (LAST)) { DECODE(pair, u); at::dil_load_k(st, u, hw, lane3, KB, pos); at::dil_load_v(st, u, hw, lane3, VB); } \
            _Pragma("unroll 1") for (; pair < (LAST); ++pair) { \
                int ln_ = lane3; asm volatile("" : "+v"(ln_));     \
                if (!PF_) { DECODE(pair, u); if (!(ABL3 & 2)) { at::dil_load_k(st, u, hw, ln_, KB, pos); at::dil_load_v(st, u, hw, ln_, VB); } } \
                at::dil_write(st, u, hl, xs, hw, ln_); \
                const int tokq_ = (128 * u.n + 32 * hw + (ln_ & 31)) * u.dil + u.r; \
                bf16x8 qr_[4]; \
                _Pragma("unroll") for (int d0 = 0; d0 < 4; ++d0) qr_[d0] = *(const GAS bf16x8*)(QB + (size_t)(u.b * SEQ + tokq_) * 1024 + u.h * 64 + 16 * d0 + 8 * (ln_ >> 5)); \
                const float posq_ = (float)pos[u.b * SEQ + tokq_]; \
                __syncthreads(); \
                asm volatile("" :: "v"(qr_[0]), "v"(qr_[1]), "v"(qr_[2]), "v"(qr_[3]), "v"(posq_));     \
                BGH; \
                const at::DilU uc = u; \
                const bool more_ = PF_ && (pair + 1 < (LAST)) && !(ABL3 & 2); \
                if (more_) { DECODE(pair + 1, u); at::dil_load_k(st, u, hw, ln_, KB, pos); }     \
                at::dil_compute<MERGEV, false>(hl, xs, hw, 0, ln_, uc, qr_, posq_, PARTG(uc), LSEG(uc), P0V, P1V, L0V, L1V, OBV, ABL3); \
                if (more_) at::dil_load_v(st, u, hw, ln_, VB);                                    \
                BGH; \
                __syncthreads(); \
            } } while (0)
#define DEC3(pr, uu) do { const int u_ = (pr) * 2 + half, bh_ = u_ >> 5, rem_ = u_ & 31, g_ = rem_ >> 4, idx_ = rem_ & 15; \
            (uu).b = bh_ >> 4; (uu).h = bh_ & 15; (uu).dil = g_ ? 4 : 1; (uu).r = g_ ? (idx_ >> 2) : 0; (uu).n = g_ ? (idx_ & 3) : idx_; } while (0)
#define DEC4(pr, uu) do { const int u_ = (pr) * 2 + half, bh_ = u_ >> 4; (uu).b = bh_ >> 4; (uu).h = bh_ & 15; (uu).dil = 16; (uu).r = u_ & 15; (uu).n = 0; } while (0)
#define PART3(uu) (PART + (size_t)((uu).dil == 4 ? 1 : 0) * NT * 1024)
#define LSE3(uu) (LSE + (size_t)((uu).dil == 4 ? 1 : 0) * NT * 16)
#define NULLP(uu) nullptr
#ifndef MK_ABL3
#define MK_ABL3 0
#endif
        RUN(3) {
            const int ABL3 = (rep_ == 2) ? MK_ABL3 : 0;
            const int per3 = (2048 + F.G - 1) / F.G, first3 = F.vcu * per3, last3 = min((F.vcu + 1) * per3, 2048);
            const int wv3 = half * 4 + hw;
            LAS float* xsr = (LAS float*)(F.lds + XS_OFF);
#define DEC3H(pr, hh, uu) do { const int u_ = (pr) * 2 + (hh), bh_ = u_ >> 5, rem_ = u_ & 31, g_ = rem_ >> 4, idx_ = rem_ & 15; \
            (uu).b = bh_ >> 4; (uu).h = bh_ & 15; (uu).dil = g_ ? 4 : 1; (uu).r = g_ ? (idx_ >> 2) : 0; (uu).n = g_ ? (idx_ & 3) : idx_; } while (0)
            at::RingStage st; at::DilU u0; int pair = first3;
            if (pair < last3) { DEC3H(pair, 0, u0); at::ring_load(st, u0, wv3, lane3, KB, VB, pos); }
#pragma unroll 1
            for (; pair < last3; ++pair) {
                int ln_ = lane3; asm volatile("" : "+v"(ln_));
                at::DilU u; DEC3H(pair, half, u); DEC3H(pair, 0, u0);
                at::ring_write(st, u0, F.lds, xsr, wv3, ln_);
                const int tokq_ = (128 * u.n + 32 * hw + (ln_ & 31)) * u.dil + u.r;
                bf16x8 qr_[4];
#pragma unroll
                for (int d0 = 0; d0 < 4; ++d0) qr_[d0] = *(const GAS bf16x8*)(QB + (size_t)(u.b * SEQ + tokq_) * 1024 + u.h * 64 + 16 * d0 + 8 * (ln_ >> 5));
                const float posq_ = (float)pos[u.b * SEQ + tokq_];
                __syncthreads();
                asm volatile("" :: "v"(qr_[0]), "v"(qr_[1]), "v"(qr_[2]), "v"(qr_[3]), "v"(posq_));
                if (pair + 1 < last3 && !(ABL3 & 2)) { at::DilU un; DEC3H(pair + 1, 0, un); at::ring_load(st, un, wv3, ln_, KB, VB, pos); }
                at::dil_compute<false, true>(F.lds, xsr, hw, wv3, ln_, u, qr_, posq_, PART3(u), LSE3(u), nullptr, nullptr, nullptr, nullptr, nullptr, ABL3);
                __syncthreads();
            }
#undef DEC3H
        }
        SEAM(3);
        RUN(4) {
            const int ABL3 = 0;
            const int per4 = (1024 + F.G - 1) / F.G;
            const bool bgw = hw < 2;
            BgConv bg; bg.init(P, 0, F.vcu * 4 + half * 2 + hw, I_DNL, F.G * 4, (LAS float*)(hl + (hw ? 32768 : 0))); bg.base = I_GUL;
            DIL_RUN(true, F.vcu * per4, min((F.vcu + 1) * per4, 1024), DEC4, NULLP, NULLP, PART, PART + (size_t)NT * 1024, LSE, LSE + (size_t)NT * 16, (bf16_t*)(P.ws + WS_OB), if (bgw) bg.step());
            if (bgw) bg.drain();
        }
#undef DIL_RUN
#undef DEC3
#undef DEC4
#undef PART3
#undef LSE3
#undef NULLP
    }
    SEAM(4);
    RUN(5) { PH;
        pg8::DenseSched S; S.init(1024, 1024, F.G, (int)blockIdx.x, (unsigned)WS_OB, P.ws + WS_WO0);
        pg8::EpiResid<false> E{P.in[0], (const float*)(P.ws + WS_MOD), 2048, X1};
        pg8::gemm_phase<pg8::EpiResid<false>, pg8::DenseSched, true>(F.lds, wsc, 1024, S, E);
    } SEAM(5);
    RUN(6) { PH; phase_route(F, 0, X1); } SEAM(6);
    RUN(7) { PH;
        load_tables(F, 0);
        pg8::MoeSched<2, true> S{(const LAS int*)(F.lds + LDSCTL_OFF), (const int*)(P.ws + WS_LT2), F.G, F.vcu, 1024, (unsigned)WS_XN, wsc + WS_WGU + (size_t)0 * 65 * 512 * 1024 * 2};
        pg8::EpiSwiglu E{(bf16_t*)(P.ws + WS_ACT), (const LAS int*)(F.lds + LDSCTL_OFF)};
#ifdef MK_ABL7
        const int ABL7 = (rep_ == 2) ? MK_ABL7 : 0;
#else
        const int ABL7 = 0;
#endif
        pg8::gemm_phase<pg8::EpiSwiglu, pg8::MoeSched<2, true>, true>(F.lds, wsc, 1024, S, E, ABL7);
    } SEAM(7);
    RUN(8) { PH;
        load_tables(F, 0);
        pg8::MoeSched<4, false> S{(const LAS int*)(F.lds + LDSCTL_OFF), (const int*)(P.ws + WS_LT2), F.G, F.vcu, 256, (unsigned)WS_ACT, wsc + WS_WDN + (size_t)0 * 65 * 1024 * 256 * 2};
        pg8::EpiYB E{(unsigned char*)(P.ws + WS_YB), (const LAS int*)(F.lds + LDSCTL_OFF)};
#ifdef MK_ABL8
        const int ABL8 = (rep_ == 2) ? MK_ABL8 : 0;
#else
        const int ABL8 = 0;
#endif
        pg8::gemm_phase<pg8::EpiYB, pg8::MoeSched<4, false>, true>(F.lds, wsc, 256, S, E, ABL8);
    } SEAM(8);
    RUN(9) { PH; phase_combine<false>(F, 0, X1, X2); } SEAM(9);
        RUN(10) { PH;
            pg8::DualSched S; S.G = F.G; S.c = (int)blockIdx.x; S.a0 = (unsigned)WS_X2; S.Bt = wsc + WS_W8;
            pg8::EpiDown E{(bf16_t*)(P.ws + WS_DKV), (const float*)(P.ws + WS_RSTD), (const float*)(P.ws + WS_CB), (float*)(P.ws + WS_SSQ), (float*)(P.ws + WS_KPSS), (float*)(P.ws + WS_KPR), (const float*)(P.ws + WS_ROPE), P.in[18]};
            pg8::gemm_phase<pg8::EpiDown, pg8::DualSched, true>(F.lds, wsc, 1024, S, E);
        } SEAM(10);
        RUN(12) { PH;
            { pg8::DenseSched S; S.init(2048, 256, F.G, (int)blockIdx.x, (unsigned)WS_DKV, P.ws + WS_WUKV, 512);
              pg8::EpiKV E{(bf16_t*)(P.ws + WS_KM), (bf16_t*)(P.ws + WS_VM), (const float*)(P.ws + WS_KPSS), (const float*)(P.ws + WS_KPR), P.in[18], (const float*)(P.ws + WS_SSQ)};
              pg8::gemm_phase<pg8::EpiKV, pg8::DenseSched, true>(F.lds, wsc, 256, S, E, 0, 512); }
            { pg8::DenseSched S; S.init(1536, 384, F.G, (int)blockIdx.x, (unsigned)WS_DQ, P.ws + WS_WUQ, 512);
              pg8::EpiQ E{(bf16_t*)(P.ws + WS_QR), (const float*)(P.ws + WS_SSQ)};
              pg8::gemm_phase<pg8::EpiQ, pg8::DenseSched, true>(F.lds, wsc, 384, S, E, 0, 512); }
        } SEAM(12);
        RUN(13) { PH;
#ifdef MK_ABL13
            const int ABL13 = (rep_ == 2) ? MK_ABL13 : 0;
#else
            const int ABL13 = 0;
#endif
            BgConv bg; bg.init(P, 1, F.vcu * NWAVES + F.wave, I_MOEL, F.G * NWAVES, (LAS float*)(F.lds + 49152 + F.wave * 8448));
            for (int v = F.vcu; v < 256; v += F.G) {
                const int bh = v >> 1, odd = v & 1;
#pragma unroll 1
                for (int i = 0; i < 4; ++i) {
                    const int qb = odd ? (i == 0 ? 1 : i == 1 ? 6 : i == 2 ? 2 : 5) : (i == 0 ? 0 : i == 1 ? 7 : i == 2 ? 3 : 4);
                    at::mla_unit(F.lds, bh >> 4, bh & 15, qb, (const bf16_t*)(P.ws + WS_QR), (const bf16_t*)(P.ws + WS_KM), (const bf16_t*)(P.ws + WS_VM), (const float*)(P.ws + WS_ROPE), P.in[22], (bf16_t*)(P.ws + WS_OB), bg, ABL13);
                }
            }
            if (!(ABL13 & 4)) bg.drain();
        } SEAM(13);
        RUN(14) { PH;
            pg8::DenseSched S; S.init(1024, 1024, F.G, (int)blockIdx.x, (unsigned)WS_OB, P.ws + WS_WO1);
            pg8::EpiResid<true> E{X2, (const float*)(P.ws + WS_MOD), 6144 + 2048, X3};
            pg8::gemm_phase<pg8::EpiResid<true>, pg8::DenseSched, true>(F.lds, wsc, 1024, S, E);
        } SEAM(14);

    RUN(15) { PH; phase_route(F, 1, X3); } SEAM(15);
    RUN(16) { PH;
        load_tables(F, 1);
        pg8::MoeSched<2, true> S{(const LAS int*)(F.lds + LDSCTL_OFF), (const int*)(P.ws + WS_LT2), F.G, F.vcu, 1024, (unsigned)WS_XN, wsc + WS_WGU + (size_t)1 * 65 * 512 * 1024 * 2};
        pg8::EpiSwiglu E{(bf16_t*)(P.ws + WS_ACT), (const LAS int*)(F.lds + LDSCTL_OFF)};
        pg8::gemm_phase<pg8::EpiSwiglu, pg8::MoeSched<2, true>, true>(F.lds, wsc, 1024, S, E);
    } SEAM(16);
    RUN(17) { PH;
        load_tables(F, 1);
        pg8::MoeSched<4, false> S{(const LAS int*)(F.lds + LDSCTL_OFF), (const int*)(P.ws + WS_LT2), F.G, F.vcu, 256, (unsigned)WS_ACT, wsc + WS_WDN + (size_t)1 * 65 * 1024 * 256 * 2};
        pg8::EpiYB E{(unsigned char*)(P.ws + WS_YB), (const LAS int*)(F.lds + LDSCTL_OFF)};
        pg8::gemm_phase<pg8::EpiYB, pg8::MoeSched<4, false>, true>(F.lds, wsc, 256, S, E);
    } SEAM(17);
    RUN(18) { PH; phase_combine<true>(F, 1, X3, P.out); } SEAM(18);
#undef IN
#undef SEAM
#undef RUN
#undef REPS
#undef PH
}
}
static int g_grid = 0;
static void mk_setup() {
    if (g_grid) return;
    int dev = 0, cus = 0, per_cu = 0;
    (void)hipGetDevice(&dev);
    (void)hipDeviceGetAttribute(&cus, hipDeviceAttributeMultiprocessorCount, dev);
    (void)hipFuncSetAttribute((const void*)mk::fwd, hipFuncAttributeMaxDynamicSharedMemorySize, mk::LDS_BYTES);
    if (hipOccupancyMaxActiveBlocksPerMultiprocessor(&per_cu, (const void*)mk::fwd, mk::NTHREADS, mk::LDS_BYTES) != hipSuccess) per_cu = 0;
    (void)hipGetLastError();
    if (per_cu < 1) fprintf(stderr, "kernel_launch: the occupancy query reports %d resident workgroups per CU for %d threads + %d B of LDS; launching one per CU anyway\n", per_cu, mk::NTHREADS, mk::LDS_BYTES);
    g_grid = cus;
    if (g_grid <= 0) g_grid = 256;
}
static void mk_launch(hipStream_t s, void* const* d_in, void* d_out, void* d_ws, int lo, int hi) {
    mk::Args a{};
    for (int i = 0; i < 30; ++i) a.in[i] = (const float*)d_in[i];
    a.out = (float*)d_out; a.ws = (unsigned char*)d_ws; a.ph_lo = lo; a.ph_hi = hi;
    hipLaunchKernelGGL(mk::fwd, dim3(g_grid), dim3(mk::NTHREADS), mk::LDS_BYTES, s, a);
}

extern "C" void kernel_launch(void* const* d_in, const int* in_sizes, int n_in, void* d_out, int out_size, void* d_ws, size_t ws_size,
                              hipStream_t stream) {
    if (n_in != 30 || ws_size < WS_END || out_size != NT * DM) { fprintf(stderr, "kernel_launch: unexpected n_in %d / out %d / ws %zu\n", n_in, out_size, ws_size); return; }
    (void)in_sizes;
    mk_setup();
    (void)hipMemsetAsync((unsigned char*)d_ws + WS_CTL, 0, 1 * MiB, stream);
#ifndef MK_PER_PHASE
    mk_launch(stream, d_in, d_out, d_ws, 0, mk::NPHASE);
#else
    for (int k = 0; k < mk::NPHASE; ++k) mk_launch(stream, d_in, d_out, d_ws, k, k + 1);
#endif
}
```

```cpp
#include <hip/hip_runtime.h>
#include <stdint.h>
#include <cstdio>
#include <cmath>

typedef unsigned short bf16_t;

constexpr int NB = 8, SEQ = 2048, DM = 1024, NT = NB * SEQ, NH = 16;
constexpr int NE = 64, TOPK = 6, PMAX = 114688  , AROWS = PMAX + NT;
constexpr int MODW = 14336;
constexpr float EPS = 1e-6f;
constexpr float LOG2E = 1.4426950408889634f;
constexpr float C2 = 0.125f * LOG2E;
constexpr float C3 = 0.10206207261596577f * LOG2E;

constexpr size_t MiB = 1u << 20;
constexpr size_t WS_CTL = 0;
constexpr size_t WS_MOD = 1 * MiB;
constexpr size_t WS_TOPI = 2 * MiB;
constexpr size_t WS_TOPW = 2 * MiB + 512 * 1024;
constexpr size_t WS_PPOS = 3 * MiB;
constexpr size_t WS_LTOK = 3 * MiB + 512 * 1024;
constexpr size_t WS_KPSS = 4 * MiB;
constexpr size_t WS_KPR = 4 * MiB + 512 * 1024;
constexpr size_t WS_XN = 8 * MiB;
constexpr size_t WS_XKV = 40 * MiB;
constexpr size_t WS_OB = 72 * MiB;
constexpr size_t WS_X1 = 104 * MiB;
constexpr size_t WS_X2 = 168 * MiB;
constexpr size_t WS_ACT = 232 * MiB;
constexpr size_t WS_YB = 296 * MiB;
constexpr size_t WS_R0 = 552 * MiB;
constexpr size_t WS_QB = WS_R0, WS_KB = WS_R0 + 32 * MiB, WS_VB = WS_R0 + 64 * MiB;
constexpr size_t WS_DKV = WS_R0, WS_DQ = WS_R0 + 16 * MiB, WS_CKV = WS_R0 + 32 * MiB, WS_CQ = WS_R0 + 40 * MiB;
constexpr size_t WS_KM = WS_R0 + 52 * MiB, WS_VM = WS_R0 + 100 * MiB, WS_QR = WS_R0 + 132 * MiB;
constexpr size_t WS_END = 1024 * MiB;

constexpr int CW_ECNT = 1024, CW_EOFF = 1024 + 128, CW_CUR = 1024 + 256;

__device__ __forceinline__ float bf2f(bf16_t v) { return __uint_as_float(((unsigned)v) << 16); }
__device__ __forceinline__ bf16_t f2bf(float f) { unsigned u = __float_as_uint(f); return (bf16_t)((u + 0x7fffu + ((u >> 16) & 1u)) >> 16); }


__device__ __forceinline__ float dppf(float v, const int ctrl_sel) {
    const int iv = __float_as_int(v); int r;
    if (ctrl_sel == 0) r = __builtin_amdgcn_update_dpp(iv, iv, 0xB1, 0xF, 0xF, false);
    else if (ctrl_sel == 1) r = __builtin_amdgcn_update_dpp(iv, iv, 0x4E, 0xF, 0xF, false);
    else if (ctrl_sel == 2) r = __builtin_amdgcn_update_dpp(iv, iv, 0x141, 0xF, 0xF, false);
    else r = __builtin_amdgcn_update_dpp(iv, iv, 0x140, 0xF, 0xF, false);
    return __int_as_float(r);
}
__device__ __forceinline__ float sum_x16(float v) { const auto r = __builtin_amdgcn_permlane16_swap(__float_as_int(v), __float_as_int(v), false, false); return __int_as_float(r[0]) + __int_as_float(r[1]); }
__device__ __forceinline__ float sum_x32(float v) { const auto r = __builtin_amdgcn_permlane32_swap(__float_as_int(v), __float_as_int(v), false, false); return __int_as_float(r[0]) + __int_as_float(r[1]); }
__device__ __forceinline__ float max_x16(float v) { const auto r = __builtin_amdgcn_permlane16_swap(__float_as_int(v), __float_as_int(v), false, false); return fmaxf(__int_as_float(r[0]), __int_as_float(r[1])); }
__device__ __forceinline__ float max_x32(float v) { const auto r = __builtin_amdgcn_permlane32_swap(__float_as_int(v), __float_as_int(v), false, false); return fmaxf(__int_as_float(r[0]), __int_as_float(r[1])); }
__device__ __forceinline__ float wave_sum_all(float v) { v += dppf(v, 0); v += dppf(v, 1); v += dppf(v, 2); v += dppf(v, 3); v = sum_x16(v); return sum_x32(v); }
__device__ __forceinline__ float wave_max_all(float v) { v = fmaxf(v, dppf(v, 0)); v = fmaxf(v, dppf(v, 1)); v = fmaxf(v, dppf(v, 2)); v = fmaxf(v, dppf(v, 3)); v = max_x16(v); return max_x32(v); }
__device__ __forceinline__ float max8(float v) { v = fmaxf(v, dppf(v, 0)); v = fmaxf(v, dppf(v, 1)); return fmaxf(v, dppf(v, 2)); }

namespace nv {
__device__ __forceinline__ void route_lane(float score, float bias, int lane, bool& sel, int& jrank, float& w) {
    const float s = score + bias;
    const int g = lane >> 3;
    const float m1 = max8(s);
    unsigned long long bal = __ballot(s == m1);
    const unsigned gm = (unsigned)(bal >> (g * 8)) & 0xffu;
    const int first = __ffs(gm) - 1;
    const float m2 = max8(((lane & 7) == first) ? -INFINITY : s);
    const float gs = m1 + m2;
    int rank = 0;
#pragma unroll
    for (int gg = 0; gg < 8; ++gg) { const float o = __int_as_float(__builtin_amdgcn_readlane(__float_as_int(gs), gg * 8)); rank += ((o > gs) || (o == gs && gg < g)) ? 1 : 0; }
    float v = (rank < 4) ? s : -INFINITY;
    sel = false; jrank = -1;
#pragma unroll
    for (int it = 0; it < TOPK; ++it) {
        const float mx = wave_max_all(v);
        bal = __ballot(v == mx);
        const int f = __ffsll((long long)bal) - 1;
        if (lane == f) { sel = true; jrank = it; v = -INFINITY; }
    }
    const float ssum = wave_sum_all(sel ? score : 0.f);
    w = sel ? score / ssum * 2.5f : 0.f;
}

}

constexpr size_t WS_WQKV = 748 * MiB;
constexpr size_t WS_WO0 = WS_WQKV + 6 * MiB;
constexpr size_t WS_WO1 = WS_WO0 + 2 * MiB;
constexpr size_t WS_WKVD = WS_WO1 + 2 * MiB;
constexpr size_t WS_WDQ = WS_WKVD + 1 * MiB;
constexpr size_t WS_WUKV = WS_WDQ + 1 * MiB;
constexpr size_t WS_WUQ = WS_WUKV + 1 * MiB;
constexpr size_t WS_WR = WS_WUQ + 1536 * 1024;
constexpr size_t WS_WGU = WS_WR + 512 * 1024;
constexpr size_t WS_WDN = WS_WGU + 130 * MiB;
constexpr size_t WS_FAST_END = WS_WDN + 65 * MiB;
static_assert(WS_FAST_END <= WS_END, "d_ws map");
constexpr size_t WS_PART = WS_R0 + 96 * MiB;
constexpr size_t WS_LSE = WS_R0 + 192 * MiB;
constexpr size_t WS_LT2 = 960 * MiB;
constexpr size_t WS_ROPE = 964 * MiB;
constexpr size_t WS_W8 = 968 * MiB;
constexpr size_t WS_PB = 984 * MiB;
constexpr size_t WS_CB = 985 * MiB;
constexpr size_t WS_RSTD = 986 * MiB;
constexpr size_t WS_SSQ = 988 * MiB;
constexpr int CW_ECNTF = 2048;

#define GAS __attribute__((address_space(1)))
#define LAS __attribute__((address_space(3)))
typedef short bf16x8 __attribute__((ext_vector_type(8)));
typedef float f32x4 __attribute__((ext_vector_type(4)));
typedef float f32x2 __attribute__((ext_vector_type(2)));
typedef unsigned u32x4 __attribute__((ext_vector_type(4)));
typedef unsigned u32x2 __attribute__((ext_vector_type(2)));

__device__ __forceinline__ unsigned pk2(float lo, float hi) { return (unsigned)f2bf(lo) | ((unsigned)f2bf(hi) << 16); }
__device__ __forceinline__ unsigned cvt_pk_bf16(float lo, float hi) { unsigned r; asm volatile("v_cvt_pk_bf16_f32 %0, %1, %2" : "=v"(r) : "v"(lo), "v"(hi)); return r; }

namespace pg8 {
constexpr int BM = 256, BK = 64, HALF = 128, HTB = HALF * BK * 2, STAGE_BYTES = 8 * HTB, NXCD = 8, WGM = 8;
__host__ __device__ __forceinline__ int lds_byte(int r, int c) { const int st = (r >> 4) * 2 + (c >> 5), rr = r & 15, cc = c & 31, ob = rr * 64 + cc * 2; return st * 1024 + (ob ^ (((ob >> 9) & 1) << 5)); }
__host__ __device__ __forceinline__ void stage_rc(int b, int& R, int& C) { const int st = b / 1024, sb = b % 1024, swz = sb ^ (((sb >> 9) & 1) << 5); R = (st >> 1) * 16 + swz / 64; C = (st & 1) * 32 + (swz % 64) / 2; }
__host__ __device__ __forceinline__ int perm32(int rho) { const int n = rho >> 4, i = rho & 15; return 8 * (i >> 2) + 4 * n + (i & 3); }

struct Unit { int rowbase; int pn; int aux; int aux2; };
__device__ __forceinline__ void st16(void* p, u32x4 v, bool wt) {
    if (wt) asm volatile("global_store_dwordx4 %0, %1, off sc1\n\ts_nop 1" :: "v"(p), "v"(v) : "memory");
    else *(GAS u32x4*)p = v;
}

template <class Epi, class Sched, bool ALIGN_EPI>
__device__ __forceinline__ void gemm_phase(LAS unsigned char* lds, const char* Abase, const int K, const Sched& S, const Epi& E, const int abl = 0, const int lda_ = 0) {
    int tid_ = threadIdx.x; asm volatile("" : "+v"(tid_));
    const int tid = tid_, wid = __builtin_amdgcn_readfirstlane(tid >> 6), lane = tid & 63, wr = wid >> 2, wc = wid & 3, fr = lane & 15, fq = lane >> 4;
    const int nt = K / BK;
    int Rr[2]; unsigned Cb[2], voffB[2], lo[2];
#pragma unroll
    for (int i = 0; i < 2; ++i) { int R, C; stage_rc(tid * 16 + i * 8192, R, C); const int Rb = Epi::PERM ? ((R & ~31) + perm32(R & 31)) : R;
        Rr[i] = R; Cb[i] = (unsigned)C * 2u; voffB[i] = (unsigned)(Rb * K + C) * 2u; lo[i] = (unsigned)(R * (lda_ ? lda_ : K) + C) * 2u; }
    const size_t kstep = (size_t)(BK * 2);
    const size_t hstepB = (size_t)HALF * K * 2, hstepA = (size_t)HALF * (lda_ ? lda_ : K) * 2;
    const unsigned ldsw = (unsigned)wid * 1024u;
    const int aoff = lds_byte(wr * 64 + fr, fq * 8), boff = lds_byte(wc * 32 + fr, fq * 8);
#define PG8_SA(b, h) (((b) * 2 + (h)) * HTB)
#define PG8_SB(b, h) ((4 + (b) * 2 + (h)) * HTB)
#define PG8_STAGE_B(bufoff, gbase) do { if (!(abl & 4)) _Pragma("unroll") for (int _i = 0; _i < 2; ++_i) \
        __builtin_amdgcn_global_load_lds((const unsigned*)((const char*)(gbase) + voffB[_i]), (LAS unsigned*)(lds + (bufoff) + ldsw + _i * 8192), 16, 0, 0); } while (0)
#define PG8_STAGE_A(bufoff, h, nx, kb) do { if (abl & 4) break; unsigned _o0, _o1; const char* _b; \
        if constexpr (Sched::GATHER) { _b = Abase + (size_t)(kb); _o0 = (nx) ? ((h) ? an10 : an00) : ((h) ? ac10 : ac00); _o1 = (nx) ? ((h) ? an11 : an01) : ((h) ? ac11 : ac01); } \
        else { _b = Abase + (size_t)(kb) + ((nx) ? nU : cU) + ((h) ? hstepA : (size_t)0); _o0 = lo[0]; _o1 = lo[1]; } \
        __builtin_amdgcn_global_load_lds((const unsigned*)(_b + _o0), (LAS unsigned*)(lds + (bufoff) + ldsw), 16, 0, 0); \
        __builtin_amdgcn_global_load_lds((const unsigned*)(_b + _o1), (LAS unsigned*)(lds + (bufoff) + ldsw + 8192), 16, 0, 0); } while (0)
#define PG8_LDA(dst, b, h) do { _Pragma("unroll") for (int m = 0; m < 4; ++m) _Pragma("unroll") for (int k = 0; k < 2; ++k) dst[m][k] = *(const LAS bf16x8*)(lds + PG8_SA(b, h) + aoff + m * 2048 + k * 1024); } while (0)
#define PG8_LDB(dst, b, h) do { _Pragma("unroll") for (int n = 0; n < 2; ++n) _Pragma("unroll") for (int k = 0; k < 2; ++k) dst[n][k] = *(const LAS bf16x8*)(lds + PG8_SB(b, h) + boff + n * 2048 + k * 1024); } while (0)
#define PG8_MMA(ai, bj, At, Bt) do { if (abl & 2) break; __builtin_amdgcn_s_setprio(1); _Pragma("unroll") for (int m = 0; m < 4; ++m) _Pragma("unroll") for (int n = 0; n < 2; ++n) _Pragma("unroll") for (int k = 0; k < 2; ++k) \
        acc[ai][bj][m][n] = __builtin_amdgcn_mfma_f32_16x16x32_bf16(Bt[n][k], At[m][k], acc[ai][bj][m][n], 0, 0, 0); __builtin_amdgcn_s_setprio(0); } while (0)
#define PG8_WAIT_V(n) asm volatile("s_waitcnt vmcnt(" #n ")" ::: "memory")
#define PG8_WAIT_L(n) asm volatile("s_waitcnt lgkmcnt(" #n ")" ::: "memory")
#define PG8_BAR __builtin_amdgcn_s_barrier()
#define PG8_SCHED __builtin_amdgcn_sched_barrier(0)
    Unit cur, nxt; int ui = 0;
    if (!S.next(0, cur)) return;
    f32x4 acc[2][2][4][2];
#pragma unroll
    for (int a = 0; a < 2; ++a)
#pragma unroll
        for (int b = 0; b < 2; ++b)
#pragma unroll
            for (int m = 0; m < 4; ++m)
#pragma unroll
                for (int n = 0; n < 2; ++n) acc[a][b][m][n] = (f32x4){0.f, 0.f, 0.f, 0.f};
    bf16x8 At[4][2], B0[2][2], B1[2][2];
    unsigned ac00 = 0, ac01 = 0, ac10 = 0, ac11 = 0, an00 = 0, an01 = 0, an10 = 0, an11 = 0; size_t cU = 0, nU = 0;
    if constexpr (Sched::GATHER) { ac00 = S.a_off(cur, Rr[0]) + Cb[0]; ac01 = S.a_off(cur, Rr[1]) + Cb[1]; ac10 = S.a_off(cur, HALF + Rr[0]) + Cb[0]; ac11 = S.a_off(cur, HALF + Rr[1]) + Cb[1]; }
    else cU = S.a_uni(cur);
    const char* cB = S.b_base(cur);
    PG8_STAGE_B(PG8_SB(0, 0), cB); PG8_STAGE_B(PG8_SB(0, 1), cB + hstepB); PG8_STAGE_A(PG8_SA(0, 0), 0, false, 0); PG8_STAGE_A(PG8_SA(0, 1), 1, false, 0);
    if (wr == 1) PG8_BAR;
    PG8_WAIT_V(2); PG8_BAR;
    PG8_STAGE_B(PG8_SB(1, 0), cB + kstep); PG8_STAGE_A(PG8_SA(1, 0), 0, false, kstep); PG8_STAGE_B(PG8_SB(1, 1), cB + hstepB + kstep);
    PG8_WAIT_V(6); PG8_BAR;
    for (;;) {
        const bool has_next = S.next(ui + 1, nxt);
        const char* nB = cB;
        if (has_next) {
            if constexpr (Sched::GATHER) { an00 = S.a_off(nxt, Rr[0]) + Cb[0]; an01 = S.a_off(nxt, Rr[1]) + Cb[1]; an10 = S.a_off(nxt, HALF + Rr[0]) + Cb[0]; an11 = S.a_off(nxt, HALF + Rr[1]) + Cb[1]; }
            else nU = S.a_uni(nxt);
            nB = S.b_base(nxt);
        } else { an00 = ac00; an01 = ac01; an10 = ac10; an11 = ac11; nU = cU; }
#pragma unroll 1
        for (int t = 0; t < nt; t += 2) {
            const bool last = (t == nt - 2);
            const size_t k1 = (size_t)(t + 1) * kstep;
            const size_t k2 = last ? (size_t)0 : (size_t)(t + 2) * kstep;
            const char* b2 = last ? nB : cB + (size_t)(t + 2) * kstep; const char* b3 = b2 + kstep;
            PG8_LDB(B0, 0, 0); PG8_LDB(B1, 0, 1); PG8_SCHED; PG8_LDA(At, 0, 0); PG8_STAGE_A(PG8_SA(1, 1), 1, false, k1);
            PG8_WAIT_V(8); PG8_WAIT_L(0); PG8_BAR; PG8_MMA(0, 0, At, B0); PG8_MMA(0, 1, At, B1); PG8_BAR; PG8_SCHED;
            const bool fin = last && !has_next;
            PG8_LDA(At, 0, 1);
            if (!fin) { PG8_STAGE_B(PG8_SB(0, 0), b2); PG8_STAGE_B(PG8_SB(0, 1), b2 + hstepB); PG8_STAGE_A(PG8_SA(0, 0), 0, last, k2); PG8_WAIT_V(8); } else PG8_WAIT_V(2);
            PG8_WAIT_L(0); PG8_BAR; PG8_MMA(1, 0, At, B0); PG8_MMA(1, 1, At, B1); PG8_BAR; PG8_SCHED;
            PG8_LDB(B0, 1, 0); PG8_LDB(B1, 1, 1); PG8_SCHED; PG8_LDA(At, 1, 0);
            if (!fin) { PG8_STAGE_A(PG8_SA(0, 1), 1, last, k2); PG8_WAIT_V(8); } else PG8_WAIT_V(0);
            PG8_WAIT_L(0); PG8_BAR; PG8_MMA(0, 0, At, B0); PG8_MMA(0, 1, At, B1); PG8_BAR; PG8_SCHED;
            PG8_LDA(At, 1, 1);
            if (!fin) { PG8_STAGE_B(PG8_SB(1, 0), b3); PG8_STAGE_B(PG8_SB(1, 1), b3 + hstepB); PG8_STAGE_A(PG8_SA(1, 0), 0, last, k2 + kstep); PG8_WAIT_V(8); } else PG8_WAIT_V(0);
            PG8_WAIT_L(0); PG8_BAR; PG8_MMA(1, 0, At, B0); PG8_MMA(1, 1, At, B1); PG8_BAR; PG8_SCHED;
        }
        if constexpr (Sched::GATHER) { if (ui == S.sig_after && S.sig_cnt > 0 && tid == 0) __hip_atomic_fetch_add(S.sig_ptr, (unsigned)S.sig_cnt, __ATOMIC_RELAXED, __HIP_MEMORY_SCOPE_AGENT); }
        if constexpr (ALIGN_EPI) { if (wr == 0) PG8_BAR; }
        { int fr_e = fr, fq_e = fq; asm volatile("" : "+v"(fr_e), "+v"(fq_e));
          if (!(abl & 1)) E(acc, cur, wr, wc, fr_e, fq_e); }
        if (!has_next) break;
#pragma unroll
        for (int a = 0; a < 2; ++a)
#pragma unroll
            for (int b = 0; b < 2; ++b)
#pragma unroll
                for (int m = 0; m < 4; ++m)
#pragma unroll
                    for (int n = 0; n < 2; ++n) acc[a][b][m][n] = (f32x4){0.f, 0.f, 0.f, 0.f};
        cur = nxt; cB = nB; ac00 = an00; ac01 = an01; ac10 = an10; ac11 = an11; cU = nU; ++ui;
        if constexpr (ALIGN_EPI) { if (wr == 1) PG8_BAR; }
    }
    PG8_WAIT_V(0);
    if constexpr (!ALIGN_EPI) { if (wr == 0) PG8_BAR; }
    PG8_BAR;
#undef PG8_SA
#undef PG8_SB
#undef PG8_STAGE_A
#undef PG8_STAGE_B
#undef PG8_LDA
#undef PG8_LDB
#undef PG8_MMA
#undef PG8_WAIT_V
#undef PG8_WAIT_L
#undef PG8_BAR
#undef PG8_SCHED
}

struct DenseSched {
    static constexpr bool GATHER = false;
    int nN, nwg, G, c, K, lda; unsigned a0; const char* Bt;
    __device__ __forceinline__ void init(int N, int K_, int G_, int c_, unsigned a0_, const void* Bt_, int lda_ = 0) { nN = N / BM; nwg = (NT / BM) * nN; G = G_; c = c_; K = K_; lda = lda_ ? lda_ : K_; a0 = a0_; Bt = (const char*)Bt_; }
    __device__ __forceinline__ bool next(int i, Unit& u) const {
        const int L = i * G + c; if (L >= nwg) return false;
        int wgid = L; { const int q = nwg / NXCD, r = nwg % NXCD, xcd = wgid % NXCD, off = wgid / NXCD; wgid = (xcd < r ? xcd * (q + 1) : r * (q + 1) + (xcd - r) * q) + off; }
        const int nM = NT / BM, nig = WGM * nN, gid = wgid / nig, fm = gid * WGM, gsz = (nM - fm) < WGM ? (nM - fm) : WGM;
        u.rowbase = (fm + ((wgid % nig) % gsz)) * BM; u.pn = (wgid % nig) / gsz; u.aux = 0; u.aux2 = 0; return true;
    }
    __device__ __forceinline__ size_t a_uni(const Unit& u) const { return (size_t)a0 + (size_t)u.rowbase * (size_t)(lda * 2); }
    __device__ __forceinline__ unsigned a_off(const Unit& u, int r) const { return 0u; }
    __device__ __forceinline__ const char* b_base(const Unit& u) const { return Bt + (size_t)u.pn * BM * K * 2; }
};

struct EpiQKV {
    static constexpr bool PERM = true;
    bf16_t *Q; const float *qg, *kg;
    __device__ __forceinline__ void operator()(const f32x4 (&acc)[2][2][4][2], const Unit& u, int wr, int wc, int fr, int fq) const {
        const int part = u.pn >> 2, head = (u.pn & 3) * 4 + wc;
        bf16_t* out = Q + (size_t)part * (size_t)(16 * 1024 * 1024) + head * 64 + 8 * fq;
        f32x4 g[2][2];
#pragma unroll
        for (int bj = 0; bj < 2; ++bj)
#pragma unroll
            for (int n = 0; n < 2; ++n) g[bj][n] = (f32x4){1.f, 1.f, 1.f, 1.f};
        if (part < 2) { const float* gp = (part ? kg : qg) + 8 * fq;
#pragma unroll
            for (int bj = 0; bj < 2; ++bj)
#pragma unroll
                for (int n = 0; n < 2; ++n) g[bj][n] = *(const f32x4*)(gp + 32 * bj + 4 * n); }
        const float rscale = (part == 0) ? C2 : 1.f;
#pragma unroll
        for (int ai = 0; ai < 2; ++ai)
#pragma unroll
            for (int m = 0; m < 4; ++m) {
                const int row = u.rowbase + ai * HALF + wr * 64 + m * 16 + fr;
                f32x4 v[2][2];
#pragma unroll
                for (int bj = 0; bj < 2; ++bj)
#pragma unroll
                    for (int n = 0; n < 2; ++n) v[bj][n] = acc[ai][bj][m][n];
                float ss = 0.f;
#pragma unroll
                for (int bj = 0; bj < 2; ++bj)
#pragma unroll
                    for (int n = 0; n < 2; ++n) { const f32x4 x = v[bj][n]; ss += (x[0] * x[0] + x[1] * x[1]) + (x[2] * x[2] + x[3] * x[3]); }
                ss = sum_x16(ss); ss = sum_x32(ss);
                const float r = (part < 2) ? rsqrtf(ss * (1.f / 64.f) + EPS) * rscale : 1.f;
#pragma unroll
                for (int bj = 0; bj < 2; ++bj)
#pragma unroll
                    for (int n = 0; n < 2; ++n) v[bj][n] = v[bj][n] * r * g[bj][n];
#pragma unroll
                for (int bj = 0; bj < 2; ++bj) { u32x4 w; w.x = cvt_pk_bf16(v[bj][0][0], v[bj][0][1]); w.y = cvt_pk_bf16(v[bj][0][2], v[bj][0][3]); w.z = cvt_pk_bf16(v[bj][1][0], v[bj][1][1]); w.w = cvt_pk_bf16(v[bj][1][2], v[bj][1][3]);
                    *(u32x4*)(out + (size_t)row * 1024 + 32 * bj) = w; }
            }
    }
};

struct DualSched {
    static constexpr bool GATHER = false;
    int G, c; unsigned a0; const char* Bt;
    __device__ __forceinline__ bool next(int i, Unit& u) const {
        const int L = i * G + c; if (L >= 256) return false;
        const int w = L >> 7, idx = L & 127;
        u.rowbase = (idx >> 1) * BM; u.pn = idx & 1; u.aux = w; u.aux2 = 0; return true;
    }
    __device__ __forceinline__ size_t a_uni(const Unit& u) const { return (size_t)a0 + (size_t)u.rowbase * 2048; }
    __device__ __forceinline__ unsigned a_off(const Unit& u, int r) const { return 0u; }
    __device__ __forceinline__ const char* b_base(const Unit& u) const { return Bt + ((size_t)(u.aux * 8 + (u.rowbase >> 11)) * 512 + (size_t)u.pn * BM) * 1024 * 2; }
};

template <int NTILE, bool GATHER_>
struct MoeSched {
    static constexpr bool GATHER = GATHER_;
    const LAS int* tab;
    const int* LT2; int G, c, K; unsigned a0; const char* Bt;
    int mode, skip, q0, nq; unsigned* sig_ptr; int sig_after, sig_cnt;
    __device__ __forceinline__ void shared_unit(int q, Unit& u) const { const int blk = q / NTILE; u.pn = q % NTILE; u.rowbase = PMAX + (blk << 8); u.aux = 64; u.aux2 = blk << 8; }
    __device__ __forceinline__ bool next(int i, Unit& u) const {
        if (mode == 2) { if (i >= nq) return false; shared_unit(q0 + i, u); return true; }
        int L = i * G + c;
        const int nrb = tab[64] >> 8;
        if (mode == 1) { if (L < 64 * NTILE) { shared_unit(L, u); return true; } L -= 64 * NTILE; if (L >= nrb * NTILE) return false; }
        else if (L >= nrb * NTILE) { const int q = L - nrb * NTILE + skip; if (q >= 64 * NTILE) return false; shared_unit(q, u); return true; }
        const int blk = L / NTILE; u.pn = L % NTILE;
        const int row0 = blk << 8, lane = threadIdx.x & 63;
        const unsigned long long bal = __ballot(tab[lane] <= row0);
        const int e = __builtin_popcountll(bal) - 1;
        u.rowbase = row0; u.aux = e; u.aux2 = row0 - tab[e];
        return true;
    }
    __device__ __forceinline__ size_t a_uni(const Unit& u) const { return (size_t)a0 + (size_t)u.rowbase * (size_t)(K * 2); }
    __device__ __forceinline__ unsigned a_off(const Unit& u, int r) const {
        int tok;
        if (u.aux < 64) { const int idx = u.aux2 + r; tok = 0; if (idx < tab[128 + u.aux]) tok = LT2[u.aux * 16384 + idx]; }
        else tok = u.aux2 + r;
        return a0 + (unsigned)tok * 2048u;
    }
    __device__ __forceinline__ const char* b_base(const Unit& u) const { return Bt + ((size_t)u.aux * NTILE + u.pn) * BM * K * 2; }
};

template <bool XBF>
struct EpiResid {
    static constexpr bool PERM = true;
    const void* xin; const float* MOD; int gate_off; bf16_t* out;
    __device__ __forceinline__ void operator()(const f32x4 (&acc)[2][2][4][2], const Unit& u, int wr, int wc, int fr, int fq) const {
        const int b = u.rowbase >> 11, col0 = u.pn * BM + wc * 32 + 8 * fq;
        f32x4 gt[2][2];
#pragma unroll
        for (int bj = 0; bj < 2; ++bj)
#pragma unroll
            for (int n = 0; n < 2; ++n) gt[bj][n] = *(const f32x4*)(MOD + b * MODW + gate_off + col0 + bj * HALF + n * 4);
#pragma unroll
        for (int ai = 0; ai < 2; ++ai)
#pragma unroll
            for (int m = 0; m < 4; ++m) { const size_t off = (size_t)(u.rowbase + ai * HALF + wr * 64 + m * 16 + fr) * 1024 + col0;
#pragma unroll
                for (int bj = 0; bj < 2; ++bj) {
                    f32x4 x0, x1;
                    if (XBF) { const u32x4 xw = *(const u32x4*)((const bf16_t*)xin + off + bj * HALF);
                        x0 = (f32x4){__uint_as_float(xw.x << 16), __uint_as_float(xw.x & 0xffff0000u), __uint_as_float(xw.y << 16), __uint_as_float(xw.y & 0xffff0000u)};
                        x1 = (f32x4){__uint_as_float(xw.z << 16), __uint_as_float(xw.z & 0xffff0000u), __uint_as_float(xw.w << 16), __uint_as_float(xw.w & 0xffff0000u)}; }
                    else { x0 = *(const f32x4*)((const float*)xin + off + bj * HALF); x1 = *(const f32x4*)((const float*)xin + off + bj * HALF + 4); }
                    const f32x4 v0 = x0 + gt[bj][0] * acc[ai][bj][m][0], v1 = x1 + gt[bj][1] * acc[ai][bj][m][1];
                    u32x4 w; w.x = cvt_pk_bf16(v0[0], v0[1]); w.y = cvt_pk_bf16(v0[2], v0[3]); w.z = cvt_pk_bf16(v1[0], v1[1]); w.w = cvt_pk_bf16(v1[2], v1[3]);
                    *(u32x4*)(out + off + bj * HALF) = w; } }
    }
};
struct EpiBf16 {
    static constexpr bool PERM = true;
    bf16_t* O; int ldo; size_t sel_stride; const LAS int* tab;
    __device__ __forceinline__ void operator()(const f32x4 (&acc)[2][2][4][2], const Unit& u, int wr, int wc, int fr, int fq) const {
        bf16_t* base = O + (size_t)u.aux * sel_stride + u.pn * BM + wc * 32 + 8 * fq;
        const int nvalid = (tab && u.aux < 64) ? tab[128 + u.aux] - u.aux2 : 256;
#pragma unroll
        for (int ai = 0; ai < 2; ++ai)
#pragma unroll
            for (int m = 0; m < 4; ++m) { const int lr = ai * HALF + wr * 64 + m * 16 + fr; if (lr >= nvalid) continue; bf16_t* rowp = base + (size_t)(u.rowbase + lr) * ldo;
#pragma unroll
                for (int bj = 0; bj < 2; ++bj) { const f32x4 v0 = acc[ai][bj][m][0], v1 = acc[ai][bj][m][1];
                    u32x4 w; w.x = cvt_pk_bf16(v0[0], v0[1]); w.y = cvt_pk_bf16(v0[2], v0[3]); w.z = cvt_pk_bf16(v1[0], v1[1]); w.w = cvt_pk_bf16(v1[2], v1[3]);
                    *(u32x4*)(rowp + bj * HALF) = w; } }
    }
};
struct EpiDown {
    static constexpr bool PERM = true, DEFER = false;
    bf16_t* O; const float* RSTD; const float* CB; float* SSQ; float* KPSS; float* KPR; const float* ROPE; const float* gk;
    __device__ __forceinline__ void operator()(const f32x4 (&acc)[2][2][4][2], const Unit& u, int wr, int wc, int fr, int fq) const {
        const int col0 = u.pn * BM + wc * 32 + 8 * fq;
        bf16_t* base = O + (size_t)u.aux * (size_t)(8 * 1024 * 1024) + col0;
        const float* cb = CB + ((u.rowbase >> 11) * 2 + u.aux) * 512 + col0;
        f32x4 bs[2][2];
#pragma unroll
        for (int bj = 0; bj < 2; ++bj)
#pragma unroll
            for (int n = 0; n < 2; ++n) bs[bj][n] = *(const f32x4*)(cb + bj * HALF + n * 4);
        const bool ropew = (u.aux == 0) && (u.pn == 1) && (wc == 0);
        f32x4 g0 = (f32x4){0.f, 0.f, 0.f, 0.f}, g1 = g0;
        if (ropew) { g0 = *(const f32x4*)(gk + 64 + 8 * fq); g1 = *(const f32x4*)(gk + 64 + 8 * fq + 4); }
#pragma unroll
        for (int ai = 0; ai < 2; ++ai)
#pragma unroll
            for (int m = 0; m < 4; ++m) { const int row = u.rowbase + ai * HALF + wr * 64 + m * 16 + fr; const float r = RSTD[row]; bf16_t* rowp = base + (size_t)row * 512;
                f32x4 v[2][2];
#pragma unroll
                for (int bj = 0; bj < 2; ++bj) { v[bj][0] = acc[ai][bj][m][0] * r + bs[bj][0]; v[bj][1] = acc[ai][bj][m][1] * r + bs[bj][1];
                    u32x4 w; w.x = cvt_pk_bf16(v[bj][0][0], v[bj][0][1]); w.y = cvt_pk_bf16(v[bj][0][2], v[bj][0][3]); w.z = cvt_pk_bf16(v[bj][1][0], v[bj][1][1]); w.w = cvt_pk_bf16(v[bj][1][2], v[bj][1][3]);
                    *(u32x4*)(rowp + bj * HALF) = w; }
                float ss = ((v[0][0][0] * v[0][0][0] + v[0][0][1] * v[0][0][1]) + (v[0][0][2] * v[0][0][2] + v[0][0][3] * v[0][0][3])) + ((v[0][1][0] * v[0][1][0] + v[0][1][1] * v[0][1][1]) + (v[0][1][2] * v[0][1][2] + v[0][1][3] * v[0][1][3]));
                if (u.pn == 0) ss += ((v[1][0][0] * v[1][0][0] + v[1][0][1] * v[1][0][1]) + (v[1][0][2] * v[1][0][2] + v[1][0][3] * v[1][0][3])) + ((v[1][1][0] * v[1][1][0] + v[1][1][1] * v[1][1][1]) + (v[1][1][2] * v[1][1][2] + v[1][1][3] * v[1][1][3]));
                ss = sum_x16(ss); ss = sum_x32(ss);
                if (!(u.aux == 0 && u.pn == 1)) { if (fq == 0) SSQ[(size_t)row * 16 + u.aux * 8 + u.pn * 4 + wc] = ss; }
                else if (ropew) {
                    if (fq == 0) KPSS[row] = ss;
                    const f32x4 kg0 = v[0][0] * g0, kg1 = v[0][1] * g1;
                    f32x4 kx0, kx1;
#pragma unroll
                    for (int j = 0; j < 4; ++j) {
                        const auto a = __builtin_amdgcn_permlane32_swap(__float_as_int(kg0[j]), __float_as_int(kg0[j]), false, false);
                        const auto b = __builtin_amdgcn_permlane32_swap(__float_as_int(kg1[j]), __float_as_int(kg1[j]), false, false);
                        kx0[j] = (fq & 2) ? __int_as_float(a[0]) : __int_as_float(a[1]); kx1[j] = (fq & 2) ? __int_as_float(b[0]) : __int_as_float(b[1]); }
                    const float* cp = ROPE + (size_t)row * 16 + 8 * (fq & 1); const float* sp = cp + (size_t)NT * 16;
                    const f32x4 c0 = *(const f32x4*)cp, c1 = *(const f32x4*)(cp + 4), s0 = *(const f32x4*)sp, s1 = *(const f32x4*)(sp + 4);
                    const float sg = (fq & 2) ? 1.f : -1.f;
                    *(f32x4*)(KPR + (size_t)row * 32 + 8 * fq) = kg0 * c0 + kx0 * s0 * sg;
                    *(f32x4*)(KPR + (size_t)row * 32 + 8 * fq + 4) = kg1 * c1 + kx1 * s1 * sg;
                } }
    }
};
struct EpiQ {
    static constexpr bool PERM = true;
    bf16_t* O; const float* SSQ;
    __device__ __forceinline__ void operator()(const f32x4 (&acc)[2][2][4][2], const Unit& u, int wr, int wc, int fr, int fq) const {
        bf16_t* base = O + u.pn * BM + wc * 32 + 8 * fq;
        f32x4 sa[2][4], sb[2][4];
#pragma unroll
        for (int ai = 0; ai < 2; ++ai)
#pragma unroll
            for (int m = 0; m < 4; ++m) { const int row = u.rowbase + ai * HALF + wr * 64 + m * 16 + fr;
                sa[ai][m] = *(const f32x4*)(SSQ + (size_t)row * 16 + 8); sb[ai][m] = *(const f32x4*)(SSQ + (size_t)row * 16 + 12); }
#pragma unroll
        for (int ai = 0; ai < 2; ++ai)
#pragma unroll
            for (int m = 0; m < 4; ++m) { const int row = u.rowbase + ai * HALF + wr * 64 + m * 16 + fr; bf16_t* rowp = base + (size_t)row * 1536;
                const f32x4 a4 = sa[ai][m], b4 = sb[ai][m];
                const float r = rsqrtf((((a4[0] + a4[1]) + (a4[2] + a4[3])) + ((b4[0] + b4[1]) + (b4[2] + b4[3]))) * (1.f / 384.f) + EPS);
#pragma unroll
                for (int bj = 0; bj < 2; ++bj) { const f32x4 v0 = acc[ai][bj][m][0] * r, v1 = acc[ai][bj][m][1] * r;
                    u32x4 w; w.x = cvt_pk_bf16(v0[0], v0[1]); w.y = cvt_pk_bf16(v0[2], v0[3]); w.z = cvt_pk_bf16(v1[0], v1[1]); w.w = cvt_pk_bf16(v1[2], v1[3]);
                    *(u32x4*)(rowp + bj * HALF) = w; } }
    }
};
constexpr float YB_SCALE = 8.f, YB_CLAMP = 440.f;
struct EpiYB {
    static constexpr bool PERM = true;
    unsigned char* O; const LAS int* tab;
    __device__ __forceinline__ void operator()(const f32x4 (&acc)[2][2][4][2], const Unit& u, int wr, int wc, int fr, int fq) const {
        unsigned char* base = O + u.pn * BM + wc * 64 + 16 * fq;
        const int nvalid = (u.aux < 64) ? tab[128 + u.aux] - u.aux2 : 256;
#pragma unroll
        for (int ai = 0; ai < 2; ++ai)
#pragma unroll
            for (int m = 0; m < 4; ++m) { const int lr = ai * HALF + wr * 64 + m * 16 + fr; if (lr >= nvalid) continue;
                int w[4];
#pragma unroll
                for (int bj = 0; bj < 2; ++bj)
#pragma unroll
                    for (int n = 0; n < 2; ++n) { f32x4 v = acc[ai][bj][m][n] * YB_SCALE;
#pragma unroll
                        for (int j = 0; j < 4; ++j) v[j] = __builtin_amdgcn_fmed3f(v[j], -YB_CLAMP, YB_CLAMP);
                        int q = 0; q = __builtin_amdgcn_cvt_pk_fp8_f32(v[0], v[1], q, false); q = __builtin_amdgcn_cvt_pk_fp8_f32(v[2], v[3], q, true); w[bj * 2 + n] = q; }
                u32x4 o; o.x = (unsigned)w[0]; o.y = (unsigned)w[1]; o.z = (unsigned)w[2]; o.w = (unsigned)w[3];
                *(u32x4*)(base + (size_t)(u.rowbase + lr) * 1024) = o; }
    }
};
struct EpiSwiglu {
    static constexpr bool PERM = true;
    bf16_t* ACT; const LAS int* tab;
    __device__ __forceinline__ void operator()(const f32x4 (&acc)[2][2][4][2], const Unit& u, int wr, int wc, int fr, int fq) const {
        bf16_t* base = ACT + u.pn * 128 + wc * 32 + 8 * fq;
        const int nvalid = (u.aux < 64) ? tab[128 + u.aux] - u.aux2 : 256;
#pragma unroll
        for (int ai = 0; ai < 2; ++ai)
#pragma unroll
            for (int m = 0; m < 4; ++m) { const int lr = ai * HALF + wr * 64 + m * 16 + fr; if (lr >= nvalid) continue; bf16_t* rowp = base + (size_t)(u.rowbase + lr) * 256;
                f32x4 a[2];
#pragma unroll
                for (int n = 0; n < 2; ++n) { const f32x4 g = acc[ai][0][m][n], uu = acc[ai][1][m][n];
#pragma unroll
                    for (int j = 0; j < 4; ++j) a[n][j] = g[j] * __builtin_amdgcn_rcpf(1.f + __expf(-g[j])) * uu[j]; }
                u32x4 w; w.x = cvt_pk_bf16(a[0][0], a[0][1]); w.y = cvt_pk_bf16(a[0][2], a[0][3]); w.z = cvt_pk_bf16(a[1][0], a[1][1]); w.w = cvt_pk_bf16(a[1][2], a[1][3]);
                st16(rowp, w, u.aux == 64); }
    }
};
struct EpiKV {
    static constexpr bool PERM = true;
    bf16_t *KM, *VM; const float *KPSS, *KPR, *gk, *SSQ;
    __device__ __forceinline__ void operator()(const f32x4 (&acc)[2][2][4][2], const Unit& u, int wr, int wc, int fr, int fq) const {
        const bool isk = u.pn < 4; const int head = (u.pn & 3) * 4 + wc;
        f32x4 g[2][2];
#pragma unroll
        for (int bj = 0; bj < 2; ++bj)
#pragma unroll
            for (int n = 0; n < 2; ++n) g[bj][n] = isk ? *(const f32x4*)(gk + 32 * bj + 8 * fq + 4 * n) : (f32x4){1.f, 1.f, 1.f, 1.f};
        f32x4 slv[2][4]; float kpv[2][4];
#pragma unroll
        for (int ai = 0; ai < 2; ++ai)
#pragma unroll
            for (int m = 0; m < 4; ++m) { const int row = u.rowbase + ai * HALF + wr * 64 + m * 16 + fr; slv[ai][m] = *(const f32x4*)(SSQ + (size_t)row * 16); kpv[ai][m] = isk ? KPSS[row] : 0.f; }
#pragma unroll
        for (int ai = 0; ai < 2; ++ai)
#pragma unroll
            for (int m = 0; m < 4; ++m) {
                const int row = u.rowbase + ai * HALF + wr * 64 + m * 16 + fr;
                float ss = 0.f;
#pragma unroll
                for (int bj = 0; bj < 2; ++bj)
#pragma unroll
                    for (int n = 0; n < 2; ++n) { const f32x4 x = acc[ai][bj][m][n]; ss += (x[0] * x[0] + x[1] * x[1]) + (x[2] * x[2] + x[3] * x[3]); }
                ss = sum_x16(ss); ss = sum_x32(ss);
                const f32x4 sl = slv[ai][m];
                const float rl = rsqrtf(((sl[0] + sl[1]) + (sl[2] + sl[3])) * (1.f / 256.f) + EPS);
                const float rk = isk ? rsqrtf((ss * rl * rl + kpv[ai][m]) * (1.f / 96.f) + EPS) : 1.f, r = rl * rk;
                bf16_t* o = isk ? KM + ((size_t)row * 16 + head) * 96 + 8 * fq : VM + (size_t)row * 1024 + head * 64 + 8 * fq;
#pragma unroll
                for (int bj = 0; bj < 2; ++bj) { const f32x4 v0 = acc[ai][bj][m][0] * r * g[bj][0], v1 = acc[ai][bj][m][1] * r * g[bj][1];
                    u32x4 w; w.x = cvt_pk_bf16(v0[0], v0[1]); w.y = cvt_pk_bf16(v0[2], v0[3]); w.z = cvt_pk_bf16(v1[0], v1[1]); w.w = cvt_pk_bf16(v1[2], v1[3]);
                    *(u32x4*)(o + 32 * bj) = w; }
                if (isk) { const f32x4 p0 = *(const f32x4*)(KPR + (size_t)row * 32 + 8 * fq) * rk, p1 = *(const f32x4*)(KPR + (size_t)row * 32 + 8 * fq + 4) * rk;
                    u32x4 w; w.x = cvt_pk_bf16(p0[0], p0[1]); w.y = cvt_pk_bf16(p0[2], p0[3]); w.z = cvt_pk_bf16(p1[0], p1[1]); w.w = cvt_pk_bf16(p1[2], p1[3]);
                    *(u32x4*)(o + 64) = w; }
            }
    }
};
}

#define XB_TMO      128
#define XB_XCNT(j)  (256  + 64 * (j))
#define XB_XSUB(j)  (1280 + 64 * (j))
#define XB_XGEN(j)  (2304 + 64 * (j))
#define XB_TOP      3328
#define XB_TOPGEN   3392
#define XCD_BAR_WORDS 3456
#define XB_SPIN_CAP (1u << 18)
__device__ __forceinline__ unsigned xb_ld(unsigned* p)              { return __hip_atomic_load(p, __ATOMIC_RELAXED, __HIP_MEMORY_SCOPE_AGENT); }
__device__ __forceinline__ unsigned xb_add(unsigned* p, unsigned v) { return __hip_atomic_fetch_add(p, v, __ATOMIC_RELAXED, __HIP_MEMORY_SCOPE_AGENT); }
__device__ __forceinline__ unsigned xb_xcc_id() { return (unsigned)__builtin_amdgcn_s_getreg((3 << 11) | 20) & 0xFu; }
#define XB_SPIN(cond, bar) do { unsigned _sp = 0; while (cond) { __builtin_amdgcn_s_sleep(1); \
    if ((++_sp & 255u) == 0u) { if (xb_ld(&(bar)[XB_TMO])) break; if (_sp > XB_SPIN_CAP) { atomicAdd(&(bar)[XB_TMO], 1u); break; } } } } while (0)
struct XcdBarrier { unsigned* bar; unsigned x; volatile LAS unsigned* st; };
__device__ __forceinline__ XcdBarrier xcd_barrier_post(unsigned* bar, volatile LAS unsigned* st) {
    XcdBarrier b; b.bar = bar; b.x = xb_xcc_id(); b.st = st;
    if (threadIdx.x == 0) (void)xb_add(&bar[XB_XCNT(b.x)], 1u);
    return b;
}
__device__ __forceinline__ void xcd_barrier_complete(unsigned* bar, unsigned x, unsigned& nloc, unsigned& nx) {
    const unsigned G = gridDim.x * gridDim.y * gridDim.z;
    unsigned sum, cnt, mine, sp = 0u;
    for (;;) {
        sum = 0u; cnt = 0u; mine = 0u;
#pragma unroll
        for (unsigned j = 0; j < 16; ++j) { const unsigned c = xb_ld(&bar[XB_XCNT(j)]); sum += c; cnt += (c > 0u) ? 1u : 0u; mine = (j == x) ? c : mine; }
        if (sum == G) break;
        __builtin_amdgcn_s_sleep(1);
        if ((++sp & 255u) == 0u) { if (xb_ld(&bar[XB_TMO])) break; if (sp > XB_SPIN_CAP) { atomicAdd(&bar[XB_TMO], 1u); break; } }
    }
    nloc = mine > 0u ? mine : 1u; nx = cnt > 0u ? cnt : 1u;
}
__device__ __forceinline__ void xcd_barrier(const XcdBarrier& b) {
    asm volatile("s_waitcnt vmcnt(0)" ::: "memory");
    __syncthreads();
    if (threadIdx.x == 0) {
        unsigned* bar = b.bar;
        __builtin_amdgcn_s_waitcnt(0);
        unsigned nloc = b.st[0], nx = b.st[1];
        if (nloc == 0u) { xcd_barrier_complete(bar, b.x, nloc, nx); b.st[0] = nloc; b.st[1] = nx; }
        const unsigned old = xb_add(&bar[XB_XSUB(b.x)], 1u);
        const unsigned gen = old / nloc;
        if (old + 1u == (gen + 1u) * nloc) {
            __builtin_amdgcn_fence(__ATOMIC_RELEASE, "agent");
            asm volatile("s_waitcnt vmcnt(0)" ::: "memory");
            __builtin_amdgcn_fence(__ATOMIC_ACQUIRE, "agent");
            const unsigned og = xb_add(&bar[XB_TOP], 1u);
            const unsigned tg = og / nx;
            if (og + 1u == (tg + 1u) * nx) xb_add(&bar[XB_TOPGEN], 1u);
            else XB_SPIN(xb_ld(&bar[XB_TOPGEN]) == tg, bar);
            xb_add(&bar[XB_XGEN(b.x)], 1u);
            asm volatile("s_waitcnt vmcnt(0)" ::: "memory");
        } else {
            __builtin_amdgcn_fence(__ATOMIC_ACQUIRE, "agent");
            XB_SPIN(xb_ld(&bar[XB_XGEN(b.x)]) == gen, bar);
            asm volatile("s_waitcnt vmcnt(0)" ::: "memory");
        }
    }
    __syncthreads();
}


namespace at {
typedef float f32x16 __attribute__((ext_vector_type(16)));
typedef short s16x4 __attribute__((ext_vector_type(4)));
__device__ __forceinline__ int crow(int r, int hi) { return (r & 3) + 8 * (r >> 2) + 4 * hi; }
__device__ __forceinline__ s16x4 vtr(const LAS unsigned char* p) { return __builtin_bit_cast(s16x4, __builtin_amdgcn_ds_read_tr16_b64_v4i16((LAS s16x4*)p)); }
__device__ __forceinline__ float bflo(unsigned u) { return __uint_as_float(u << 16); }
__device__ __forceinline__ float bfhi(unsigned u) { return __uint_as_float(u & 0xffff0000u); }

__device__ __forceinline__ void v_frags(bf16x8 (&vf)[8], const LAS unsigned char* vlane) {
#pragma unroll
    for (int d0 = 0; d0 < 2; ++d0)
#pragma unroll
        for (int ks = 0; ks < 4; ++ks) {
            const s16x4 lo = vtr(vlane + d0 * 4096 + ks * 1024), hi = vtr(vlane + d0 * 4096 + ks * 1024 + 512);
            vf[d0 * 4 + ks] = (bf16x8){lo[0], lo[1], lo[2], lo[3], hi[0], hi[1], hi[2], hi[3]};
        }
}
__device__ __forceinline__ void v_frags_half(bf16x8 (&vf)[4], const LAS unsigned char* vlane, int d0) {
#pragma unroll
    for (int ks = 0; ks < 4; ++ks) {
        const s16x4 lo = vtr(vlane + d0 * 4096 + ks * 1024), hi = vtr(vlane + d0 * 4096 + ks * 1024 + 512);
        vf[ks] = (bf16x8){lo[0], lo[1], lo[2], lo[3], hi[0], hi[1], hi[2], hi[3]};
    }
}
__device__ __forceinline__ void pv_mma_half(f32x16& o, const bf16x8 (&vf)[4], const u32x4 (&pw)[4]) {
    __builtin_amdgcn_s_setprio(1);
#pragma unroll
    for (int ks = 0; ks < 4; ++ks) o = __builtin_amdgcn_mfma_f32_32x32x16_bf16(__builtin_bit_cast(bf16x8, pw[ks]), vf[ks], o, 0, 0, 0);
    __builtin_amdgcn_s_setprio(0);
}
__device__ __forceinline__ void pv_mma(f32x16 (&o)[2], const bf16x8 (&vf)[8], const u32x4 (&pw)[4]) {
    __builtin_amdgcn_s_setprio(1);
#pragma unroll
    for (int ks = 0; ks < 4; ++ks)
#pragma unroll
        for (int d0 = 0; d0 < 2; ++d0) o[d0] = __builtin_amdgcn_mfma_f32_32x32x16_bf16(__builtin_bit_cast(bf16x8, pw[ks]), vf[d0 * 4 + ks], o[d0], 0, 0, 0);
    __builtin_amdgcn_s_setprio(0);
}
constexpr float SM_THR = 8.f;
__device__ __forceinline__ bool softmax_step(f32x16& p0, f32x16& p1, float& mhat, float& l, f32x16 (&o)[2], u32x4 (&pw)[4], LAS float* wsf, int r32, int hi, bool first) {
    float a = fmaxf(fmaxf(p0[0], p1[0]), fmaxf(p0[1], p1[1]));
#pragma unroll
    for (int r = 2; r < 16; r += 2) a = fmaxf(a, fmaxf(fmaxf(p0[r], p1[r]), fmaxf(p0[r + 1], p1[r + 1])));
    a = max_x32(a);
    const bool moved = first || __any(a > SM_THR);
    if (moved) {
        const float dl = first ? a : fmaxf(a, 0.f);
        mhat += dl;
#pragma unroll
        for (int r = 0; r < 16; ++r) { p0[r] -= dl; p1[r] -= dl; }
        if (!first) {
            const float f = __builtin_amdgcn_exp2f(-dl);
            l *= f;
            if (hi == 0) wsf[r32] = f;
            asm volatile("s_waitcnt lgkmcnt(0)" ::: "memory");
#pragma unroll
            for (int g = 0; g < 4; ++g) { const f32x4 al = *(const LAS f32x4*)(wsf + 8 * g + 4 * hi);
#pragma unroll
                for (int j = 0; j < 4; ++j) { o[0][4 * g + j] *= al[j]; o[1][4 * g + j] *= al[j]; } }
        }
    }
    f32x2 sa = (f32x2){0.f, 0.f}, sb = (f32x2){0.f, 0.f};
#pragma unroll
    for (int r = 0; r < 16; r += 2) {
        p0[r] = __builtin_amdgcn_exp2f(p0[r]); p0[r + 1] = __builtin_amdgcn_exp2f(p0[r + 1]); p1[r] = __builtin_amdgcn_exp2f(p1[r]); p1[r + 1] = __builtin_amdgcn_exp2f(p1[r + 1]);
        sa += (f32x2){p0[r], p0[r + 1]}; sb += (f32x2){p1[r], p1[r + 1]};
    }
    sa += sb; l += sa.x + sa.y;
#pragma unroll
    for (int k = 0; k < 2; ++k) {
        pw[k].x = cvt_pk_bf16(p0[8 * k + 0], p0[8 * k + 1]); pw[k].y = cvt_pk_bf16(p0[8 * k + 2], p0[8 * k + 3]); pw[k].z = cvt_pk_bf16(p0[8 * k + 4], p0[8 * k + 5]); pw[k].w = cvt_pk_bf16(p0[8 * k + 6], p0[8 * k + 7]);
        pw[2 + k].x = cvt_pk_bf16(p1[8 * k + 0], p1[8 * k + 1]); pw[2 + k].y = cvt_pk_bf16(p1[8 * k + 2], p1[8 * k + 3]); pw[2 + k].z = cvt_pk_bf16(p1[8 * k + 4], p1[8 * k + 5]); pw[2 + k].w = cvt_pk_bf16(p1[8 * k + 6], p1[8 * k + 7]);
    }    return moved;
}
template <int S> __device__ __forceinline__ float dpp_xor(float v) {
    const int iv = __float_as_int(v);
    if (S == 1) return __int_as_float(__builtin_amdgcn_update_dpp(iv, iv, 0xB1, 0xF, 0xF, false));
    if (S == 2) return __int_as_float(__builtin_amdgcn_update_dpp(iv, iv, 0x4E, 0xF, 0xF, false));
    const int t = __builtin_amdgcn_update_dpp(iv, iv, 0x141, 0xF, 0xF, false);
    return __int_as_float(__builtin_amdgcn_update_dpp(t, t, 0x1B, 0xF, 0xF, false));
}
struct Frag16 { float v[16]; };
template <int S> __device__ __forceinline__ void tr_stage(Frag16& x, bool up) {
#pragma unroll
    for (int a = 0; a < 16; ++a) if ((a & S) == 0) { const float lo_ = x.v[a], hi_ = x.v[a + S]; const float got = dpp_xor<S>(up ? lo_ : hi_); x.v[a] = up ? got : lo_; x.v[a + S] = up ? hi_ : got; }
}
__device__ __forceinline__ Frag16 tr8x16(const f32x16& in, int lane) {
    Frag16 x;
#pragma unroll
    for (int a = 0; a < 16; ++a) x.v[a] = in[a];
    tr_stage<1>(x, (lane & 1) != 0); tr_stage<2>(x, (lane & 2) != 0); tr_stage<4>(x, (lane & 4) != 0); return x;
}
__device__ __forceinline__ u32x4 pack8(const Frag16& x, int base, float sc) {
    u32x4 w; w.x = cvt_pk_bf16(x.v[base] * sc, x.v[base + 1] * sc); w.y = cvt_pk_bf16(x.v[base + 2] * sc, x.v[base + 3] * sc); w.z = cvt_pk_bf16(x.v[base + 4] * sc, x.v[base + 5] * sc); w.w = cvt_pk_bf16(x.v[base + 6] * sc, x.v[base + 7] * sc); return w;
}
__device__ __forceinline__ void finish_store(f32x16 (&o)[2], float l, LAS float* wsf, int r32, int hi, bf16_t* Orow0, size_t ostride) {
    l = sum_x32(l);
    if (hi == 0) wsf[32 + r32] = l;
    asm volatile("s_waitcnt lgkmcnt(0)" ::: "memory");
    const int i = r32 & 7, grp = r32 >> 3, rowA = 8 * (i >> 2) + 4 * hi + (i & 3), rowB = rowA + 16;
    const float rlA = __builtin_amdgcn_rcpf(wsf[32 + rowA]), rlB = __builtin_amdgcn_rcpf(wsf[32 + rowB]);
#pragma unroll
    for (int d0 = 0; d0 < 2; ++d0) {
        const Frag16 t = tr8x16(o[d0], r32);
        *(GAS u32x4*)(Orow0 + (size_t)rowA * ostride + 32 * d0 + 8 * grp) = pack8(t, 0, rlA);
        *(GAS u32x4*)(Orow0 + (size_t)rowB * ostride + 32 * d0 + 8 * grp) = pack8(t, 8, rlB);
    }
}

constexpr int MLA_KB = 12288, MLA_BUF = 20480;
template <class BG>
__device__ __forceinline__ void mla_unit(LAS unsigned char* lds, int b, int h, int qb, const bf16_t* QR, const bf16_t* KM, const bf16_t* VM, const float* ROPE, const float* gq, bf16_t* OB, BG& bg, const int abl = 0) {
    int tid = threadIdx.x; asm volatile("" : "+v"(tid));
    const int lane = tid & 63, r32 = lane & 31, hi = lane >> 5, wid = __builtin_amdgcn_readfirstlane(tid >> 6);
    const int q0 = qb * 256, NTL = 4 * (qb + 1), rowbase = b * SEQ;
    LAS float* wsf = (LAS float*)(lds + 4 * MLA_BUF) + wid * 64;
    const bf16_t* kg0 = KM + ((size_t)(rowbase + lane) * 16 + h) * 96 + wid * 8;
    const bf16_t* kg1 = KM + ((size_t)(rowbase + lane) * 16 + h) * 96 + (8 + (wid & 3)) * 8;
    const bf16_t* vg = VM + (size_t)(rowbase + 16 * (wid & 3) + (lane >> 2)) * 1024 + h * 64 + (wid >> 2) * 32 + (lane & 3) * 8;
    const int kl0 = wid * 1024 + lane * 16, kl1 = (8 + (wid & 3)) * 1024 + lane * 16, vl = MLA_KB + wid * 1024 + lane * 16;
    u32x4 ak0, ak1, av, bk0, bk1, bv; ak1 = (u32x4){0u, 0u, 0u, 0u}; bk1 = ak1;
#define MLA_LOAD(S, t) do { S##k0 = *(const GAS u32x4*)(kg0 + (size_t)(t) * 64 * 1536); if (wid < 4) S##k1 = *(const GAS u32x4*)(kg1 + (size_t)(t) * 64 * 1536); S##v = *(const GAS u32x4*)(vg + (size_t)(t) * 64 * 1024); } while (0)
#define MLA_WRITE(S, buf) do { *(LAS u32x4*)(lds + (buf) * MLA_BUF + kl0) = S##k0; if (wid < 4) *(LAS u32x4*)(lds + (buf) * MLA_BUF + kl1) = S##k1; *(LAS u32x4*)(lds + (buf) * MLA_BUF + vl) = S##v; } while (0)
    MLA_LOAD(a, 0); MLA_LOAD(b, 1);
    bf16x8 qr[6];
    {
        const int qrow = rowbase + q0 + wid * 32 + r32;
        const bf16_t* qp = QR + (size_t)qrow * 1536 + h * 96 + hi * 8;
        float qf[6][8]; float ss = 0.f;
#pragma unroll
        for (int d0 = 0; d0 < 6; ++d0) { const u32x4 w = *(const GAS u32x4*)(qp + 16 * d0);
            qf[d0][0] = bflo(w.x); qf[d0][1] = bfhi(w.x); qf[d0][2] = bflo(w.y); qf[d0][3] = bfhi(w.y); qf[d0][4] = bflo(w.z); qf[d0][5] = bfhi(w.z); qf[d0][6] = bflo(w.w); qf[d0][7] = bfhi(w.w);
#pragma unroll
            for (int j = 0; j < 8; ++j) ss += qf[d0][j] * qf[d0][j]; }
        ss = sum_x32(ss);
        const float rn = rsqrtf(ss * (1.f / 96.f) + EPS) * C3;
#pragma unroll
        for (int d0 = 0; d0 < 6; ++d0) { const f32x4 g0 = *(const GAS f32x4*)(gq + 16 * d0 + 8 * hi), g1 = *(const GAS f32x4*)(gq + 16 * d0 + 8 * hi + 4);
#pragma unroll
            for (int j = 0; j < 4; ++j) { qf[d0][j] *= rn * g0[j]; qf[d0][4 + j] *= rn * g1[j]; } }
        { const f32x4 c0 = *(const GAS f32x4*)(ROPE + (size_t)qrow * 16 + 8 * hi), c1 = *(const GAS f32x4*)(ROPE + (size_t)qrow * 16 + 8 * hi + 4);
          const f32x4 s0 = *(const GAS f32x4*)(ROPE + (size_t)NT * 16 + (size_t)qrow * 16 + 8 * hi), s1 = *(const GAS f32x4*)(ROPE + (size_t)NT * 16 + (size_t)qrow * 16 + 8 * hi + 4);
#pragma unroll
          for (int j = 0; j < 8; ++j) { const float cs = j < 4 ? c0[j & 3] : c1[j & 3], sn = j < 4 ? s0[j & 3] : s1[j & 3]; const float t1 = qf[4][j], t2 = qf[5][j];
              qf[4][j] = t1 * cs - t2 * sn; qf[5][j] = t1 * sn + t2 * cs; } }
#pragma unroll
        for (int d0 = 0; d0 < 6; ++d0) { u32x4 w; w.x = cvt_pk_bf16(qf[d0][0], qf[d0][1]); w.y = cvt_pk_bf16(qf[d0][2], qf[d0][3]); w.z = cvt_pk_bf16(qf[d0][4], qf[d0][5]); w.w = cvt_pk_bf16(qf[d0][6], qf[d0][7]);
            qr[d0] = __builtin_bit_cast(bf16x8, w); }
    }
    MLA_WRITE(a, 0); MLA_WRITE(b, 1);
    MLA_LOAD(a, 2); MLA_LOAD(b, 3);
    __syncthreads();
    float m = 0.f, l = 0.f; f32x16 o[2], negm;
#pragma unroll
    for (int r = 0; r < 16; ++r) { o[0][r] = 0.f; o[1][r] = 0.f; negm[r] = 0.f; }
    const int qabs = q0 + wid * 32 + r32, qmax_w = q0 + wid * 32 + 31;
    const int voff = MLA_KB + ((lane >> 4) & 1) * 32 + (lane & 3) * 8 + (4 * hi + ((lane & 15) >> 2)) * 64;
#define MLA_TILE(t, buf) do { \
        if (64 * (t) <= qmax_w && !(abl & 1)) {                      \
            const LAS unsigned char* kb = lds + (buf) * MLA_BUF + hi * 1024 + r32 * 16; \
            bf16x8 kf[12]; \
            _Pragma("unroll") for (int d0 = 0; d0 < 6; ++d0) { kf[2 * d0] = *(const LAS bf16x8*)(kb + d0 * 2048); kf[2 * d0 + 1] = *(const LAS bf16x8*)(kb + d0 * 2048 + 512); } \
            f32x16 p0, p1; \
            __builtin_amdgcn_sched_barrier(0); \
            __builtin_amdgcn_s_setprio(1); \
            p0 = __builtin_amdgcn_mfma_f32_32x32x16_bf16(kf[0], qr[0], negm, 0, 0, 0);     \
            p1 = __builtin_amdgcn_mfma_f32_32x32x16_bf16(kf[1], qr[0], negm, 0, 0, 0); \
            _Pragma("unroll") for (int d0 = 1; d0 < 6; ++d0) { \
                p0 = __builtin_amdgcn_mfma_f32_32x32x16_bf16(kf[2 * d0], qr[d0], p0, 0, 0, 0); \
                p1 = __builtin_amdgcn_mfma_f32_32x32x16_bf16(kf[2 * d0 + 1], qr[d0], p1, 0, 0, 0); } \
            __builtin_amdgcn_s_setprio(0); \
            bf16x8 vf[8]; \
            v_frags(vf, lds + (buf) * MLA_BUF + voff); \
            __builtin_amdgcn_sched_barrier(0); \
            if (64 * (t) + 63 > q0 + wid * 32) {                     \
                _Pragma("unroll") for (int r = 0; r < 16; ++r) { const int kv = 64 * (t) + crow(r, hi); if (kv > qabs) p0[r] = -INFINITY; if (kv + 32 > qabs) p1[r] = -INFINITY; } } \
            u32x4 pw[4]; \
            if (softmax_step(p0, p1, m, l, o, pw, wsf, r32, hi, (t) == 0)) { _Pragma("unroll") for (int r = 0; r < 16; ++r) negm[r] = -m; } \
            __builtin_amdgcn_sched_barrier(0); \
            pv_mma(o, vf, pw); \
        } } while (0)
#pragma unroll 1
    for (int t = 0; t < NTL; t += 2) {
        const int pr = (t >> 1) & 1;
        if (!(abl & 4)) bg.step();
        MLA_TILE(t, 2 * pr);
        MLA_TILE(t + 1, 2 * pr + 1);
        if (t + 2 < NTL && !(abl & 2)) {
            MLA_WRITE(a, 2 * (pr ^ 1)); MLA_WRITE(b, 2 * (pr ^ 1) + 1);
            if (t + 4 < NTL) { MLA_LOAD(a, t + 4); MLA_LOAD(b, t + 5); }
        }
        __syncthreads();
    }
#undef MLA_TILE
#undef MLA_LOAD
#undef MLA_WRITE
    finish_store(o, l, wsf, r32, hi, OB + (size_t)(rowbase + q0 + wid * 32) * 1024 + h * 64, 1024);
    __syncthreads();
}

struct DilU { int b, h, dil, r, n; };
struct DilStage { u32x4 kk[8], vv[8]; int pk; };
__device__ __forceinline__ void dil_load_k(DilStage& st, const DilU& u, int hw, int lane, const bf16_t* K, const int* pos) {
    if (hw >= ((u.n == 0) ? 2 : 0)) {
        const int rowbase = u.b * SEQ, ci = 64 * hw + lane, tokk = (128 * (u.n - 1) + ci) * u.dil + u.r;
        const bf16_t* kg = K + (size_t)(rowbase + tokk) * 1024 + u.h * 64;
#pragma unroll
        for (int c = 0; c < 8; ++c) st.kk[c] = *(const GAS u32x4*)(kg + c * 8);
        st.pk = pos[rowbase + tokk];
    }
}
__device__ __forceinline__ void dil_load_v(DilStage& st, const DilU& u, int hw, int lane, const bf16_t* V) {
    if (hw >= ((u.n == 0) ? 2 : 0)) {
        const int rowbase = u.b * SEQ;
#pragma unroll
        for (int pc = 0; pc < 8; ++pc) { const int rg = pc & 3, dh = pc >> 2; const int cv = 64 * hw + 16 * rg + (lane >> 2); const int tokv = (128 * (u.n - 1) + cv) * u.dil + u.r;
            st.vv[pc] = *(const GAS u32x4*)(V + (size_t)(rowbase + tokv) * 1024 + u.h * 64 + dh * 32 + (lane & 3) * 8); }
    }
}
__device__ __forceinline__ void dil_write(const DilStage& st, const DilU& u, LAS unsigned char* hl, LAS float* xs, int hw, int lane) {
    if (hw >= ((u.n == 0) ? 2 : 0)) {
#pragma unroll
        for (int c = 0; c < 8; ++c) *(LAS u32x4*)(hl + hw * 8192 + c * 1024 + lane * 16) = st.kk[c];
#pragma unroll
        for (int pc = 0; pc < 8; ++pc) *(LAS u32x4*)(hl + 32768 + hw * 8192 + pc * 1024 + lane * 16) = st.vv[pc];
        xs[64 * hw + lane] = (float)st.pk;
    }
}
struct RingStage { u32x4 d[8]; int pk; };
__device__ __forceinline__ void ring_load(RingStage& st, const DilU& u0, int wv, int lane, const bf16_t* K, const bf16_t* V, const int* pos) {
    const int j = wv >> 1, rowbase = u0.b * SEQ, key0 = 128 * (u0.n + (j >> 1)) + 64 * (j & 1);
    if (!(wv & 1)) {
        const int tok = (key0 + lane) * u0.dil + u0.r;
        const bf16_t* kg = K + (size_t)(rowbase + tok) * 1024 + u0.h * 64;
#pragma unroll
        for (int c = 0; c < 8; ++c) st.d[c] = *(const GAS u32x4*)(kg + c * 8);
        st.pk = pos[rowbase + tok];
    } else {
#pragma unroll
        for (int pc = 0; pc < 8; ++pc) { const int rg = pc & 3, dh = pc >> 2; const int tok = (key0 + 16 * rg + (lane >> 2)) * u0.dil + u0.r;
            st.d[pc] = *(const GAS u32x4*)(V + (size_t)(rowbase + tok) * 1024 + u0.h * 64 + dh * 32 + (lane & 3) * 8); }
    }
}
__device__ __forceinline__ void ring_write(const RingStage& st, const DilU& u0, LAS unsigned char* lds, LAS float* xs, int wv, int lane) {
    const int j = wv >> 1, slot = (u0.n + (j >> 1)) & 3;
    LAS unsigned char* base = lds + slot * 32768 + (j & 1) * 8192 + ((wv & 1) ? 16384 : 0);
#pragma unroll
    for (int c = 0; c < 8; ++c) *(LAS u32x4*)(base + c * 1024 + lane * 16) = st.d[c];
    if (!(wv & 1)) xs[slot * 128 + (j & 1) * 64 + lane] = (float)st.pk;
}
template <bool MERGE, bool RING>
__device__ __forceinline__ void dil_compute(LAS unsigned char* hl, LAS float* xs, int hw, int wv, int lane, const DilU& u, const bf16x8 (&qr)[4], float posq,
                                            bf16_t* PARTg, float* LSEg, const bf16_t* P0, const bf16_t* P1, const float* L0, const float* L1, bf16_t* OB, const int abl = 0) {
    const int b = u.b, h = u.h, dil = u.dil, r = u.r, n = u.n;
    const int r32 = lane & 31, hi = lane >> 5;
    const int rowbase = b * SEQ, first_tile = (n == 0) ? 2 : 0;
    LAS float* wsf = RING ? xs + 512 + wv * 64 : xs + 256 + hw * 64;
    const int a = 32 * hw + r32;
    const int tokq = (128 * n + a) * dil + r;
    const float slope2 = exp2f(-0.5f * (float)(h + 1)) * LOG2E;
    float m = 0.f, l = 0.f; f32x16 o[2], negm;
#pragma unroll
    for (int rr = 0; rr < 16; ++rr) { o[0][rr] = 0.f; o[1][rr] = 0.f; negm[rr] = 0.f; }
    const int tlo = max((32 * hw) >> 6, first_tile), thi = (abl & 1) ? -1 : min((32 * hw + 159) >> 6, 3);
    const int voff = ((lane >> 4) & 1) * 32 + (lane & 3) * 8 + (4 * hi + ((lane & 15) >> 2)) * 64;
#pragma unroll 1
    for (int T = tlo; T <= thi; ++T) {
        const int slot = (n - 1 + (T >> 1)) & 3;
        const int kofs = RING ? slot * 32768 + (T & 1) * 8192 : T * 8192, vofs = RING ? kofs + 16384 : 32768 + T * 8192;
        const LAS float* posk = RING ? xs + slot * 128 + (T & 1) * 64 : xs + 64 * T;
        const LAS unsigned char* kb = hl + kofs + hi * 1024 + r32 * 16;
        bf16x8 kf[8];
#pragma unroll
        for (int d0 = 0; d0 < 4; ++d0) { kf[2 * d0] = *(const LAS bf16x8*)(kb + d0 * 2048); kf[2 * d0 + 1] = *(const LAS bf16x8*)(kb + d0 * 2048 + 512); }
        f32x16 p0, p1;
        __builtin_amdgcn_sched_barrier(0);
        __builtin_amdgcn_s_setprio(1);
        p0 = __builtin_amdgcn_mfma_f32_32x32x16_bf16(kf[0], qr[0], negm, 0, 0, 0);
        p1 = __builtin_amdgcn_mfma_f32_32x32x16_bf16(kf[1], qr[0], negm, 0, 0, 0);
#pragma unroll
        for (int d0 = 1; d0 < 4; ++d0) {
            p0 = __builtin_amdgcn_mfma_f32_32x32x16_bf16(kf[2 * d0], qr[d0], p0, 0, 0, 0);
            p1 = __builtin_amdgcn_mfma_f32_32x32x16_bf16(kf[2 * d0 + 1], qr[d0], p1, 0, 0, 0);
        }
        __builtin_amdgcn_s_setprio(0);
        bf16x8 vf0[4];
        v_frags_half(vf0, hl + vofs + voff, 0);
        __builtin_amdgcn_sched_barrier(0);
#pragma unroll
        for (int g = 0; g < 4; ++g) { const f32x4 pa = *(const LAS f32x4*)(posk + 8 * g + 4 * hi), pb = *(const LAS f32x4*)(posk + 32 + 8 * g + 4 * hi);
#pragma unroll
            for (int j = 0; j < 4; ++j) { p0[4 * g + j] += slope2 * (pa[j] - posq); p1[4 * g + j] += slope2 * (pb[j] - posq); } }
        if (64 * T < 32 * hw + 31 || 64 * T + 63 > 32 * hw + 128) {
#pragma unroll
            for (int rr = 0; rr < 16; ++rr) { const int c0 = 64 * T + crow(rr, hi), c1 = c0 + 32;
                if (c0 < a || c0 > a + 128) p0[rr] = -INFINITY;
                if (c1 < a || c1 > a + 128) p1[rr] = -INFINITY; }
        }
        u32x4 pw[4];
        if (softmax_step(p0, p1, m, l, o, pw, wsf, r32, hi, T == tlo)) {
#pragma unroll
            for (int rr = 0; rr < 16; ++rr) negm[rr] = -m; }
        bf16x8 vf1[4];
        v_frags_half(vf1, hl + vofs + voff, 1);
        __builtin_amdgcn_sched_barrier(0);
        pv_mma_half(o[0], vf0, pw);
        pv_mma_half(o[1], vf1, pw);
    }
    l = sum_x32(l);
    int r32e = r32, hie = hi; asm volatile("" : "+v"(r32e), "+v"(hie));
    const int tokqe = (128 * n + 32 * hw + r32e) * dil + r;
    const int ie = r32e & 7, grp = r32e >> 3, rowA = 8 * (ie >> 2) + 4 * hie + (ie & 3), rowB = rowA + 16;
    const size_t rwA = (size_t)(rowbase + (128 * n + 32 * hw + rowA) * dil + r), rwB = (size_t)(rowbase + (128 * n + 32 * hw + rowB) * dil + r);
    if (!MERGE) {
        if (hie == 0) { wsf[32 + r32e] = l; LSEg[(size_t)(rowbase + tokqe) * 16 + h] = m + log2f(l); }
        asm volatile("s_waitcnt lgkmcnt(0)" ::: "memory");
        const float rlA = __builtin_amdgcn_rcpf(wsf[32 + rowA]), rlB = __builtin_amdgcn_rcpf(wsf[32 + rowB]);
#pragma unroll
        for (int d0 = 0; d0 < 2; ++d0) {
            const Frag16 t = tr8x16(o[d0], r32e);
            *(GAS u32x4*)(PARTg + rwA * 1024 + h * 64 + 32 * d0 + 8 * grp) = pack8(t, 0, rlA);
            *(GAS u32x4*)(PARTg + rwB * 1024 + h * 64 + 32 * d0 + 8 * grp) = pack8(t, 8, rlB);
        }
    } else {
        if (hie == 0) { wsf[32 + r32e] = l; wsf[r32e] = m + log2f(l); }
        u32x4 pa[2][2], pb[2][2];
#pragma unroll
        for (int d0 = 0; d0 < 2; ++d0) {
            pa[d0][0] = *(const GAS u32x4*)(P0 + rwA * 1024 + h * 64 + 32 * d0 + 8 * grp); pa[d0][1] = *(const GAS u32x4*)(P0 + rwB * 1024 + h * 64 + 32 * d0 + 8 * grp);
            pb[d0][0] = *(const GAS u32x4*)(P1 + rwA * 1024 + h * 64 + 32 * d0 + 8 * grp); pb[d0][1] = *(const GAS u32x4*)(P1 + rwB * 1024 + h * 64 + 32 * d0 + 8 * grp); }
        const float e0A = L0[rwA * 16 + h], e1A = L1[rwA * 16 + h], e0B = L0[rwB * 16 + h], e1B = L1[rwB * 16 + h];
        asm volatile("s_waitcnt lgkmcnt(0)" ::: "memory");
        const Frag16 t0 = tr8x16(o[0], r32e), t1 = tr8x16(o[1], r32e);
        float w0[2], w1[2], w2l[2], rden[2];
#pragma unroll
        for (int x = 0; x < 2; ++x) { const float e0 = x ? e0B : e0A, e1 = x ? e1B : e1A, e2 = wsf[x ? rowB : rowA], lv = wsf[32 + (x ? rowB : rowA)];
            const float M = fmaxf(fmaxf(e0, e1), e2); w0[x] = exp2f(e0 - M); w1[x] = exp2f(e1 - M); const float w2 = exp2f(e2 - M);
            rden[x] = __builtin_amdgcn_rcpf(w0[x] + w1[x] + w2); w2l[x] = w2 * __builtin_amdgcn_rcpf(lv); }
#pragma unroll
        for (int d0 = 0; d0 < 2; ++d0)
#pragma unroll
            for (int x = 0; x < 2; ++x) { const Frag16& tt = d0 ? t1 : t0;
                const unsigned au[4] = {pa[d0][x].x, pa[d0][x].y, pa[d0][x].z, pa[d0][x].w}, bu[4] = {pb[d0][x].x, pb[d0][x].y, pb[d0][x].z, pb[d0][x].w};
                float v[8];
#pragma unroll
                for (int q = 0; q < 4; ++q) {
                    v[2 * q] = (w0[x] * bflo(au[q]) + w1[x] * bflo(bu[q]) + w2l[x] * tt.v[8 * x + 2 * q]) * rden[x];
                    v[2 * q + 1] = (w0[x] * bfhi(au[q]) + w1[x] * bfhi(bu[q]) + w2l[x] * tt.v[8 * x + 2 * q + 1]) * rden[x]; }
                u32x4 w; w.x = cvt_pk_bf16(v[0], v[1]); w.y = cvt_pk_bf16(v[2], v[3]); w.z = cvt_pk_bf16(v[4], v[5]); w.w = cvt_pk_bf16(v[6], v[7]);
                *(GAS u32x4*)(OB + (x ? rwB : rwA) * 1024 + h * 64 + 32 * d0 + 8 * grp) = w;
            }
    }
}
}

namespace mk {
constexpr int NWAVES = 8, NTHREADS = 512;
constexpr int RING_BYTES = 131072, LDSCTL_OFF = RING_BYTES, MISC_OFF = LDSCTL_OFF + 2048;
constexpr int XS_OFF = RING_BYTES + 4096;
constexpr int LDS_BYTES = RING_BYTES + 4096 + 4096;
constexpr int CW_BAR = 4096;
constexpr int NPHASE = 19;

struct Args {
    const float* in[30]; float* out; unsigned char* ws; int ph_lo, ph_hi;
};

__device__ __forceinline__ float wave_sum(float v) { return wave_sum_all(v); }

struct TItem { const float* W; int ldw, k0, srccol0; bf16_t* WT; bf16_t* lo; int Kd, dstrow0, spread; const float* ks; };
__device__ __forceinline__ void titem_load(const TItem& it, f32x4 (&v)[8], int lane) {
    const int c = lane & 7, coff = it.spread ? 16 * (c >> 1) + 4 * (c & 1) : 4 * c;
#pragma unroll
    for (int i = 0; i < 8; ++i) v[i] = __builtin_nontemporal_load((const GAS f32x4*)(it.W + (size_t)(it.k0 + 8 * (lane >> 3) + i) * it.ldw + it.srccol0 + coff));
}
__device__ __forceinline__ void titem_finish(const TItem& it, const f32x4 (&v)[8], LAS float* scr, int lane) {
    const int c = lane & 7, kc = it.k0 + 8 * (lane >> 3);
    f32x4 s0 = (f32x4){1.f, 1.f, 1.f, 1.f}, s1 = s0;
    if (it.ks) { s0 = *(const GAS f32x4*)(it.ks + kc); s1 = *(const GAS f32x4*)(it.ks + kc + 4); }
#pragma unroll
    for (int j = 0; j < 4; ++j) { const int n = 4 * c + j;
        float f[8];
#pragma unroll
        for (int q = 0; q < 8; ++q) f[q] = v[q][j] * (q < 4 ? s0[q & 3] : s1[q & 3]);
        u32x4 o; o.x = cvt_pk_bf16(f[0], f[1]); o.y = cvt_pk_bf16(f[2], f[3]); o.z = cvt_pk_bf16(f[4], f[5]); o.w = cvt_pk_bf16(f[6], f[7]);
        __builtin_nontemporal_store(o, (GAS u32x4*)(it.WT + (size_t)(it.dstrow0 + n) * it.Kd + kc));
        if (it.lo) {
            float rs[8];
#pragma unroll
            for (int q = 0; q < 8; ++q) rs[q] = f[q] - bf2f(f2bf(f[q]));
            u32x4 ol; ol.x = pk2(rs[0], rs[1]); ol.y = pk2(rs[2], rs[3]); ol.z = pk2(rs[4], rs[5]); ol.w = pk2(rs[6], rs[7]);
            *(GAS u32x4*)(it.lo + (size_t)(it.dstrow0 + n) * it.Kd + kc) = ol;
        }
    }
}

__device__ __forceinline__ int hpw_src_block(int db) { const int pn = db >> 3, q = db & 7, bj = q >> 2, wc = q & 3; return (4 * pn + wc) * 2 + bj; }

__device__ __forceinline__ int opaque(int v) { asm volatile("" : "+v"(v)); return v; }
struct Ctx {
    LAS unsigned char* lds; int tid, lane, wave, G, vcu;
    unsigned char* ws; const float* const* in; float* out;
};
template <class T> __device__ __forceinline__ T* opaque_uniform_ptr(T* p) {
    const unsigned long long u = (unsigned long long)p;
    unsigned lo = __builtin_amdgcn_readfirstlane((unsigned)u), hi = __builtin_amdgcn_readfirstlane((unsigned)(u >> 32));
    asm volatile("" : "+s"(lo), "+s"(hi));
    return (T*)(((unsigned long long)hi << 32) | lo);
}
__device__ __forceinline__ Ctx phase_ctx(const Ctx& F0) {
    Ctx F = F0; F.lane = opaque(F0.lane); F.tid = opaque(F0.tid);
    F.ws = opaque_uniform_ptr(F0.ws); F.out = opaque_uniform_ptr(F0.out); return F;
}

constexpr int I_QKV = 16 * 96, I_O = 16 * 32, I_KVD = 0, I_DQ = 0  , I_UK = 4 * 32, I_UQ = 6 * 48, I_R = 2 * 16 * 2;
constexpr int I_GU1 = 16 * 16, I_DN1 = 4 * 32, I_GUL = 65 * I_GU1, I_DNL = 65 * I_DN1, I_MOEL = I_GUL + I_DNL;
constexpr int NITEMS_P0 = I_MOEL + I_QKV + 2 * I_O + I_KVD + I_DQ + 2 * I_UK + I_UQ + I_R;
__device__ __forceinline__ TItem decode_item(const Ctx& F, int it, int l) {
    bf16_t* Wqkv = (bf16_t*)(F.ws + WS_WQKV); bf16_t* Wo0 = (bf16_t*)(F.ws + WS_WO0); bf16_t* Wo1 = (bf16_t*)(F.ws + WS_WO1);
    bf16_t* Wkvd = (bf16_t*)(F.ws + WS_WKVD); bf16_t* Wdq = (bf16_t*)(F.ws + WS_WDQ); bf16_t* Wukv = (bf16_t*)(F.ws + WS_WUKV); bf16_t* Wuq = (bf16_t*)(F.ws + WS_WUQ);
    bf16_t* Wr = (bf16_t*)(F.ws + WS_WR); bf16_t* Wgu = (bf16_t*)(F.ws + WS_WGU); bf16_t* Wdn = (bf16_t*)(F.ws + WS_WDN);
    TItem t; t.lo = nullptr; t.spread = 0; t.ks = nullptr;
    int r = it;
    if (r < I_GUL) {
        const int e = r / I_GU1, rr = r % I_GU1, kb = rr >> 4, db = rr & 15, tl = db >> 3, q = db & 7, sb = (q >> 2) * 8 + tl * 4 + (q & 3), le = l * 65 + e;
        t.W = (e < 64) ? F.in[26] + ((size_t)l * 64 + e) * 1024 * 512 : F.in[28] + (size_t)l * 1024 * 512;
        t.ldw = 512; t.k0 = kb * 64; t.srccol0 = sb * 32; t.WT = Wgu + (size_t)le * 512 * 1024; t.Kd = 1024; t.dstrow0 = db * 32; return t; }
    r -= I_GUL;
    if (r < I_DNL) {
        const int e = r / I_DN1, rr = r % I_DN1, kb = rr >> 5, db = rr & 31, le = l * 65 + e;
        t.W = (e < 64) ? F.in[27] + ((size_t)l * 64 + e) * 256 * 1024 : F.in[29] + (size_t)l * 256 * 1024;
        { const int pn = db >> 3, q = db & 7, bj = q >> 2, wc = q & 3; t.srccol0 = pn * 256 + 64 * wc + 8 * bj; t.spread = 1; }
        t.ldw = 1024; t.k0 = kb * 64; t.WT = Wdn + (size_t)le * 1024 * 256; t.Kd = 256; t.dstrow0 = db * 32; return t; }
    r -= I_DNL;
    if (r < I_QKV) { const int kb = r / 96, db = r % 96, sct = db >> 5; t.W = F.in[7]; t.ldw = 3072; t.k0 = kb * 64; t.srccol0 = (sct * 32 + hpw_src_block(db & 31)) * 32; t.WT = Wqkv; t.Kd = 1024; t.dstrow0 = db * 32; return t; }
    r -= I_QKV;
    if (r < 2 * I_O) { const int w = r / I_O, rr = r % I_O, kb = rr >> 5, db = rr & 31; t.W = w ? F.in[23] : F.in[10]; t.ldw = 1024; t.k0 = kb * 64; t.srccol0 = db * 32; t.WT = w ? Wo1 : Wo0; t.Kd = 1024; t.dstrow0 = db * 32; return t; }
    r -= 2 * I_O;
    if (r < I_KVD) { const int kb = r / 9, db = r % 9; t.W = F.in[14]; t.ldw = 288; t.k0 = kb * 64; t.srccol0 = db * 32; t.WT = Wkvd; t.Kd = 1024; t.dstrow0 = db * 32; return t; }
    r -= I_KVD;
    if (r < I_DQ) { const int kb = r / 12, db = r % 12; t.W = F.in[19]; t.ldw = 384; t.k0 = kb * 64; t.srccol0 = db * 32; t.WT = Wdq; t.Kd = 1024; t.dstrow0 = db * 32; return t; }
    r -= I_DQ;
    if (r < 2 * I_UK) { const int w = r / I_UK, rr = r % I_UK, kb = rr >> 5, db = rr & 31; t.W = w ? F.in[17] : F.in[16]; t.ldw = 1024; t.k0 = kb * 64; t.srccol0 = hpw_src_block(db) * 32; t.WT = Wukv; t.Kd = 256; t.dstrow0 = w * 1024 + db * 32; t.ks = F.in[15]; return t; }
    r -= 2 * I_UK;
    if (r < I_UQ) { const int kb = r / 48, db = r % 48; t.W = F.in[21]; t.ldw = 1536; t.k0 = kb * 64; t.srccol0 = db * 32; t.WT = Wuq; t.Kd = 384; t.dstrow0 = db * 32; t.ks = F.in[20]; return t; }
    r -= I_UQ;
    { const int l = r >> 5, rr = r & 31, kb = rr >> 1, db = rr & 1;
      t.W = F.in[24] + (size_t)l * 1024 * 64; t.ldw = 64; t.k0 = kb * 64; t.srccol0 = db * 32; t.WT = Wr + (size_t)(l * 2 + 0) * 64 * 1024; t.lo = Wr + (size_t)(l * 2 + 1) * 64 * 1024; t.Kd = 1024; t.dstrow0 = db * 32; return t; }
}


struct BgConv {
    Ctx F; int l, idx, end, stride, cnt, base; bool pend; LAS float* scr; TItem it; f32x4 v[8];
    static constexpr int BG_PERIOD = 2;
    __device__ __forceinline__ void init(const Ctx& F_, int l_, int first, int end_, int stride_, LAS float* scr_) { F = F_; l = l_; idx = first; end = end_; stride = stride_; cnt = 0; base = 0; pend = false; scr = scr_; }
    __device__ __forceinline__ void tick() {
        if (++cnt < BG_PERIOD) return;
        cnt = 0;
        if (pend) { titem_finish(it, v, scr, F.lane); pend = false; }
        if (idx < end) { it = decode_item(F, base + idx, l); titem_load(it, v, F.lane); pend = true; idx += stride; }
    }
    __device__ __forceinline__ void step() {
        if (pend) { titem_finish(it, v, scr, F.lane); pend = false; }
        if (idx < end) { it = decode_item(F, base + idx, l); titem_load(it, v, F.lane); pend = true; idx += stride; }
    }
    __device__ __forceinline__ void drain() {
        for (;;) {
            if (pend) { titem_finish(it, v, scr, F.lane); pend = false; }
            if (idx >= end) break;
            it = decode_item(F, base + idx, l); titem_load(it, v, F.lane); pend = true; idx += stride;
        }
    }
};
struct BgNone { __device__ __forceinline__ void tick() {} };

__device__ __forceinline__ void phase_prologue(const Ctx& F0) {
    const Ctx F = phase_ctx(F0);
    LAS float* sc = (LAS float*)(F.lds + 8 * 16384 - 32768);
    LAS int* qctl = (LAS int*)(F.lds + XS_OFF);
    const float* c = F.in[1];
    if (F.tid < 3) qctl[F.tid] = 0;
    for (int i = F.tid; i < 8 * 1024; i += NTHREADS) { const float cv = c[i]; sc[i] = cv / (1.f + expf(-cv)); }
    __syncthreads();
    float* MOD = (float*)(F.ws + WS_MOD);
    LAS float* red = (LAS float*)(F.lds + 67584);
    if (F.wave < 4) {
        int seq = 0;
        for (int task = F.vcu; task < MODW / 64; task += F.G) {
            ++seq;
            const int j = task * 64 + F.lane;
            const float* W; int nc, jj; float bias;
            if (j < 12288) { const int l = j / 6144; jj = j % 6144; W = F.in[3] + (size_t)l * 1024 * 6144; nc = 6144; bias = F.in[4][l * 6144 + jj]; }
            else { jj = j - 12288; W = F.in[11]; nc = 2048; bias = F.in[12][jj]; }
            const int kk = F.lane >> 4, cg = F.lane & 15;
            f32x4 a4[8];
#pragma unroll
            for (int b = 0; b < 8; ++b) a4[b] = (f32x4){0.f, 0.f, 0.f, 0.f};
            const int kbeg = F.wave * 256;
            const float* Wl = W + (size_t)(8 * kk) * nc + (jj - F.lane) + 4 * cg;
#pragma unroll 1
            for (int k0 = kbeg; k0 < kbeg + 256; k0 += 32) {
                f32x4 w[8];
#pragma unroll
                for (int q = 0; q < 8; ++q) w[q] = __builtin_nontemporal_load((const GAS f32x4*)(Wl + (size_t)(k0 + q) * nc));
#pragma unroll
                for (int b = 0; b < 8; ++b) { const f32x4 s0 = *(const LAS f32x4*)(sc + b * 1024 + k0 + 8 * kk), s1 = *(const LAS f32x4*)(sc + b * 1024 + k0 + 8 * kk + 4);
                    a4[b] += w[0] * s0.x; a4[b] += w[1] * s0.y; a4[b] += w[2] * s0.z; a4[b] += w[3] * s0.w; a4[b] += w[4] * s1.x; a4[b] += w[5] * s1.y; a4[b] += w[6] * s1.z; a4[b] += w[7] * s1.w; }
            }
            float acc[8];
#pragma unroll
            for (int b = 0; b < 8; ++b) {
                f32x4 t = a4[b];
#pragma unroll
                for (int j = 0; j < 4; ++j) { t[j] = sum_x16(t[j]); t[j] = sum_x32(t[j]); }
                LAS float* xs = red + 3 * 512 + F.wave * 512;
                if (kk == 0) *(LAS f32x4*)(xs + b * 64 + 4 * cg) = t;
            }
            asm volatile("s_waitcnt lgkmcnt(0)" ::: "memory");
#pragma unroll
            for (int b = 0; b < 8; ++b) acc[b] = (red + 3 * 512 + F.wave * 512)[b * 64 + F.lane];
            if (F.wave != 0) {
                while (__hip_atomic_load(qctl + 2, __ATOMIC_RELAXED, __HIP_MEMORY_SCOPE_WORKGROUP) != seq - 1) __builtin_amdgcn_s_sleep(2);
#pragma unroll
                for (int b = 0; b < 8; ++b) red[((F.wave - 1) * 8 + b) * 64 + F.lane] = acc[b];
                asm volatile("s_waitcnt lgkmcnt(0)" ::: "memory");
                if (F.lane == 0) __hip_atomic_fetch_add(qctl + 1, 1, __ATOMIC_RELEASE, __HIP_MEMORY_SCOPE_WORKGROUP);
            } else {
                while (__hip_atomic_load(qctl + 1, __ATOMIC_ACQUIRE, __HIP_MEMORY_SCOPE_WORKGROUP) != 3 * seq) __builtin_amdgcn_s_sleep(2);
#pragma unroll
                for (int b = 0; b < 8; ++b) MOD[b * MODW + j] = (((acc[b] + red[(0 * 8 + b) * 64 + F.lane]) + red[(1 * 8 + b) * 64 + F.lane]) + red[(2 * 8 + b) * 64 + F.lane]) + bias;
                asm volatile("s_waitcnt lgkmcnt(0)" ::: "memory");
                if (F.lane == 0) __hip_atomic_store(qctl + 2, seq, __ATOMIC_RELEASE, __HIP_MEMORY_SCOPE_WORKGROUP);
            }
        }
    }
    LAS float* scr = (LAS float*)(F.lds + F.wave * 8448);
    {
        constexpr int NITEMS = NITEMS_P0 - I_DNL;
#define P0_IDX(i) ((i) < I_GUL ? (i) : (i) + I_DNL)
#define P0_GRAB(dst) do { int s_ = 0; if (F.lane == 0) s_ = __hip_atomic_fetch_add(qctl, 1, __ATOMIC_RELAXED, __HIP_MEMORY_SCOPE_WORKGROUP); s_ = __builtin_amdgcn_readfirstlane(s_); dst = (F.vcu + (s_ >> 3) * F.G) * 8 + (s_ & 7); } while (0)
        f32x4 va[8], vb[8]; TItem ta, tb;
        int it; P0_GRAB(it);
        if (it < NITEMS) { ta = decode_item(F, P0_IDX(it), 0); titem_load(ta, va, F.lane); }
        while (it < NITEMS) {
            int itn; P0_GRAB(itn);
            if (itn < NITEMS) { tb = decode_item(F, P0_IDX(itn), 0); titem_load(tb, vb, F.lane); }
            titem_finish(ta, va, scr, F.lane);
            if (itn >= NITEMS) break;
            int itn2; P0_GRAB(itn2);
            if (itn2 < NITEMS) { ta = decode_item(F, P0_IDX(itn2), 0); titem_load(ta, va, F.lane); }
            titem_finish(tb, vb, scr, F.lane);
            it = itn2;
        }
#undef P0_GRAB
    }
}

__device__ __forceinline__ void modnorm_row(const float* xrow, const float* g, const float* sc, const float* sh, bf16_t* orow, int lane) {
    const GAS f32x4* xr = (const GAS f32x4*)xrow + lane;
    f32x4 v[4]; float s2 = 0.f;
#pragma unroll
    for (int j = 0; j < 4; ++j) { v[j] = xr[64 * j]; s2 += (v[j].x * v[j].x + v[j].y * v[j].y) + (v[j].z * v[j].z + v[j].w * v[j].w); }
    const float rstd = rsqrtf(wave_sum(s2) * (1.f / 1024.f) + EPS);
    GAS u32x2* o8 = (GAS u32x2*)orow + lane;
#pragma unroll
    for (int j = 0; j < 4; ++j) {
        const f32x4 gg = ((const GAS f32x4*)g)[lane + 64 * j], ss = ((const GAS f32x4*)sc)[lane + 64 * j], hh = ((const GAS f32x4*)sh)[lane + 64 * j];
        const f32x4 o = v[j] * rstd * gg * (ss + 1.f) + hh;
        u32x2 w; w.x = pk2(o.x, o.y); w.y = pk2(o.z, o.w); o8[64 * j] = w;
    }
}
constexpr int I_FOLD1 = 16 * 9 + 16 * 12, I_FOLD = 8 * I_FOLD1;
__device__ __forceinline__ float sum8(float v) { v += dppf(v, 0); v += dppf(v, 1); return v + dppf(v, 2); }
struct FoldItem { f32x4 v[8]; f32x4 a0, a1, h0, h1; bf16_t* WT; float* PB; int n0, kc; };
__device__ __forceinline__ float sum_r8(float v) {
    v += __int_as_float(__builtin_amdgcn_update_dpp(0, __float_as_int(v), 0x128  , 0xF, 0xF, false));
    v = sum_x16(v); return sum_x32(v);
}
__device__ __forceinline__ void fold_load(const Ctx& F, int idx, FoldItem& t) {
    const int lane = F.lane, b = idx / I_FOLD1; int r = idx % I_FOLD1;
    const float* MOD = (const float*)(F.ws + WS_MOD) + b * MODW;
    int w, kb, db, ldw; const float *W, *sg, *ssc, *ssh;
    if (r < 144) { w = 0; kb = r / 9; db = r % 9; W = F.in[14]; ldw = 288; sg = F.in[13]; ssc = MOD + 12288 + 1024; ssh = MOD + 12288; }
    else { r -= 144; w = 1; kb = r / 12; db = r % 12; W = F.in[19]; ldw = 384; sg = F.in[5] + 1024; ssc = MOD + 6144 + 1024; ssh = MOD + 6144; }
    const int c = lane & 7, kc = kb * 64 + 8 * (lane >> 3);
#pragma unroll
    for (int i = 0; i < 8; ++i) t.v[i] = *(const GAS f32x4*)(W + (size_t)(kc + i) * ldw + db * 32 + 4 * c);
    const f32x4 g0 = *(const GAS f32x4*)(sg + kc), g1 = *(const GAS f32x4*)(sg + kc + 4), s0 = *(const GAS f32x4*)(ssc + kc), s1 = *(const GAS f32x4*)(ssc + kc + 4);
    t.h0 = *(const GAS f32x4*)(ssh + kc); t.h1 = *(const GAS f32x4*)(ssh + kc + 4);
    t.a0 = g0 * (s0 + 1.f); t.a1 = g1 * (s1 + 1.f);
    t.WT = (bf16_t*)(F.ws + WS_W8) + (size_t)(w * 8 + b) * 512 * 1024; t.PB = (float*)(F.ws + WS_PB) + ((size_t)((b * 2 + w) * 16 + kb)) * 512;
    t.n0 = db * 32 + 4 * c; t.kc = kc;
}
__device__ __forceinline__ void fold_finish(const Ctx& F, const FoldItem& t) {
#pragma unroll
    for (int j = 0; j < 4; ++j) {
        float f[8]; float pb = 0.f;
#pragma unroll
        for (int q = 0; q < 8; ++q) { const float x = t.v[q][j]; pb += x * (q < 4 ? t.h0[q & 3] : t.h1[q & 3]); f[q] = x * (q < 4 ? t.a0[q & 3] : t.a1[q & 3]); }
        u32x4 o; o.x = cvt_pk_bf16(f[0], f[1]); o.y = cvt_pk_bf16(f[2], f[3]); o.z = cvt_pk_bf16(f[4], f[5]); o.w = cvt_pk_bf16(f[6], f[7]);
        *(GAS u32x4*)(t.WT + (size_t)(t.n0 + j) * 1024 + t.kc) = o;
        pb = sum_r8(pb);
        if ((F.lane >> 3) == 0) t.PB[t.n0 + j] = pb;
    }
}

__device__ __forceinline__ void phase_norm1(const Ctx& F0) {
    const Ctx F = phase_ctx(F0);
    const int gw = F.vcu * NWAVES + F.wave, NGW = F.G * NWAVES, lane = F.lane;
    const float* MOD = (const float*)(F.ws + WS_MOD);
    bf16_t* XN = (bf16_t*)(F.ws + WS_XN);
    const float* x = F.in[0]; const float* g = F.in[5];
    FoldItem ft; const bool have = gw < I_FOLD; if (have) fold_load(F, gw, ft);
    for (int base = gw * 8; base < NT; base += NGW * 8) {
        const int b = base / SEQ;
        const float* sc = MOD + b * MODW + 1024; const float* sh = MOD + b * MODW;
        f32x4 Aw[4], Bw[4];
#pragma unroll
        for (int q = 0; q < 4; ++q) { const int c0 = 16 * lane + 4 * q;
            const f32x4 gg = *(const GAS f32x4*)(g + c0), ss = *(const GAS f32x4*)(sc + c0);
            Aw[q] = gg * (ss + 1.f); Bw[q] = *(const GAS f32x4*)(sh + c0); }
        f32x4 v[4];
#pragma unroll
        for (int q = 0; q < 4; ++q) v[q] = *(const GAS f32x4*)(x + (size_t)base * 1024 + 16 * lane + 4 * q);
#pragma unroll 1
        for (int ti = 0; ti < 8; ++ti) {
            const int m = base + ti, mn = ti < 7 ? m + 1 : m;
            f32x4 vn[4];
#pragma unroll
            for (int q = 0; q < 4; ++q) vn[q] = *(const GAS f32x4*)(x + (size_t)mn * 1024 + 16 * lane + 4 * q);
            float s2 = 0.f;
#pragma unroll
            for (int q = 0; q < 4; ++q) s2 += (v[q].x * v[q].x + v[q].y * v[q].y) + (v[q].z * v[q].z + v[q].w * v[q].w);
            const float rstd = rsqrtf(wave_sum(s2) * (1.f / 1024.f) + EPS);
            unsigned wq[8];
#pragma unroll
            for (int q = 0; q < 4; ++q) { const f32x4 o = v[q] * rstd * Aw[q] + Bw[q]; wq[2 * q] = cvt_pk_bf16(o.x, o.y); wq[2 * q + 1] = cvt_pk_bf16(o.z, o.w); }
            u32x4 w0, w1; w0.x = wq[0]; w0.y = wq[1]; w0.z = wq[2]; w0.w = wq[3]; w1.x = wq[4]; w1.y = wq[5]; w1.z = wq[6]; w1.w = wq[7];
            bf16_t* o = XN + (size_t)m * 1024 + 16 * lane;
            *(GAS u32x4*)(o) = w0; *(GAS u32x4*)(o + 8) = w1;
#pragma unroll
            for (int q = 0; q < 4; ++q) v[q] = vn[q];
        }
    }
    if (have) fold_finish(F, ft);
    for (int idx = gw + NGW; idx < I_FOLD; idx += NGW) { fold_load(F, idx, ft); fold_finish(F, ft); }
}


__device__ __forceinline__ void load_tables(const Ctx& F0, int l) {
    const Ctx F = phase_ctx(F0);
    LAS int* tab = (LAS int*)(F.lds + LDSCTL_OFF);
    const int* ctl = (const int*)(F.ws + WS_CTL);
    __syncthreads();
    if (F.wave == 0) {
        const int c = ctl[CW_ECNTF + 128 * l + F.lane];
        const int pc = ((c + 255) >> 8) << 8;
        tab[256 + F.lane] = pc; tab[128 + F.lane] = c;
        asm volatile("s_waitcnt lgkmcnt(0)" ::: "memory");
        int x = 0;
        for (int j = 0; j < 64; ++j) { const int y = tab[256 + j]; if (j < F.lane) x += y; }
        tab[F.lane] = x; if (F.lane == 63) tab[64] = x + pc;
    }
    __syncthreads();
}

__device__ __forceinline__ void phase_route(const Ctx& F0, int l, const bf16_t* X) {
    const Ctx F = phase_ctx(F0);
    const float* MOD = (const float*)(F.ws + WS_MOD);
    const float* g = F.in[6] + l * 1024; const float* rb = F.in[25] + l * 64;
    bf16_t* XN = (bf16_t*)(F.ws + WS_XN);
    const bf16_t* Whi = (const bf16_t*)(F.ws + WS_WR) + (size_t)(l * 2) * 64 * 1024; const bf16_t* Wlo = Whi + 64 * 1024;
    int* TOPI = (int*)(F.ws + WS_TOPI); float* TOPW = (float*)(F.ws + WS_TOPW); int* LP = (int*)(F.ws + WS_PPOS); int* LT2 = (int*)(F.ws + WS_LT2);
    unsigned* ecnt = (unsigned*)(F.ws + WS_CTL) + CW_ECNTF + 128 * l;
    LAS float* part = (LAS float*)(F.lds);
    LAS int* hist = (LAS int*)(F.lds + XS_OFF); LAS int* gbase = (LAS int*)(F.lds + XS_OFF + 256);
    LAS unsigned char* rowsL = F.lds; constexpr int ROWB = 2064;
    const int lane = F.lane;
    for (int bt = F.vcu; bt < NT / 64; bt += F.G) {
        if (F.tid < 64) hist[F.tid] = 0;
        const int tokb = bt * 64, tok0 = tokb + F.wave * 8, b = tok0 / SEQ;
        const float* sc = MOD + b * MODW + l * 6144 + 4096; const float* sh = MOD + b * MODW + l * 6144 + 3072;
        {
            f32x4 Aw[4], Bw[4];
#pragma unroll
            for (int q = 0; q < 4; ++q) { const int c0 = 16 * lane + 4 * q;
                const f32x4 gg = *(const GAS f32x4*)(g + c0), ss = *(const GAS f32x4*)(sc + c0);
                Aw[q] = gg * (ss + 1.f); Bw[q] = *(const GAS f32x4*)(sh + c0); }
            u32x4 xa = *(const GAS u32x4*)(X + (size_t)tok0 * 1024 + 16 * lane), xb = *(const GAS u32x4*)(X + (size_t)tok0 * 1024 + 16 * lane + 8);
#pragma unroll 1
            for (int ti = 0; ti < 8; ++ti) {
                const int tok = tok0 + ti, tokn = ti < 7 ? tok + 1 : tok;
                const u32x4 xan = *(const GAS u32x4*)(X + (size_t)tokn * 1024 + 16 * lane), xbn = *(const GAS u32x4*)(X + (size_t)tokn * 1024 + 16 * lane + 8);
                const unsigned xw[8] = {xa.x, xa.y, xa.z, xa.w, xb.x, xb.y, xb.z, xb.w};
                f32x4 v[4]; float s2 = 0.f;
#pragma unroll
                for (int q = 0; q < 4; ++q) { v[q] = (f32x4){__uint_as_float(xw[2 * q] << 16), __uint_as_float(xw[2 * q] & 0xffff0000u), __uint_as_float(xw[2 * q + 1] << 16), __uint_as_float(xw[2 * q + 1] & 0xffff0000u)};
                    s2 += (v[q].x * v[q].x + v[q].y * v[q].y) + (v[q].z * v[q].z + v[q].w * v[q].w); }
                const float rstd = rsqrtf(wave_sum(s2) * (1.f / 1024.f) + EPS);
                unsigned wq[8];
#pragma unroll
                for (int q = 0; q < 4; ++q) { const f32x4 o = v[q] * rstd * Aw[q] + Bw[q]; wq[2 * q] = cvt_pk_bf16(o.x, o.y); wq[2 * q + 1] = cvt_pk_bf16(o.z, o.w); }
                u32x4 w0, w1; w0.x = wq[0]; w0.y = wq[1]; w0.z = wq[2]; w0.w = wq[3]; w1.x = wq[4]; w1.y = wq[5]; w1.z = wq[6]; w1.w = wq[7];
                bf16_t* o = XN + (size_t)tok * 1024 + 16 * lane;
                *(GAS u32x4*)(o) = w0; *(GAS u32x4*)(o + 8) = w1;
                { LAS unsigned char* lr = rowsL + (F.wave * 8 + ti) * ROWB + lane * 32; *(LAS u32x4*)lr = w0; *(LAS u32x4*)(lr + 16) = w1; }
                xa = xan; xb = xbn;
            }
        }
        bf16x8 pbh[2][4], pbl[2][4];
        { const size_t boffs0 = (size_t)(lane & 15) * 1024 + F.wave * 128 + 8 * (lane >> 4);
#pragma unroll
          for (int ks = 0; ks < 2; ++ks)
#pragma unroll
            for (int et = 0; et < 4; ++et) { pbh[ks][et] = *(const GAS bf16x8*)(Whi + boffs0 + (size_t)et * 16 * 1024 + ks * 32); pbl[ks][et] = *(const GAS bf16x8*)(Wlo + boffs0 + (size_t)et * 16 * 1024 + ks * 32); } }
        __syncthreads();
        {
            const int ksl = F.wave;
            f32x4 acc[4][4];
#pragma unroll
            for (int tt = 0; tt < 4; ++tt)
#pragma unroll
                for (int et = 0; et < 4; ++et) acc[tt][et] = (f32x4){0.f, 0.f, 0.f, 0.f};
            const size_t boffs = (size_t)(lane & 15) * 1024 + ksl * 128 + 8 * (lane >> 4);
#pragma unroll
            for (int ks = 0; ks < 4; ++ks) {
                bf16x8 ah[4];
#pragma unroll
                for (int tt = 0; tt < 4; ++tt) ah[tt] = *(const LAS bf16x8*)(rowsL + (tt * 16 + (lane & 15)) * ROWB + (ksl * 128 + ks * 32 + 8 * (lane >> 4)) * 2);
#pragma unroll
                for (int et = 0; et < 4; ++et) {
                    bf16x8 bh, bl;
                    if (ks < 2) { bh = pbh[ks][et]; bl = pbl[ks][et]; }
                    else { bh = *(const GAS bf16x8*)(Whi + boffs + (size_t)et * 16 * 1024 + ks * 32); bl = *(const GAS bf16x8*)(Wlo + boffs + (size_t)et * 16 * 1024 + ks * 32); }
#pragma unroll
                    for (int tt = 0; tt < 4; ++tt) {
                        acc[tt][et] = __builtin_amdgcn_mfma_f32_16x16x32_bf16(ah[tt], bh, acc[tt][et], 0, 0, 0);
                        acc[tt][et] = __builtin_amdgcn_mfma_f32_16x16x32_bf16(ah[tt], bl, acc[tt][et], 0, 0, 0);
                    }
                }
            }
            __syncthreads();
            if (ksl < 4) {
#pragma unroll
                for (int tt = 0; tt < 4; ++tt)
#pragma unroll
                    for (int et = 0; et < 4; ++et)
#pragma unroll
                        for (int r = 0; r < 4; ++r) part[(ksl * 64 + tt * 16 + (lane >> 4) * 4 + r) * 64 + et * 16 + (lane & 15)] = acc[tt][et][r];
            }
            __syncthreads();
            if (ksl >= 4) {
#pragma unroll
                for (int tt = 0; tt < 4; ++tt)
#pragma unroll
                    for (int et = 0; et < 4; ++et)
#pragma unroll
                        for (int r = 0; r < 4; ++r) { LAS float* pp = part + ((ksl - 4) * 64 + tt * 16 + (lane >> 4) * 4 + r) * 64 + et * 16 + (lane & 15); *pp = *pp + acc[tt][et][r]; }
            }
        }
        __syncthreads();
        LAS float* scoreT = (LAS float*)(F.lds + 69632); LAS float* vT = scoreT + 64 * 65;
        { const float bias_ = rb[lane];
#pragma unroll 1
          for (int ti = 0; ti < 8; ++ti) {
            const int tl = F.wave * 8 + ti;
            const float logit = ((part[(0 * 64 + tl) * 64 + lane] + part[(1 * 64 + tl) * 64 + lane]) + part[(2 * 64 + tl) * 64 + lane]) + part[(3 * 64 + tl) * 64 + lane];
            const float sc_ = 1.f / (1.f + expf(-logit));
            scoreT[lane * 65 + tl] = sc_; vT[lane * 65 + tl] = sc_ + bias_;
          } }
        __syncthreads();
        if (F.wave == 0) {
            const int tok = tokb + lane;
            float gm[8], gs[8];
#pragma unroll
            for (int g8 = 0; g8 < 8; ++g8) { float m1 = -INFINITY, m2 = -INFINITY;
#pragma unroll
                for (int i = 0; i < 8; ++i) { const float x = vT[(8 * g8 + i) * 65 + lane]; m2 = fmaxf(m2, fminf(m1, x)); m1 = fmaxf(m1, x); }
                gm[g8] = m1; gs[g8] = m1 + m2; }
#pragma unroll
            for (int g8 = 0; g8 < 8; ++g8) { int rank = 0;
#pragma unroll
                for (int gg = 0; gg < 8; ++gg) if (gg != g8) rank += ((gs[gg] > gs[g8]) || (gs[gg] == gs[g8] && gg < g8)) ? 1 : 0;
                gm[g8] = (rank >= 4) ? -INFINITY : gm[g8]; }
            int ei[TOPK]; float wi[TOPK]; float ssum = 0.f;
#pragma unroll
            for (int it = 0; it < TOPK; ++it) {
                float mx = gm[0];
#pragma unroll
                for (int g8 = 1; g8 < 8; ++g8) mx = fmaxf(mx, gm[g8]);
                int gsel = 0;
#pragma unroll
                for (int g8 = 7; g8 >= 0; --g8) gsel = (gm[g8] == mx) ? g8 : gsel;
                float x[8];
#pragma unroll
                for (int i = 0; i < 8; ++i) x[i] = vT[(8 * gsel + i) * 65 + lane];
                int isel = 0;
#pragma unroll
                for (int i = 7; i >= 0; --i) isel = (x[i] == mx) ? i : isel;
                const int idx = 8 * gsel + isel;
                vT[idx * 65 + lane] = -INFINITY;
                float nm = -INFINITY;
#pragma unroll
                for (int i = 0; i < 8; ++i) nm = fmaxf(nm, (i == isel) ? -INFINITY : x[i]);
#pragma unroll
                for (int g8 = 0; g8 < 8; ++g8) gm[g8] = (g8 == gsel) ? nm : gm[g8];
                const float wsel = scoreT[idx * 65 + lane];
                ei[it] = idx; wi[it] = wsel; ssum += wsel;
            }
            int pj[TOPK];
#pragma unroll
            for (int j = 0; j < TOPK; ++j) pj[j] = __hip_atomic_fetch_add(hist + ei[j], 1, __ATOMIC_RELAXED, __HIP_MEMORY_SCOPE_WORKGROUP);
            asm volatile("s_waitcnt lgkmcnt(0)" ::: "memory");
            { const int h = hist[lane]; gbase[lane] = (int)__hip_atomic_fetch_add(ecnt + lane, (unsigned)h, __ATOMIC_RELAXED, __HIP_MEMORY_SCOPE_AGENT); }
            asm volatile("s_waitcnt lgkmcnt(0)" ::: "memory");
#pragma unroll
            for (int j = 0; j < TOPK; ++j) { const int e = ei[j], lp = gbase[e] + pj[j];
                TOPI[tok * 6 + j] = e; TOPW[tok * 6 + j] = wi[j] / ssum * 2.5f; LP[tok * 6 + j] = lp; LT2[e * 16384 + lp] = tok; }
        }
        __syncthreads();
    }
}

template <bool LAST>
__device__ __forceinline__ void phase_combine(const Ctx& F0, int l, const bf16_t* Xin, void* Xout, const bool have_tables) {
    const Ctx F = phase_ctx(F0);
    if (!have_tables) load_tables(F, l);
    const LAS int* tab = (const LAS int*)(F.lds + LDSCTL_OFF);
    const float* MOD = (const float*)(F.ws + WS_MOD);
    const unsigned char* YB = (const unsigned char*)(F.ws + WS_YB);
    const int* TOPI = (const int*)(F.ws + WS_TOPI); const float* TOPW = (const float*)(F.ws + WS_TOPW); const int* LP = (const int*)(F.ws + WS_PPOS);
    float* RSTD = (float*)(F.ws + WS_RSTD); float* ROPE = (float*)(F.ws + WS_ROPE); const int* posp = (const int*)F.in[2];
    const int gw = F.vcu * NWAVES + F.wave, NGW = F.G * NWAVES, lane = F.lane;
    const float inv = powf(10000.f, -(float)(lane & 15) / 16.f);
    if (!LAST && F.wave == 0) {
        const float* PB = (const float*)(F.ws + WS_PB); float* CB = (float*)(F.ws + WS_CB);
        for (int t = F.vcu; t < 128; t += F.G) { const int o = t * 64 + lane, n = o & 511, w = (o >> 9) & 1;
            float sacc = 0.f;
            if (n < (w ? 384 : 288)) {
#pragma unroll
                for (int kb = 0; kb < 16; ++kb) sacc += PB[((size_t)(o >> 9) * 16 + kb) * 512 + n]; }
            CB[o] = sacc; }
    }
    for (int base = gw * 8; base < NT; base += NGW * 8) {
        const int b = base / SEQ;
        f32x4 gate[4];
#pragma unroll
        for (int q = 0; q < 4; ++q) gate[q] = *(const GAS f32x4*)(MOD + b * MODW + l * 6144 + 5120 + 16 * lane + 4 * q);
        u32x4 y[7], xa, xb; float w[7];
#define CMB_LOAD(TOK, Y, W, XA, XB) do { const int tk_ = (TOK); _Pragma("unroll") for (int j = 0; j < 7; ++j) { int p; \
            if (j < 6) { const int e = TOPI[tk_ * 6 + j]; p = tab[e] + LP[tk_ * 6 + j]; W[j] = TOPW[tk_ * 6 + j] * (1.f / pg8::YB_SCALE); } else { p = PMAX + tk_; W[j] = 1.f / pg8::YB_SCALE; } \
            Y[j] = __builtin_nontemporal_load((const GAS u32x4*)(YB + (size_t)p * 1024 + 16 * lane)); }     \
            { const size_t off_ = (size_t)tk_ * 1024 + 16 * lane; XA = *(const GAS u32x4*)(Xin + off_); XB = *(const GAS u32x4*)(Xin + off_ + 8); } } while (0)
        CMB_LOAD(base, y, w, xa, xb);
#pragma unroll 1
        for (int ti = 0; ti < 8; ++ti) {
            const int tok = base + ti;
            u32x4 yn[7], xan, xbn; float wn[7];
            CMB_LOAD(ti < 7 ? tok + 1 : tok, yn, wn, xan, xbn);
            f32x4 a[4];
#pragma unroll
            for (int q = 0; q < 4; ++q) a[q] = (f32x4){0.f, 0.f, 0.f, 0.f};
#pragma unroll
            for (int j = 0; j < 7; ++j) {
                const unsigned yw[4] = {y[j].x, y[j].y, y[j].z, y[j].w};
#pragma unroll
                for (int q = 0; q < 4; ++q) { const f32x2 lo = __builtin_amdgcn_cvt_pk_f32_fp8((int)yw[q], false), hi = __builtin_amdgcn_cvt_pk_f32_fp8((int)yw[q], true);
                    a[q][0] += w[j] * lo.x; a[q][1] += w[j] * lo.y; a[q][2] += w[j] * hi.x; a[q][3] += w[j] * hi.y; }
            }
            float s2 = 0.f;
            { const size_t off = (size_t)tok * 1024 + 16 * lane;
              const unsigned xw[8] = {xa.x, xa.y, xa.z, xa.w, xb.x, xb.y, xb.z, xb.w};
#pragma unroll
              for (int q = 0; q < 4; ++q) {
                  const f32x4 xi = (f32x4){__uint_as_float(xw[2 * q] << 16), __uint_as_float(xw[2 * q] & 0xffff0000u), __uint_as_float(xw[2 * q + 1] << 16), __uint_as_float(xw[2 * q + 1] & 0xffff0000u)};
                  const f32x4 xo = xi + gate[q] * a[q];
                  a[q] = xo;
                  if (LAST) *(GAS f32x4*)((float*)Xout + off + 4 * q) = xo;
                  s2 += (xo.x * xo.x + xo.y * xo.y) + (xo.z * xo.z + xo.w * xo.w);
              }
              if (!LAST) { u32x4 w0, w1; w0.x = pk2(a[0].x, a[0].y); w0.y = pk2(a[0].z, a[0].w); w0.z = pk2(a[1].x, a[1].y); w0.w = pk2(a[1].z, a[1].w);
                  w1.x = pk2(a[2].x, a[2].y); w1.y = pk2(a[2].z, a[2].w); w1.z = pk2(a[3].x, a[3].y); w1.w = pk2(a[3].z, a[3].w);
                  *(GAS u32x4*)((bf16_t*)Xout + off) = w0; *(GAS u32x4*)((bf16_t*)Xout + off + 8) = w1; }
            }
            if (!LAST) {
                const float rstd = rsqrtf(wave_sum(s2) * (1.f / 1024.f) + EPS);
                if (lane == 0) RSTD[tok] = rstd;
                if (lane < 16) { const float ang = (float)posp[tok] * inv; ROPE[(size_t)tok * 16 + lane] = cosf(ang); ROPE[(size_t)NT * 16 + (size_t)tok * 16 + lane] = sinf(ang); }
            }
#pragma unroll
            for (int j = 0; j < 7; ++j) { y[j] = yn[j]; w[j] = wn[j]; }
            xa = xan; xb = xbn;
        }
#undef CMB_LOAD
    }
}

constexpr int CW_SHD = 3008, EARLY_PER_WG = 2;
__device__ __forceinline__ void early_split(int nrb, int G, int& r1, int& nearly, int& extra) {
    const int n1 = (nrb + 64) * 2, R1 = (n1 + G - 1) / G; r1 = n1 - (R1 - 1) * G;
    const int idle = (R1 >= 2) ? G - r1 : 0;
    nearly = min(256, idle * EARLY_PER_WG); extra = 0;
    const int rem = ((nrb + 64) * 4 - nearly) % G;
    if (rem > 0 && rem <= idle && nearly + rem <= 256) { extra = rem; nearly += rem; }
}
__device__ __forceinline__ void phase_moe_gu(const Ctx& F, const Ctx& P, const char* wsc, int l, int abl) {
    load_tables(F, l);
    const LAS int* tab = (const LAS int*)(F.lds + LDSCTL_OFF);
    const int nrb = tab[64] >> 8; int r1, nearly, extra; early_split(nrb, F.G, r1, nearly, extra);
    unsigned* sig = (unsigned*)(P.ws + WS_CTL) + CW_SHD + l;
    const int nsh = (F.vcu < 128) ? (127 - F.vcu) / F.G + 1 : 0;
    const int nun = (F.vcu < (nrb + 64) * 2) ? ((nrb + 64) * 2 - 1 - F.vcu) / F.G + 1 : 0;
    {
        pg8::MoeSched<2, true> S{tab, (const int*)(P.ws + WS_LT2), F.G, F.vcu, 1024, (unsigned)WS_XN, wsc + WS_WGU + (size_t)l * 65 * 512 * 1024 * 2, 1, 0, 0, 0, sig, nsh, nsh};
        pg8::EpiSwiglu E{(bf16_t*)(P.ws + WS_ACT), tab};
        pg8::gemm_phase<pg8::EpiSwiglu, pg8::MoeSched<2, true>, true>(F.lds, wsc, 1024, S, E, abl);
    }
    if (nsh > 0 && nun <= nsh && F.tid == 0) __hip_atomic_fetch_add(sig, (unsigned)nsh, __ATOMIC_RELAXED, __HIP_MEMORY_SCOPE_AGENT);
    const int k = F.vcu - r1;
    const int q0 = k * EARLY_PER_WG + min(max(k, 0), extra), nq = min(EARLY_PER_WG + (k < extra ? 1 : 0), nearly - q0);
    if (nearly > 0 && k >= 0 && nq > 0) {
        if (F.tid == 0) { unsigned sp = 0;
            while (__hip_atomic_load(sig, __ATOMIC_RELAXED, __HIP_MEMORY_SCOPE_AGENT) < 128u) { __builtin_amdgcn_s_sleep(2); if (++sp > (1u << 22)) break; }
            __builtin_amdgcn_fence(__ATOMIC_ACQUIRE, "agent"); asm volatile("s_waitcnt vmcnt(0)" ::: "memory"); }
        __syncthreads();
        pg8::MoeSched<4, false> S2{tab, (const int*)(P.ws + WS_LT2), F.G, F.vcu, 256, (unsigned)WS_ACT, wsc + WS_WDN + (size_t)l * 65 * 1024 * 256 * 2, 2, 0, q0, nq, nullptr, -1, 0};
        pg8::EpiYB E2{(unsigned char*)(P.ws + WS_YB), tab};
        pg8::gemm_phase<pg8::EpiYB, pg8::MoeSched<4, false>, true>(F.lds, wsc, 256, S2, E2);
    }
}
__device__ __forceinline__ void phase_moe_dn(const Ctx& F, const Ctx& P, const char* wsc, int l, int abl, bool have_tables) {
    if (!have_tables) load_tables(F, l);
    const LAS int* tab = (const LAS int*)(F.lds + LDSCTL_OFF);
    int r1, nearly, extra; early_split(tab[64] >> 8, F.G, r1, nearly, extra);
    pg8::MoeSched<4, false> S{tab, (const int*)(P.ws + WS_LT2), F.G, F.vcu, 256, (unsigned)WS_ACT, wsc + WS_WDN + (size_t)l * 65 * 1024 * 256 * 2, 0, nearly, 0, 0, nullptr, -1, 0};
    pg8::EpiYB E{(unsigned char*)(P.ws + WS_YB), tab};
    pg8::gemm_phase<pg8::EpiYB, pg8::MoeSched<4, false>, true>(F.lds, wsc, 256, S, E, abl);
}

__global__ void __launch_bounds__(NTHREADS, 2) fwd(Args args) {
    extern __shared__ __attribute__((aligned(16))) unsigned char lds_raw[];
    Ctx F;
    F.lds = (LAS unsigned char*)lds_raw;
    F.tid = threadIdx.x; F.lane = F.tid & 63; F.wave = __builtin_amdgcn_readfirstlane(F.tid >> 6);
    F.G = gridDim.x; { const int bx = blockIdx.x; F.vcu = (F.G % 8 == 0) ? (bx % 8) * (F.G / 8) + bx / 8 : bx; }
    F.ws = args.ws; F.in = args.in; F.out = args.out;
    volatile LAS unsigned* MISC = (volatile LAS unsigned*)(F.lds + MISC_OFF);
    for (int u = F.tid; u < (LDS_BYTES - LDSCTL_OFF) / 4; u += NTHREADS) ((LAS unsigned*)(F.lds + LDSCTL_OFF))[u] = 0u;
    __syncthreads();
    const int lo = args.ph_lo, hi = args.ph_hi;
    const bool single = (hi - lo) > 1;
    unsigned* barw = (unsigned*)(F.ws + WS_CTL) + CW_BAR;
    XcdBarrier bar; bar.bar = barw; bar.x = 0; bar.st = nullptr;
    if (single) bar = xcd_barrier_post(barw, MISC + 8);
#define IN(k) (lo <= (k) && (k) < hi)
#define SEAM(k) do { if (IN(k) && IN((k) + 1)) xcd_barrier(bar); } while (0)
#ifndef MK_REPMASK
#define MK_REPMASK 0u
#endif
#define REPS(k) ((((unsigned)(MK_REPMASK) >> (k)) & 1u) ? 2 : 1)
#define RUN(k) for (int rep_ = (IN(k) ? REPS(k) : 0); rep_ > 0; (--rep_ > 0 ? xcd_barrier(bar) : (void)0))
#define PH const Ctx P = phase_ctx(F); const char* wsc = (const char*)P.ws; bf16_t* X1 = (bf16_t*)(P.ws + WS_X1); bf16_t* X2 = (bf16_t*)(P.ws + WS_X2); bf16_t* X3 = X1; (void)wsc; (void)X1; (void)X2; (void)X3

#ifdef MK_XBAR
    if (single) for (int xb_ = 0; xb_ < MK_XBAR; ++xb_) xcd_barrier(bar);
#endif
    RUN(0) { phase_prologue(F); } SEAM(0);
    RUN(1) { phase_norm1(F); } SEAM(1);
    RUN(2) { PH;
        pg8::DenseSched S; S.init(3072, 1024, F.G, (int)blockIdx.x, (unsigned)WS_XN, P.ws + WS_WQKV);
        pg8::EpiQKV E{(bf16_t*)(P.ws + WS_QB), P.in[8], P.in[9]};
        pg8::gemm_phase<pg8::EpiQKV, pg8::DenseSched, true>(F.lds, wsc, 1024, S, E);
    } SEAM(2);
    if (IN(3) || IN(4)) {
        PH;
        int tid3 = threadIdx.x; asm volatile("" : "+v"(tid3));
        const int half = __builtin_amdgcn_readfirstlane(tid3 >> 8), hw = __builtin_amdgcn_readfirstlane((tid3 >> 6) & 3), lane3 = tid3 & 63;
        LAS unsigned char* hl = F.lds + half * 65536; LAS float* xs = (LAS float*)(F.lds + XS_OFF + half * 2048);
        const bf16_t* QB = (const bf16_t*)(P.ws + WS_QB); const bf16_t* KB = (const bf16_t*)(P.ws + WS_KB); const bf16_t* VB = (const bf16_t*)(P.ws + WS_VB);
        bf16_t* PART = (bf16_t*)(P.ws + WS_PART); float* LSE = (float*)(P.ws + WS_LSE); const int* pos = (const int*)P.in[2];
#define DIL_RUN(MERGEV, FIRST, LAST, DECODE, PARTG, LSEG, P0V, P1V, L0V, L1V, OBV, BGH) do { \
            constexpr bool PF_ = !(MERGEV);                          \
            at::DilStage st; at::DilU u; int pair = (FIRST); \
            _Pragma("unroll") for (int z_ = 0; z_ < 8; ++z_) { st.kk[z_] = (u32x4){0u, 0u, 0u, 0u}; st.vv[z_] = (u32x4){0u, 0u, 0u, 0u}; } st.pk = 0; \
            if (PF_ && pair < (LAST)) { DECODE(pair, u); at::dil_load_k(st, u, hw, lane3, KB, pos); at::dil_load_v(st, u, hw, lane3, VB); } \
            _Pragma("unroll 1") for (; pair < (LAST); ++pair) { \
                int ln_ = lane3; asm volatile("" : "+v"(ln_));     \
                if (!PF_) { DECODE(pair, u); if (!(ABL3 & 2)) { at::dil_load_k(st, u, hw, ln_, KB, pos); at::dil_load_v(st, u, hw, ln_, VB); } } \
                at::dil_write(st, u, hl, xs, hw, ln_); \
                const int tokq_ = (128 * u.n + 32 * hw + (ln_ & 31)) * u.dil + u.r; \
                bf16x8 qr_[4]; \
                _Pragma("unroll") for (int d0 = 0; d0 < 4; ++d0) qr_[d0] = *(const GAS bf16x8*)(QB + (size_t)(u.b * SEQ + tokq_) * 1024 + u.h * 64 + 16 * d0 + 8 * (ln_ >> 5)); \
                const float posq_ = (float)pos[u.b * SEQ + tokq_]; \
                __syncthreads(); \
                asm volatile("" :: "v"(qr_[0]), "v"(qr_[1]), "v"(qr_[2]), "v"(qr_[3]), "v"(posq_));     \
                BGH; \
                const at::DilU uc = u; \
                const bool more_ = PF_ && (pair + 1 < (LAST)) && !(ABL3 & 2); \
                if (more_) { DECODE(pair + 1, u); at::dil_load_k(st, u, hw, ln_, KB, pos); }     \
                at::dil_compute<MERGEV, false>(hl, xs, hw, 0, ln_, uc, qr_, posq_, PARTG(uc), LSEG(uc), P0V, P1V, L0V, L1V, OBV, ABL3); \
                if (more_) at::dil_load_v(st, u, hw, ln_, VB);                                    \
                BGH; \
                __syncthreads(); \
            } } while (0)
#define DEC3(pr, uu) do { const int u_ = (pr) * 2 + half, bh_ = u_ >> 5, rem_ = u_ & 31, g_ = rem_ >> 4, idx_ = rem_ & 15; \
            (uu).b = bh_ >> 4; (uu).h = bh_ & 15; (uu).dil = g_ ? 4 : 1; (uu).r = g_ ? (idx_ >> 2) : 0; (uu).n = g_ ? (idx_ & 3) : idx_; } while (0)
#define DEC4(pr, uu) do { const int u_ = (pr) * 2 + half, bh_ = u_ >> 4; (uu).b = bh_ >> 4; (uu).h = bh_ & 15; (uu).dil = 16; (uu).r = u_ & 15; (uu).n = 0; } while (0)
#define PART3(uu) (PART + (size_t)((uu).dil == 4 ? 1 : 0) * NT * 1024)
#define LSE3(uu) (LSE + (size_t)((uu).dil == 4 ? 1 : 0) * NT * 16)
#define NULLP(uu) nullptr
#ifndef MK_ABL3
#define MK_ABL3 0
#endif
        RUN(3) {
            const int ABL3 = (rep_ == 2) ? MK_ABL3 : 0;
            const int per3 = (2048 + F.G - 1) / F.G, first3 = F.vcu * per3, last3 = min((F.vcu + 1) * per3, 2048);
            const int wv3 = half * 4 + hw;
            LAS float* xsr = (LAS float*)(F.lds + XS_OFF);
#define DEC3H(pr, hh, uu) do { const int u_ = (pr) * 2 + (hh), bh_ = u_ >> 5, rem_ = u_ & 31, g_ = rem_ >> 4, idx_ = rem_ & 15; \
            (uu).b = bh_ >> 4; (uu).h = bh_ & 15; (uu).dil = g_ ? 4 : 1; (uu).r = g_ ? (idx_ >> 2) : 0; (uu).n = g_ ? (idx_ & 3) : idx_; } while (0)
            at::RingStage st; at::DilU u0; int pair = first3;
            if (pair < last3) { DEC3H(pair, 0, u0); at::ring_load(st, u0, wv3, lane3, KB, VB, pos); }
#pragma unroll 1
            for (; pair < last3; ++pair) {
                int ln_ = lane3; asm volatile("" : "+v"(ln_));
                at::DilU u; DEC3H(pair, half, u); DEC3H(pair, 0, u0);
                at::ring_write(st, u0, F.lds, xsr, wv3, ln_);
                const int tokq_ = (128 * u.n + 32 * hw + (ln_ & 31)) * u.dil + u.r;
                bf16x8 qr_[4];
#pragma unroll
                for (int d0 = 0; d0 < 4; ++d0) qr_[d0] = *(const GAS bf16x8*)(QB + (size_t)(u.b * SEQ + tokq_) * 1024 + u.h * 64 + 16 * d0 + 8 * (ln_ >> 5));
                const float posq_ = (float)pos[u.b * SEQ + tokq_];
                __syncthreads();
                asm volatile("" :: "v"(qr_[0]), "v"(qr_[1]), "v"(qr_[2]), "v"(qr_[3]), "v"(posq_));
                if (pair + 1 < last3 && !(ABL3 & 2)) { at::DilU un; DEC3H(pair + 1, 0, un); at::ring_load(st, un, wv3, ln_, KB, VB, pos); }
                at::dil_compute<false, true>(F.lds, xsr, hw, wv3, ln_, u, qr_, posq_, PART3(u), LSE3(u), nullptr, nullptr, nullptr, nullptr, nullptr, ABL3);
                __syncthreads();
            }
#undef DEC3H
        }
        SEAM(3);
        RUN(4) {
            const int ABL3 = 0;
            const int per4 = (1024 + F.G - 1) / F.G;
            const bool bgw = hw < 2;
            BgConv bg; bg.init(P, 0, F.vcu * 4 + half * 2 + hw, I_DNL, F.G * 4, (LAS float*)(hl + (hw ? 32768 : 0))); bg.base = I_GUL;
            DIL_RUN(true, F.vcu * per4, min((F.vcu + 1) * per4, 1024), DEC4, NULLP, NULLP, PART, PART + (size_t)NT * 1024, LSE, LSE + (size_t)NT * 16, (bf16_t*)(P.ws + WS_OB), if (bgw) bg.step());
            if (bgw) bg.drain();
        }
#undef DIL_RUN
#undef DEC3
#undef DEC4
#undef PART3
#undef LSE3
#undef NULLP
    }
    SEAM(4);
    RUN(5) { PH;
        pg8::DenseSched S; S.init(1024, 1024, F.G, (int)blockIdx.x, (unsigned)WS_OB, P.ws + WS_WO0);
        pg8::EpiResid<false> E{P.in[0], (const float*)(P.ws + WS_MOD), 2048, X1};
        pg8::gemm_phase<pg8::EpiResid<false>, pg8::DenseSched, true>(F.lds, wsc, 1024, S, E);
    } SEAM(5);
    RUN(6) { PH; phase_route(F, 0, X1); } SEAM(6);
    RUN(7) { PH; phase_moe_gu(F, P, wsc, 0, 0); } SEAM(7);
    RUN(8) { PH; phase_moe_dn(F, P, wsc, 0, 0, single); } SEAM(8);
    RUN(9) { PH; phase_combine<false>(F, 0, X1, X2, single); } SEAM(9);
        RUN(10) { PH;
            pg8::DualSched S; S.G = F.G; S.c = (int)blockIdx.x; S.a0 = (unsigned)WS_X2; S.Bt = wsc + WS_W8;
            pg8::EpiDown E{(bf16_t*)(P.ws + WS_DKV), (const float*)(P.ws + WS_RSTD), (const float*)(P.ws + WS_CB), (float*)(P.ws + WS_SSQ), (float*)(P.ws + WS_KPSS), (float*)(P.ws + WS_KPR), (const float*)(P.ws + WS_ROPE), P.in[18]};
            pg8::gemm_phase<pg8::EpiDown, pg8::DualSched, true>(F.lds, wsc, 1024, S, E);
        } SEAM(10);
        RUN(12) { PH;
            { pg8::DenseSched S; S.init(2048, 256, F.G, (int)blockIdx.x, (unsigned)WS_DKV, P.ws + WS_WUKV, 512);
              pg8::EpiKV E{(bf16_t*)(P.ws + WS_KM), (bf16_t*)(P.ws + WS_VM), (const float*)(P.ws + WS_KPSS), (const float*)(P.ws + WS_KPR), P.in[18], (const float*)(P.ws + WS_SSQ)};
              pg8::gemm_phase<pg8::EpiKV, pg8::DenseSched, true>(F.lds, wsc, 256, S, E, 0, 512); }
            { pg8::DenseSched S; S.init(1536, 384, F.G, (int)blockIdx.x, (unsigned)WS_DQ, P.ws + WS_WUQ, 512);
              pg8::EpiQ E{(bf16_t*)(P.ws + WS_QR), (const float*)(P.ws + WS_SSQ)};
              pg8::gemm_phase<pg8::EpiQ, pg8::DenseSched, true>(F.lds, wsc, 384, S, E, 0, 512); }
        } SEAM(12);
        RUN(13) { PH;
#ifdef MK_ABL13
            const int ABL13 = (rep_ == 2) ? MK_ABL13 : 0;
#else
            const int ABL13 = 0;
#endif
            BgConv bg; bg.init(P, 1, F.vcu * NWAVES + F.wave, I_MOEL, F.G * NWAVES, (LAS float*)(F.lds + 49152 + F.wave * 8448));
            for (int v = F.vcu; v < 256; v += F.G) {
                const int bh = v >> 1, odd = v & 1;
#pragma unroll 1
                for (int i = 0; i < 4; ++i) {
                    const int qb = odd ? (i == 0 ? 1 : i == 1 ? 6 : i == 2 ? 2 : 5) : (i == 0 ? 0 : i == 1 ? 7 : i == 2 ? 3 : 4);
                    at::mla_unit(F.lds, bh >> 4, bh & 15, qb, (const bf16_t*)(P.ws + WS_QR), (const bf16_t*)(P.ws + WS_KM), (const bf16_t*)(P.ws + WS_VM), (const float*)(P.ws + WS_ROPE), P.in[22], (bf16_t*)(P.ws + WS_OB), bg, ABL13);
                }
            }
            if (!(ABL13 & 4)) bg.drain();
        } SEAM(13);
        RUN(14) { PH;
            pg8::DenseSched S; S.init(1024, 1024, F.G, (int)blockIdx.x, (unsigned)WS_OB, P.ws + WS_WO1);
            pg8::EpiResid<true> E{X2, (const float*)(P.ws + WS_MOD), 6144 + 2048, X3};
            pg8::gemm_phase<pg8::EpiResid<true>, pg8::DenseSched, true>(F.lds, wsc, 1024, S, E);
        } SEAM(14);

    RUN(15) { PH; phase_route(F, 1, X3); } SEAM(15);
    RUN(16) { PH; phase_moe_gu(F, P, wsc, 1, 0); } SEAM(16);
    RUN(17) { PH; phase_moe_dn(F, P, wsc, 1, 0, single); } SEAM(17);
    RUN(18) { PH; phase_combine<true>(F, 1, X3, P.out, single); } SEAM(18);
#undef IN
#undef SEAM
#undef RUN
#undef REPS
#undef PH
}
}
static int g_grid = 0;
static void mk_setup() {
    if (g_grid) return;
    int dev = 0, cus = 0, per_cu = 0;
    (void)hipGetDevice(&dev);
    (void)hipDeviceGetAttribute(&cus, hipDeviceAttributeMultiprocessorCount, dev);
    (void)hipFuncSetAttribute((const void*)mk::fwd, hipFuncAttributeMaxDynamicSharedMemorySize, mk::LDS_BYTES);
    if (hipOccupancyMaxActiveBlocksPerMultiprocessor(&per_cu, (const void*)mk::fwd, mk::NTHREADS, mk::LDS_BYTES) != hipSuccess) per_cu = 0;
    (void)hipGetLastError();
    if (per_cu < 1) fprintf(stderr, "kernel_launch: the occupancy query reports %d resident workgroups per CU for %d threads + %d B of LDS; launching one per CU anyway\n", per_cu, mk::NTHREADS, mk::LDS_BYTES);
    g_grid = cus;
    if (g_grid <= 0) g_grid = 256;
}
static void mk_launch(hipStream_t s, void* const* d_in, void* d_out, void* d_ws, int lo, int hi) {
    mk::Args a{};
    for (int i = 0; i < 30; ++i) a.in[i] = (const float*)d_in[i];
    a.out = (float*)d_out; a.ws = (unsigned char*)d_ws; a.ph_lo = lo; a.ph_hi = hi;
    hipLaunchKernelGGL(mk::fwd, dim3(g_grid), dim3(mk::NTHREADS), mk::LDS_BYTES, s, a);
}

extern "C" void kernel_launch(void* const* d_in, const int* in_sizes, int n_in, void* d_out, int out_size, void* d_ws, size_t ws_size,
                              hipStream_t stream) {
    if (n_in != 30 || ws_size < WS_END || out_size != NT * DM) { fprintf(stderr, "kernel_launch: unexpected n_in %d / out %d / ws %zu\n", n_in, out_size, ws_size); return; }
    (void)in_sizes;
    mk_setup();
    (void)hipMemsetAsync((unsigned char*)d_ws + WS_CTL, 0, 1 * MiB, stream);
#ifndef MK_PER_PHASE
    mk_launch(stream, d_in, d_out, d_ws, 0, mk::NPHASE);
#else
    for (int k = 0; k < mk::NPHASE; ++k) mk_launch(stream, d_in, d_out, d_ws, k, k + 1);
#endif
}
```
